# Optimizing an MI355X kernel written in HIP

```python
import jax, jax.numpy as jnp
from jax import lax
import numpy as np


D_MODEL = 1024
BATCH = 4
SEQ = 8192
DEPTH = 2
DEC_BATCH = 1
DEC_SEQ = 16384
PAST_LEN = 128

GRID_W = 64
HEAD_DIM = 64
NA_HEADS = 8
NA_KH_MAX = 8
NA_KW = 16
MLA_HEADS = 8
MLA_Q_RANK = 384
MLA_KV_RANK = 256
MLA_NOPE = 64
MLA_ROPE = 32
MLA_V = 64
MLA_THETA = 10000.0
GQA_Q_HEADS = 16
GQA_KV_HEADS = 4
WINDOW = 128
ROPE_THETA = 500000.0
ROT_DIM = HEAD_DIM // 4
D_FF = 2816
CONV_W = 3
BLOCK_Q = 128
ALPHA = (2 * DEPTH) ** 0.25
BETA = (8 * DEPTH) ** -0.25
NORM_EPS = 1e-5
NA_WIDTH = NA_HEADS * HEAD_DIM
L0_IN = 3 * NA_WIDTH + MLA_Q_RANK + MLA_KV_RANK + MLA_ROPE
L1_IN = (GQA_Q_HEADS + 2 * GQA_KV_HEADS) * HEAD_DIM

kernel_name = "hybrid_na_mla_swa_encoder"


def layer_norm(x, g, b):
    xf = x.astype(jnp.float32)
    mu = jnp.mean(xf, axis=-1, keepdims=True)
    xc = xf - mu
    var = jnp.mean(xc * xc, axis=-1, keepdims=True)
    y = xc * lax.rsqrt(var + NORM_EPS)
    return (y * g.astype(jnp.float32) + b.astype(jnp.float32)).astype(x.dtype)


def rms_norm(x, g):
    xf = x.astype(jnp.float32)
    y = xf * lax.rsqrt(jnp.mean(xf * xf, axis=-1, keepdims=True) + NORM_EPS)
    return (y * g.astype(jnp.float32)).astype(x.dtype)


def rope(x, theta, rot_dim):
    S = x.shape[1]
    half = rot_dim // 2
    inv = 1.0 / (theta ** (jnp.arange(0, rot_dim, 2, dtype=jnp.float32) / rot_dim))
    ang = jnp.arange(S, dtype=jnp.float32)[:, None] * inv[None, :]
    cos = jnp.cos(ang)[None, :, None, :]
    sin = jnp.sin(ang)[None, :, None, :]
    xr = x[..., :rot_dim].astype(jnp.float32)
    x1, x2 = xr[..., :half], xr[..., half:]
    rot = jnp.concatenate([x1 * cos - x2 * sin, x2 * cos + x1 * sin], axis=-1)
    return jnp.concatenate([rot.astype(x.dtype), x[..., rot_dim:]], axis=-1)


def neighbourhood_attention(q, k, v, rpb):
    B, S, H, dh = q.shape
    rows = S // GRID_W
    kh = min(NA_KH_MAX, rows)
    n = kh * NA_KW
    col = jnp.arange(GRID_W)
    cs = jnp.clip(col - NA_KW // 2, 0, GRID_W - NA_KW)
    key_cols = cs[:, None] + jnp.arange(NA_KW)[None, :]
    dc = jnp.broadcast_to((key_cols - col[:, None])[:, None, :], (GRID_W, kh, NA_KW))
    scale = dh ** -0.5

    def one_row(args):
        q_r, r = args
        rs = jnp.clip(r - kh // 2, 0, rows - kh)
        key_rows = rs + jnp.arange(kh)
        idx = (key_rows[None, :, None] * GRID_W + key_cols[:, None, :]).reshape(GRID_W, n)
        dr = jnp.broadcast_to((key_rows - r)[None, :, None], (GRID_W, kh, NA_KW))
        bias = rpb[:, dr + NA_KH_MAX - 1, dc + NA_KW - 1].reshape(H, GRID_W, n)
        k_g = k[:, idx]
        v_g = v[:, idx]
        s = jnp.einsum('bqhd,bqnhd->bhqn', q_r, k_g).astype(jnp.float32) * scale
        s = s + bias.astype(jnp.float32)[None]
        p = jax.nn.softmax(s, axis=-1).astype(v.dtype)
        return jnp.einsum('bhqn,bqnhd->bqhd', p, v_g)

    q_rows = q.reshape(B, rows, GRID_W, H, dh).transpose(1, 0, 2, 3, 4)
    out = lax.map(one_row, (q_rows, jnp.arange(rows)))
    return out.transpose(1, 0, 2, 3, 4).reshape(B, S, H * dh)


def mla_attention(q_nope, q_rope, k_nope, k_rope, v):
    B, S, H, _ = q_nope.shape
    nb = S // BLOCK_Q
    scale = (MLA_NOPE + MLA_ROPE) ** -0.5

    def blk(args):
        qn, qr = args
        s = jnp.einsum('bqhd,bkhd->bhqk', qn, k_nope) + jnp.einsum('bqhr,bkr->bhqk', qr, k_rope)
        p = jax.nn.softmax(s.astype(jnp.float32) * scale, axis=-1).astype(v.dtype)
        return jnp.einsum('bhqk,bkhd->bqhd', p, v)

    def to_blocks(t):
        return t.reshape(B, nb, BLOCK_Q, *t.shape[2:]).swapaxes(0, 1)

    out = lax.map(blk, (to_blocks(q_nope), to_blocks(q_rope)))
    return out.swapaxes(0, 1).reshape(B, S, H * MLA_V)


def window_gqa_sink(q, k, v, sinks):
    B, S, Hq, dh = q.shape
    Hkv = k.shape[2]
    G = Hq // Hkv
    nb = S // BLOCK_Q
    pad = ((0, 0), (BLOCK_Q, BLOCK_Q), (0, 0), (0, 0))
    kp = jnp.pad(k, pad).reshape(B, nb + 2, BLOCK_Q, Hkv, dh)
    vp = jnp.pad(v, pad).reshape(B, nb + 2, BLOCK_Q, Hkv, dh)
    kb = jnp.concatenate([kp[:, :-2], kp[:, 1:-1], kp[:, 2:]], axis=2)
    vb = jnp.concatenate([vp[:, :-2], vp[:, 1:-1], vp[:, 2:]], axis=2)
    qb = q.reshape(B, nb, BLOCK_Q, Hkv, G, dh)
    s = jnp.einsum('bnqkgd,bnjkd->bnkgqj', qb, kb).astype(jnp.float32) * (dh ** -0.5)
    blk = jnp.arange(nb)[:, None, None]
    qpos = blk * BLOCK_Q + jnp.arange(BLOCK_Q)[None, :, None]
    kpos = (blk - 1) * BLOCK_Q + jnp.arange(3 * BLOCK_Q)[None, None, :]
    valid = (jnp.abs(qpos - kpos) <= WINDOW) & (kpos >= 0) & (kpos < S)
    s = jnp.where(valid[None, :, None, None], s, -jnp.inf)
    sink = sinks.astype(jnp.float32).reshape(1, 1, Hkv, G, 1, 1)
    m = jnp.maximum(jnp.max(s, axis=-1, keepdims=True), sink)
    p = jnp.exp(s - m)
    p = (p / (jnp.sum(p, axis=-1, keepdims=True) + jnp.exp(sink - m))).astype(v.dtype)
    out = jnp.einsum('bnkgqj,bnjkd->bnqkgd', p, vb)
    return out.reshape(B, S, Hq * dh)


def even_layer(x, w_in, rpb, g_qn, w_q_up, g_kvn, w_kv_up, w_out, ln_g, ln_b):
    B, S, _ = x.shape
    h = x @ w_in
    sizes = [NA_WIDTH, NA_WIDTH, NA_WIDTH, MLA_Q_RANK, MLA_KV_RANK]
    splits = [int(c) for c in np.cumsum(sizes)]
    qa, ka, va, q_lat, kv_lat, k_r = jnp.split(h, splits, axis=-1)
    shp = (B, S, NA_HEADS, HEAD_DIM)
    a_out = neighbourhood_attention(qa.reshape(shp), ka.reshape(shp), va.reshape(shp), rpb)
    qm = (rms_norm(q_lat, g_qn) @ w_q_up).reshape(B, S, MLA_HEADS, MLA_NOPE + MLA_ROPE)
    q_nope = qm[..., :MLA_NOPE]
    q_rope = rope(qm[..., MLA_NOPE:], MLA_THETA, MLA_ROPE)
    kvm = (rms_norm(kv_lat, g_kvn) @ w_kv_up).reshape(B, S, MLA_HEADS, MLA_NOPE + MLA_V)
    k_nope, v_m = kvm[..., :MLA_NOPE], kvm[..., MLA_NOPE:]
    k_rope = rope(k_r[:, :, None, :], MLA_THETA, MLA_ROPE)[:, :, 0]
    b_out = mla_attention(q_nope, q_rope, k_nope, k_rope, v_m)
    mix = jnp.concatenate([a_out, b_out], axis=-1) @ w_out
    return layer_norm(ALPHA * x + mix, ln_g, ln_b)


def odd_layer(x, w_in, sinks, w_out, ln_g, ln_b):
    B, S, _ = x.shape
    h = x @ w_in
    qw = GQA_Q_HEADS * HEAD_DIM
    kw = GQA_KV_HEADS * HEAD_DIM
    q, k, v = jnp.split(h, [qw, qw + kw], axis=-1)
    q = rope(q.reshape(B, S, GQA_Q_HEADS, HEAD_DIM), ROPE_THETA, ROT_DIM)
    k = rope(k.reshape(B, S, GQA_KV_HEADS, HEAD_DIM), ROPE_THETA, ROT_DIM)
    v = v.reshape(B, S, GQA_KV_HEADS, HEAD_DIM)
    mix = window_gqa_sink(q, k, v, sinks) @ w_out
    return layer_norm(ALPHA * x + mix, ln_g, ln_b)


def channel_block(x, w_up, conv_w, conv_b, w_down, ln_g, ln_b):
    S = x.shape[1]
    h = x @ w_up
    hp = jnp.pad(h, ((0, 0), (CONV_W // 2, CONV_W // 2), (0, 0)))
    h = sum(hp[:, j:j + S] * conv_w[j] for j in range(CONV_W)) + conv_b
    gate, val = jnp.split(h, 2, axis=-1)
    y = (jax.nn.gelu(gate, approximate=False) * val) @ w_down
    return layer_norm(ALPHA * x + y, ln_g, ln_b)


def encoder(x, even_params, odd_params, ffn_params):
    for layer in range(DEPTH):
        if layer % 2 == 0:
            x = even_layer(x, *even_params)
        else:
            x = odd_layer(x, *odd_params)
        x = channel_block(x, *ffn_params[layer])
    return x


def setup_inputs(seed: int = 0) -> dict:
    key = jax.random.key(seed)
    ks = iter(jax.random.split(key, 40))

    def nrm(shape, scale):
        return jax.random.normal(next(ks), shape, jnp.float32) * scale

    def gain(n):
        return 1.0 + nrm((n,), 0.01)

    d = D_MODEL
    inp = {}
    inp['x_prompt'] = nrm((BATCH, SEQ, d), 1.0)
    inp['x_sample'] = nrm((DEC_BATCH, DEC_SEQ, d), 1.0)
    inp['l0_w_in'] = nrm((d, L0_IN), d ** -0.5)
    inp['l0_rpb'] = nrm((NA_HEADS, 2 * NA_KH_MAX - 1, 2 * NA_KW - 1), 0.1)
    inp['l0_g_q_norm'] = gain(MLA_Q_RANK)
    inp['l0_w_q_up'] = nrm((MLA_Q_RANK, MLA_HEADS * (MLA_NOPE + MLA_ROPE)), MLA_Q_RANK ** -0.5)
    inp['l0_g_kv_norm'] = gain(MLA_KV_RANK)
    inp['l0_w_kv_up'] = nrm((MLA_KV_RANK, MLA_HEADS * (MLA_NOPE + MLA_V)), MLA_KV_RANK ** -0.5)
    inp['l0_w_out'] = nrm((NA_WIDTH + MLA_HEADS * MLA_V, d), BETA * (NA_WIDTH + MLA_HEADS * MLA_V) ** -0.5)
    inp['l0_ln1_g'] = gain(d)
    inp['l0_ln1_b'] = nrm((d,), 0.01)
    inp['l0_ffn_w_up'] = nrm((d, 2 * D_FF), d ** -0.5)
    inp['l0_ffn_conv_w'] = nrm((CONV_W, 2 * D_FF), CONV_W ** -0.5)
    inp['l0_ffn_conv_b'] = nrm((2 * D_FF,), 0.01)
    inp['l0_ffn_w_down'] = nrm((D_FF, d), BETA * D_FF ** -0.5)
    inp['l0_ln2_g'] = gain(d)
    inp['l0_ln2_b'] = nrm((d,), 0.01)
    inp['l1_w_in'] = nrm((d, L1_IN), d ** -0.5)
    inp['l1_sinks'] = nrm((GQA_Q_HEADS,), 1.0)
    inp['l1_w_out'] = nrm((GQA_Q_HEADS * HEAD_DIM, d), BETA * (GQA_Q_HEADS * HEAD_DIM) ** -0.5)
    inp['l1_ln1_g'] = gain(d)
    inp['l1_ln1_b'] = nrm((d,), 0.01)
    inp['l1_ffn_w_up'] = nrm((d, 2 * D_FF), d ** -0.5)
    inp['l1_ffn_conv_w'] = nrm((CONV_W, 2 * D_FF), CONV_W ** -0.5)
    inp['l1_ffn_conv_b'] = nrm((2 * D_FF,), 0.01)
    inp['l1_ffn_w_down'] = nrm((D_FF, d), BETA * D_FF ** -0.5)
    inp['l1_ln2_g'] = gain(d)
    inp['l1_ln2_b'] = nrm((d,), 0.01)
    return inp


def reference(x_prompt, x_sample,
              l0_w_in, l0_rpb, l0_g_q_norm, l0_w_q_up, l0_g_kv_norm, l0_w_kv_up, l0_w_out,
              l0_ln1_g, l0_ln1_b, l0_ffn_w_up, l0_ffn_conv_w, l0_ffn_conv_b, l0_ffn_w_down,
              l0_ln2_g, l0_ln2_b,
              l1_w_in, l1_sinks, l1_w_out, l1_ln1_g, l1_ln1_b,
              l1_ffn_w_up, l1_ffn_conv_w, l1_ffn_conv_b, l1_ffn_w_down, l1_ln2_g, l1_ln2_b):
    even_params = (l0_w_in, l0_rpb, l0_g_q_norm, l0_w_q_up, l0_g_kv_norm, l0_w_kv_up,
                   l0_w_out, l0_ln1_g, l0_ln1_b)
    odd_params = (l1_w_in, l1_sinks, l1_w_out, l1_ln1_g, l1_ln1_b)
    ffn_params = [
        (l0_ffn_w_up, l0_ffn_conv_w, l0_ffn_conv_b, l0_ffn_w_down, l0_ln2_g, l0_ln2_b),
        (l1_ffn_w_up, l1_ffn_conv_w, l1_ffn_conv_b, l1_ffn_w_down, l1_ln2_g, l1_ln2_b),
    ]
    y_prompt = encoder(x_prompt, even_params, odd_params, ffn_params)
    y_sample = encoder(x_sample, even_params, odd_params, ffn_params)
    return (y_prompt, y_sample)
```

```cpp
#include <hip/hip_runtime.h>
#include <hip/hip_cooperative_groups.h>
#include <cstdio>
namespace cg = cooperative_groups;

#ifndef MEGA
#define MEGA 0
#endif

typedef _Float16 hf;
typedef _Float16 h8 __attribute__((ext_vector_type(8)));
typedef _Float16 h4 __attribute__((ext_vector_type(4)));
typedef float f4 __attribute__((ext_vector_type(4)));
typedef float f16v __attribute__((ext_vector_type(16)));
#define MFMA(a, b, c) __builtin_amdgcn_mfma_f32_32x32x16_f16((a), (b), (c), 0, 0, 0)
#define DI __device__ __forceinline__

constexpr int T = 49152;
constexpr int TP = 32768;
constexpr int DM = 1024;
constexpr int DFF = 2816;
constexpr float LOG2E = 1.4426950408889634f;
constexpr float ALPHA = 1.4142135623730951f;
constexpr float EPS = 1e-5f;
constexpr float NEG_BIG = -1e30f;

constexpr size_t SZ_WIN0 = (size_t)2304 * 1024 * 2, SZ_WQUP = (size_t)768 * 384 * 2, SZ_WKVUP = (size_t)1024 * 256 * 2,
                 SZ_WOUT = (size_t)1024 * 1024 * 2, SZ_WUP = (size_t)5632 * 1024 * 2, SZ_WDN = (size_t)1024 * 2816 * 2,
                 SZ_WIN1 = (size_t)1536 * 1024 * 2;
constexpr size_t OFF_WIN0 = 0, OFF_WQUP = OFF_WIN0 + SZ_WIN0, OFF_WKVUP = OFF_WQUP + SZ_WQUP, OFF_WOUT0 = OFF_WKVUP + SZ_WKVUP,
                 OFF_WUP0 = OFF_WOUT0 + SZ_WOUT, OFF_WDN0 = OFF_WUP0 + SZ_WUP, OFF_WIN1 = OFF_WDN0 + SZ_WDN, OFF_WOUT1 = OFF_WIN1 + SZ_WIN1,
                 OFF_WUP1 = OFF_WOUT1 + SZ_WOUT, OFF_WDN1 = OFF_WUP1 + SZ_WUP, OFF_ROPEM = OFF_WDN1 + SZ_WDN;
constexpr size_t SZ_ROPEM = (size_t)16384 * 16 * 4 * 2, SZ_ROPEG = (size_t)16384 * 8 * 4 * 2;
constexpr size_t OFF_ROPEG = OFF_ROPEM + SZ_ROPEM, OFF_SS = OFF_ROPEG + SZ_ROPEG, SZ_SS = (size_t)T * 8 * 4;
constexpr size_t OFF_R1 = OFF_SS + SZ_SS, SZ_R1 = (size_t)T * 1024 * 2;
constexpr size_t OFF_R2 = OFF_R1 + SZ_R1, SZ_R2 = (size_t)T * 1024 * 2;
constexpr size_t OFF_R3 = OFF_R2 + SZ_R2, SZ_R3 = (size_t)T * 2816 * 2;
constexpr size_t WS_END = OFF_R3 + SZ_R3;
constexpr size_t OFF_XH = OFF_R1, OFF_QM = OFF_R1;
constexpr size_t OFF_AO = OFF_R2, OFF_QL = OFF_R2, OFF_KVL = OFF_R2 + (size_t)T * 384 * 2;
constexpr size_t OFF_U = OFF_R3;
constexpr size_t OFF_QA = OFF_R3, OFF_KA = OFF_QA + (size_t)T * 512 * 2, OFF_VAT = OFF_KA + (size_t)T * 512 * 2, OFF_KN = OFF_VAT + (size_t)T * 512 * 2,
                 OFF_VMT = OFF_KN + (size_t)T * 512 * 2, OFF_KR = OFF_VMT + (size_t)T * 512 * 2;
constexpr size_t OFF_Q1 = OFF_R3, OFF_K1 = OFF_Q1 + (size_t)T * 1024 * 2, OFF_V1T = OFF_K1 + (size_t)T * 256 * 2;
static_assert(OFF_KR + (size_t)T * 32 * 2 <= WS_END, "L0 attention buffers overflow R3");
static_assert(OFF_V1T + (size_t)T * 256 * 2 <= WS_END, "L1 attention buffers overflow R3");

constexpr int LDS_BYTES = 73728;
constexpr int AST = 72;
constexpr int CST = 132;

struct Params {
    const float* in[28];
    float* out;
    char* ws;
};

DI void seq_of(int t, int& s0, int& L) { if (t < TP) { s0 = t & ~8191; L = 8192; } else { s0 = TP; L = 16384; } }
DI const float* xrow(const Params& p, int t) { return t < TP ? p.in[0] + (size_t)t * DM : p.in[1] + (size_t)(t - TP) * DM; }
DI h8 cvt8(f4 a, f4 b, float s) { h8 v; v[0] = (hf)(a[0] * s); v[1] = (hf)(a[1] * s); v[2] = (hf)(a[2] * s); v[3] = (hf)(a[3] * s); v[4] = (hf)(b[0] * s); v[5] = (hf)(b[1] * s); v[6] = (hf)(b[2] * s); v[7] = (hf)(b[3] * s); return v; }
DI float wave_sum(float v) { v += __shfl_xor(v, 32); v += __shfl_xor(v, 16); v += __shfl_xor(v, 8); v += __shfl_xor(v, 4); v += __shfl_xor(v, 2); v += __shfl_xor(v, 1); return v; }

DI void prep_weight(const float* __restrict__ src, const float* __restrict__ g, hf* __restrict__ dst, int K, int Nsrc, int Npad, int mode, long gtid, long gstride) {
    const long total = (long)(K >> 3) * Npad;
    for (long idx = gtid; idx < total; idx += gstride) {
        const int n = (int)(idx % Npad), kc = (int)(idx / Npad);
        int col = n;
        if (mode == 1) { const int t = n >> 7, w = n & 127; col = (w < 64) ? (t * 64 + w) : (DFF + t * 64 + (w - 64)); }
        h8 v;
#pragma unroll
        for (int j = 0; j < 8; ++j) {
            float x = 0.f;
            if (col < Nsrc) { x = src[(size_t)(kc * 8 + j) * Nsrc + col]; if (g) x *= g[kc * 8 + j]; }
            v[j] = (hf)x;
        }
        *(h8*)(dst + (size_t)n * K + kc * 8) = v;
    }
}

__device__ void phase_prep(const Params& p) {
    const long gtid = (long)blockIdx.x * 256 + threadIdx.x, gs = (long)gridDim.x * 256;
    char* ws = p.ws;
    prep_weight(p.in[2], nullptr, (hf*)(ws + OFF_WIN0), 1024, 2208, 2304, 0, gtid, gs);
    prep_weight(p.in[5], p.in[4], (hf*)(ws + OFF_WQUP), 384, 768, 768, 0, gtid, gs);
    prep_weight(p.in[7], p.in[6], (hf*)(ws + OFF_WKVUP), 256, 1024, 1024, 0, gtid, gs);
    prep_weight(p.in[8], nullptr, (hf*)(ws + OFF_WOUT0), 1024, 1024, 1024, 0, gtid, gs);
    prep_weight(p.in[11], nullptr, (hf*)(ws + OFF_WUP0), 1024, 5632, 5632, 1, gtid, gs);
    prep_weight(p.in[14], nullptr, (hf*)(ws + OFF_WDN0), 2816, 1024, 1024, 0, gtid, gs);
    prep_weight(p.in[17], nullptr, (hf*)(ws + OFF_WIN1), 1024, 1536, 1536, 0, gtid, gs);
    prep_weight(p.in[19], nullptr, (hf*)(ws + OFF_WOUT1), 1024, 1024, 1024, 0, gtid, gs);
    prep_weight(p.in[22], nullptr, (hf*)(ws + OFF_WUP1), 1024, 5632, 5632, 1, gtid, gs);
    prep_weight(p.in[25], nullptr, (hf*)(ws + OFF_WDN1), 2816, 1024, 1024, 0, gtid, gs);
    hf* xh = (hf*)(ws + OFF_XH);
    for (long idx = gtid; idx < (long)T * 128; idx += gs) {
        const int t = (int)(idx >> 7), c = (int)(idx & 127) * 8;
        const float* xr = xrow(p, t) + c;
        const f4 a = *(const f4*)xr, b = *(const f4*)(xr + 4);
        *(h8*)(xh + (size_t)t * DM + c) = cvt8(a, b, 1.f);
    }
    float* rm = (float*)(ws + OFF_ROPEM); float* rg = (float*)(ws + OFF_ROPEG);
    for (long idx = gtid; idx < 16384L * 24; idx += gs) {
        const int pos = (int)(idx / 24), i = (int)(idx % 24);
        double inv;
        if (i < 16) inv = exp2(-(double)i / 16.0 * 13.287712379549449);
        else inv = exp2(-(double)(i - 16) / 8.0 * 18.931568569324174);
        const float angf = (float)pos * (float)inv;
        const double ang = (double)angf;
        const float c = (float)cos(ang), s = (float)sin(ang);
        if (i < 16) { rm[(size_t)pos * 32 + i] = c; rm[(size_t)pos * 32 + 16 + i] = s; }
        else { rg[(size_t)pos * 16 + (i - 16)] = c; rg[(size_t)pos * 16 + 8 + (i - 16)] = s; }
    }
}

DI void gemm_tile_to_lds(const hf* __restrict__ A, int lda, int arow0, int alo, int ahi, const hf* __restrict__ Bt, int K, int n0, char* smem) {
    const int tid = threadIdx.x, lane = tid & 63, wave = tid >> 6, wr = wave >> 1, wc = wave & 1, ml = lane & 31, h = lane >> 5;
    hf* As = (hf*)smem;
    hf* Bs = As + 2 * 128 * AST;
    const hf* pa[4]; const hf* pb[4];
    const int lr = tid >> 3, kc = (tid & 7) * 8;
#pragma unroll
    for (int i = 0; i < 4; ++i) {
        int rg = arow0 + lr + 32 * i; rg = rg < alo ? alo : (rg > ahi ? ahi : rg);
        pa[i] = A + (size_t)rg * lda + kc;
        pb[i] = Bt + (size_t)(n0 + lr + 32 * i) * K + kc;
    }
    f16v acc[2][2];
#pragma unroll
    for (int i = 0; i < 2; ++i)
#pragma unroll
        for (int j = 0; j < 2; ++j)
#pragma unroll
            for (int e = 0; e < 16; ++e) acc[i][j][e] = 0.f;
    h8 ra[4], rb[4];
#pragma unroll
    for (int i = 0; i < 4; ++i) { ra[i] = *(const h8*)pa[i]; rb[i] = *(const h8*)pb[i]; }
    __syncthreads();
#pragma unroll
    for (int i = 0; i < 4; ++i) { *(h8*)(As + (lr + 32 * i) * AST + kc) = ra[i]; *(h8*)(Bs + (lr + 32 * i) * AST + kc) = rb[i]; }
    __syncthreads();
    const int nk = K >> 6;
    for (int kt = 0; kt < nk; ++kt) {
        const int cur = kt & 1;
        if (kt + 1 < nk) {
#pragma unroll
            for (int i = 0; i < 4; ++i) { ra[i] = *(const h8*)(pa[i] + (kt + 1) * 64); rb[i] = *(const h8*)(pb[i] + (kt + 1) * 64); }
        }
        const hf* as = As + cur * 128 * AST + (wr * 64 + ml) * AST + 8 * h;
        const hf* bs = Bs + cur * 128 * AST + (wc * 64 + ml) * AST + 8 * h;
#pragma unroll
        for (int kk = 0; kk < 4; ++kk) {
            const h8 a0 = *(const h8*)(as + kk * 16), a1 = *(const h8*)(as + 32 * AST + kk * 16);
            const h8 b0 = *(const h8*)(bs + kk * 16), b1 = *(const h8*)(bs + 32 * AST + kk * 16);
            acc[0][0] = MFMA(b0, a0, acc[0][0]); acc[0][1] = MFMA(b1, a0, acc[0][1]);
            acc[1][0] = MFMA(b0, a1, acc[1][0]); acc[1][1] = MFMA(b1, a1, acc[1][1]);
        }
        if (kt + 1 < nk) {
            hf* ad = As + (cur ^ 1) * 128 * AST; hf* bd = Bs + (cur ^ 1) * 128 * AST;
#pragma unroll
            for (int i = 0; i < 4; ++i) { *(h8*)(ad + (lr + 32 * i) * AST + kc) = ra[i]; *(h8*)(bd + (lr + 32 * i) * AST + kc) = rb[i]; }
        }
        __syncthreads();
    }
    float* C = (float*)smem;
#pragma unroll
    for (int i = 0; i < 2; ++i)
#pragma unroll
        for (int j = 0; j < 2; ++j)
#pragma unroll
            for (int g = 0; g < 4; ++g) {
                f4 v; v[0] = acc[i][j][4 * g]; v[1] = acc[i][j][4 * g + 1]; v[2] = acc[i][j][4 * g + 2]; v[3] = acc[i][j][4 * g + 3];
                *(f4*)(C + (wr * 64 + i * 32 + ml) * CST + wc * 64 + j * 32 + 8 * g + 4 * h) = v;
            }
    __syncthreads();
}

DI void ld8(const float* C, int r, int c, f4& a, f4& b) { a = *(const f4*)(C + r * CST + c); b = *(const f4*)(C + r * CST + c + 4); }

template <int NCOLS, bool RSCALE>
DI void store_transposed(const float* C, int c0, hf* dst  , int tok0) {
    const int tid = threadIdx.x;
    const int col = tid % NCOLS, rc0 = tid / NCOLS;
    constexpr int STEP = 256 / NCOLS;
#pragma unroll
    for (int rc = rc0; rc < 16; rc += STEP) {
        h8 v;
#pragma unroll
        for (int j = 0; j < 8; ++j) { float x = C[(8 * rc + j) * CST + c0 + col]; if (RSCALE) x *= C[(8 * rc + j) * CST + 128]; v[j] = (hf)x; }
        *(h8*)(dst + (size_t)col * T + tok0 + 8 * rc) = v;
    }
}

__device__ void phase_in0(const Params& p, char* smem) {
    char* ws = p.ws;
    const hf* Xh = (const hf*)(ws + OFF_XH); const hf* W = (const hf*)(ws + OFF_WIN0);
    hf* Qa = (hf*)(ws + OFF_QA); hf* Ka = (hf*)(ws + OFF_KA); hf* VaT = (hf*)(ws + OFF_VAT);
    hf* QL = (hf*)(ws + OFF_QL); hf* KVL = (hf*)(ws + OFF_KVL); hf* Kr = (hf*)(ws + OFF_KR);
    float* SS = (float*)(ws + OFF_SS); const float* rm = (const float*)(ws + OFF_ROPEM);
    const float* C = (const float*)smem;
    const int tid = threadIdx.x, cc = tid & 15, rb = tid >> 4;
    for (int tile = blockIdx.x; tile < 384 * 18; tile += gridDim.x) {
        const int tm = tile / 18, tn = tile % 18, m0 = tm * 128;
        gemm_tile_to_lds(Xh, DM, m0, 0, T - 1, W, 1024, tn * 128, smem);
        if (tn >= 8 && tn < 12) {
            store_transposed<128, false>(C, 0, VaT + (size_t)(tn - 8) * 128 * T, m0);
        } else if (tn == 17) {
            if (cc < 2) {
                int s0, L; seq_of(m0, s0, L);
#pragma unroll
                for (int i = 0; i < 8; ++i) {
                    const int r = rb + 16 * i, t = m0 + r, pos = t - s0;
                    f4 a0, a1, b0, b1; ld8(C, r, 8 * cc, a0, a1); ld8(C, r, 16 + 8 * cc, b0, b1);
                    const float* cs = rm + (size_t)pos * 32 + 8 * cc;
                    h8 o1, o2;
#pragma unroll
                    for (int j = 0; j < 8; ++j) {
                        const float x1 = j < 4 ? a0[j & 3] : a1[j & 3], x2 = j < 4 ? b0[j & 3] : b1[j & 3];
                        const float c = cs[j], s = cs[16 + j];
                        o1[j] = (hf)(x1 * c - x2 * s); o2[j] = (hf)(x2 * c + x1 * s);
                    }
                    *(h8*)(Kr + (size_t)t * 32 + 8 * cc) = o1; *(h8*)(Kr + (size_t)t * 32 + 16 + 8 * cc) = o2;
                }
            }
        } else {
            hf* dst; int ld, cbase, ssidx = -1; float scale = 1.f;
            if (tn < 4) { dst = Qa; ld = 512; cbase = tn * 128; scale = 0.125f * LOG2E; }
            else if (tn < 8) { dst = Ka; ld = 512; cbase = (tn - 4) * 128; }
            else if (tn < 15) { dst = QL; ld = 384; cbase = (tn - 12) * 128; ssidx = tn - 12; }
            else { dst = KVL; ld = 256; cbase = (tn - 15) * 128; ssidx = 3 + (tn - 15); }
#pragma unroll
            for (int i = 0; i < 8; ++i) {
                const int r = rb + 16 * i, t = m0 + r;
                f4 a, b; ld8(C, r, 8 * cc, a, b);
                *(h8*)(dst + (size_t)t * ld + cbase + 8 * cc) = cvt8(a, b, scale);
                if (ssidx >= 0) {
                    float ss = a[0] * a[0] + a[1] * a[1] + a[2] * a[2] + a[3] * a[3] + b[0] * b[0] + b[1] * b[1] + b[2] * b[2] + b[3] * b[3];
                    ss += __shfl_xor(ss, 1); ss += __shfl_xor(ss, 2); ss += __shfl_xor(ss, 4); ss += __shfl_xor(ss, 8);
                    if (cc == 0) SS[(size_t)t * 8 + ssidx] = ss;
                }
            }
        }
    }
}

__device__ void phase_up(const Params& p, char* smem) {
    char* ws = p.ws;
    const hf* QL = (const hf*)(ws + OFF_QL); const hf* KVL = (const hf*)(ws + OFF_KVL);
    const hf* Wq = (const hf*)(ws + OFF_WQUP); const hf* Wkv = (const hf*)(ws + OFF_WKVUP);
    hf* Qm = (hf*)(ws + OFF_QM); hf* Kn = (hf*)(ws + OFF_KN); hf* VmT = (hf*)(ws + OFF_VMT);
    const float* SS = (const float*)(ws + OFF_SS); const float* rm = (const float*)(ws + OFF_ROPEM);
    float* C = (float*)smem;
    const int tid = threadIdx.x;
    const float QSC = 0.10206207261596575f * LOG2E;
    for (int tile = blockIdx.x; tile < 384 * 14; tile += gridDim.x) {
        const int tm = tile / 14, tw = tile % 14, m0 = tm * 128;
        if (tw < 6) {
            const int tn = tw;
            gemm_tile_to_lds(QL, 384, m0, 0, T - 1, Wq, 384, tn * 128, smem);
            if (tid < 128) { const float* s = SS + (size_t)(m0 + tid) * 8; C[tid * CST + 128] = rsqrtf((s[0] + s[1] + s[2]) * (1.f / 384.f) + EPS); }
            __syncthreads();
            const int cc = tid & 15, rb = tid >> 4;
            const int n = tn * 128 + 8 * cc, hd = n / 96, w = n - hd * 96;
            int s0, L; seq_of(m0, s0, L);
#pragma unroll
            for (int i = 0; i < 8; ++i) {
                const int r = rb + 16 * i, t = m0 + r, pos = t - s0;
                const float rq = C[r * CST + 128] * QSC;
                f4 a, b; ld8(C, r, 8 * cc, a, b);
                if (w >= 64) {
                    const int iw = w - 64;
                    f4 pa, pb;
                    if (iw < 16) ld8(C, r, 8 * cc + 16, pa, pb); else ld8(C, r, 8 * cc - 16, pa, pb);
                    const float* cs = rm + (size_t)pos * 32 + (iw & 15);
                    const float sg = iw < 16 ? -1.f : 1.f;
#pragma unroll
                    for (int j = 0; j < 4; ++j) {
                        a[j] = a[j] * cs[j] + sg * pa[j] * cs[16 + j];
                        b[j] = b[j] * cs[4 + j] + sg * pb[j] * cs[20 + j];
                    }
                }
                *(h8*)(Qm + (size_t)t * 768 + n) = cvt8(a, b, rq);
            }
        } else {
            const int tn = tw - 6;
            gemm_tile_to_lds(KVL, 256, m0, 0, T - 1, Wkv, 256, tn * 128, smem);
            if (tid < 128) { const float* s = SS + (size_t)(m0 + tid) * 8; C[tid * CST + 128] = rsqrtf((s[3] + s[4]) * (1.f / 256.f) + EPS); }
            __syncthreads();
            const int cc = tid & 7, rb = tid >> 3;
#pragma unroll
            for (int i = 0; i < 4; ++i) {
                const int r = rb + 32 * i, t = m0 + r;
                f4 a, b; ld8(C, r, 8 * cc, a, b);
                *(h8*)(Kn + (size_t)t * 512 + tn * 64 + 8 * cc) = cvt8(a, b, C[r * CST + 128]);
            }
            store_transposed<64, true>(C, 64, VmT + (size_t)tn * 64 * T, m0);
        }
    }
}

enum { AT_MLA = 0, AT_NA = 1, AT_SWA = 2 };
struct AttnArgs {
    const hf* Q; int qs;
    const hf* K; int ks;
    const hf* Kx;
    const hf* Vt;
    hf* O;
    int t0;
    int kt0;
    int nkt;
    int R0, rows, kr0;
    int qpos0, kpos0; float sink;
};

template <int DQK, int MODE>
__device__ void attn_item(const AttnArgs& a, char* smem) {
    constexpr int KST = DQK + 8, VST = 68, NKC = DQK / 32;
    hf* Ks = (hf*)smem;
    hf* Vs = Ks + 64 * KST;
    const float* biasL = (const float*)(smem + 24576);
    const int tid = threadIdx.x, lane = tid & 63, wave = tid >> 6, ql = lane & 31, h = lane >> 5;
    const int qrow = 32 * wave + ql;
    h8 qf[DQK / 16];
    {
        const hf* qp = a.Q + (size_t)(a.t0 + qrow) * a.qs + 8 * h;
#pragma unroll
        for (int s = 0; s < DQK / 16; ++s) qf[s] = *(const h8*)(qp + 16 * s);
    }
    float m = NEG_BIG, l = 0.f;
    if (MODE == AT_SWA) { m = a.sink; l = (h == 0) ? 1.f : 0.f; }
    f16v o[2];
#pragma unroll
    for (int e = 0; e < 16; ++e) { o[0][e] = 0.f; o[1][e] = 0.f; }
    int qr = 0, qc = 0, rsq = 0, csq = 0;
    if (MODE == AT_NA) {
        qr = a.R0 + (qrow >> 6); qc = qrow & 63;
        rsq = qr - 4; rsq = rsq < 0 ? 0 : (rsq > a.rows - 8 ? a.rows - 8 : rsq);
        csq = qc - 8; csq = csq < 0 ? 0 : (csq > 48 ? 48 : csq);
    }
    const int pq = a.qpos0 + qrow;
    h8 rk[NKC], rv[2];
    auto load_tile = [&](int kt) {
        const int tok0 = a.kt0 + 64 * kt;
#pragma unroll
        for (int i = 0; i < NKC; ++i) {
            const int c = tid + 256 * i, row = c / (DQK / 8), kc = c % (DQK / 8);
            if (MODE == AT_MLA && kc >= 8) rk[i] = *(const h8*)(a.Kx + (size_t)(tok0 + row) * 32 + (kc - 8) * 8);
            else rk[i] = *(const h8*)(a.K + (size_t)(tok0 + row) * a.ks + kc * 8);
        }
#pragma unroll
        for (int i = 0; i < 2; ++i) {
            const int c = tid + 256 * i, d = c >> 3, kc = c & 7;
            rv[i] = *(const h8*)(a.Vt + (size_t)d * T + tok0 + kc * 8);
        }
    };
    load_tile(0);
    for (int kt = 0; kt < a.nkt; ++kt) {
        __syncthreads();
#pragma unroll
        for (int i = 0; i < NKC; ++i) {
            const int c = tid + 256 * i, row = c / (DQK / 8), kc = c % (DQK / 8);
            *(h8*)(Ks + row * KST + kc * 8) = rk[i];
        }
#pragma unroll
        for (int i = 0; i < 2; ++i) {
            const int c = tid + 256 * i, d = c >> 3, kc = c & 7;
            h4 lo, hi; lo[0] = rv[i][0]; lo[1] = rv[i][1]; lo[2] = rv[i][2]; lo[3] = rv[i][3]; hi[0] = rv[i][4]; hi[1] = rv[i][5]; hi[2] = rv[i][6]; hi[3] = rv[i][7];
            *(h4*)(Vs + d * VST + kc * 8) = lo; *(h4*)(Vs + d * VST + kc * 8 + 4) = hi;
        }
        __syncthreads();
        if (kt + 1 < a.nkt) load_tile(kt + 1);
        f16v x[2];
#pragma unroll
        for (int i = 0; i < 2; ++i) {
#pragma unroll
            for (int e = 0; e < 16; ++e) x[i][e] = 0.f;
            const hf* kp = Ks + (32 * i + ql) * KST + 8 * h;
#pragma unroll
            for (int s = 0; s < DQK / 16; ++s) { const h8 kf = *(const h8*)(kp + 16 * s); x[i] = MFMA(kf, qf[s], x[i]); }
        }
        if (MODE == AT_NA) {
            const int kr = a.kr0 + kt;
            const bool vr = (kr >= rsq) && (kr < rsq + 8);
            const int brow = (kr - qr + 7) * 31;
#pragma unroll
            for (int i = 0; i < 2; ++i)
#pragma unroll
                for (int e = 0; e < 16; ++e) {
                    const int kcol = 32 * i + (e & 3) + 8 * (e >> 2) + 4 * h;
                    const bool v = vr && (kcol >= csq) && (kcol < csq + 16);
                    const int bi = v ? (brow + kcol - qc + 15) : 0;
                    const float bb = biasL[bi];
                    x[i][e] = v ? (x[i][e] + bb) : NEG_BIG;
                }
        } else if (MODE == AT_SWA) {
            const int pk0 = a.kpos0 + 64 * kt;
#pragma unroll
            for (int i = 0; i < 2; ++i)
#pragma unroll
                for (int e = 0; e < 16; ++e) {
                    const int pk = pk0 + 32 * i + (e & 3) + 8 * (e >> 2) + 4 * h;
                    const int dd = pq - pk;
                    const bool v = (dd <= 128) && (dd >= -128);
                    x[i][e] = v ? x[i][e] : NEG_BIG;
                }
        }
        float mx = x[0][0];
#pragma unroll
        for (int e = 1; e < 16; ++e) mx = fmaxf(mx, x[0][e]);
#pragma unroll
        for (int e = 0; e < 16; ++e) mx = fmaxf(mx, x[1][e]);
        mx = fmaxf(mx, __shfl_xor(mx, 32));
        const float mnew = fmaxf(m, mx);
        const float alpha = __builtin_amdgcn_exp2f(m - mnew);
        m = mnew;
        float ps = 0.f;
#pragma unroll
        for (int i = 0; i < 2; ++i)
#pragma unroll
            for (int e = 0; e < 16; ++e) { const float pv = __builtin_amdgcn_exp2f(x[i][e] - mnew); x[i][e] = pv; ps += pv; }
        l = l * alpha + ps;
#pragma unroll
        for (int e = 0; e < 16; ++e) { o[0][e] *= alpha; o[1][e] *= alpha; }
#pragma unroll
        for (int i = 0; i < 2; ++i)
#pragma unroll
            for (int sp = 0; sp < 2; ++sp) {
                h8 pf;
#pragma unroll
                for (int j = 0; j < 8; ++j) pf[j] = (hf)x[i][8 * sp + j];
#pragma unroll
                for (int dt = 0; dt < 2; ++dt) {
                    const hf* vp = Vs + (32 * dt + ql) * VST + 32 * i + 16 * sp + 4 * h;
                    const h4 v0 = *(const h4*)vp, v1 = *(const h4*)(vp + 8);
                    h8 vf; vf[0] = v0[0]; vf[1] = v0[1]; vf[2] = v0[2]; vf[3] = v0[3]; vf[4] = v1[0]; vf[5] = v1[1]; vf[6] = v1[2]; vf[7] = v1[3];
                    o[dt] = MFMA(vf, pf, o[dt]);
                }
            }
    }
    l += __shfl_xor(l, 32);
    const float inv = 1.f / l;
    hf* op = a.O + (size_t)(a.t0 + qrow) * 1024;
#pragma unroll
    for (int dt = 0; dt < 2; ++dt)
#pragma unroll
        for (int g = 0; g < 4; ++g) {
            h4 v; v[0] = (hf)(o[dt][4 * g] * inv); v[1] = (hf)(o[dt][4 * g + 1] * inv); v[2] = (hf)(o[dt][4 * g + 2] * inv); v[3] = (hf)(o[dt][4 * g + 3] * inv);
            *(h4*)(op + 32 * dt + 8 * g + 4 * h) = v;
        }
}

__device__ void phase_attn0(const Params& p, char* smem) {
    char* ws = p.ws;
    const int tid = threadIdx.x;
    for (int it = blockIdx.x; it < 3072 + 3072; it += gridDim.x) {
        AttnArgs a{};
        a.O = (hf*)(ws + OFF_AO);
        if (it < 3072) {
            const int u = (it & 7) + 8 * (it >> 9), qb = (it >> 3) & 63;
            int head, s0, L, t0;
            if (u < 32) { const int sq = u >> 3; head = u & 7; s0 = sq * 8192; L = 8192; t0 = s0 + qb * 128; }
            else { const int su = u - 32; head = su >> 1; s0 = TP; L = 16384; t0 = s0 + ((su & 1) * 64 + qb) * 128; }
            a.Q = (const hf*)(ws + OFF_QM) + head * 96; a.qs = 768;
            a.K = (const hf*)(ws + OFF_KN) + head * 64; a.ks = 512;
            a.Kx = (const hf*)(ws + OFF_KR);
            a.Vt = (const hf*)(ws + OFF_VMT) + (size_t)head * 64 * T;
            a.O += 512 + head * 64;
            a.t0 = t0; a.kt0 = s0; a.nkt = L / 64;
            attn_item<96, AT_MLA>(a, smem);
        } else {
            const int i2 = it - 3072, head = i2 & 7, qblk = i2 >> 3, t0 = qblk * 128;
            int s0, L; seq_of(t0, s0, L);
            const int rows = L / 64, R0 = (t0 - s0) / 64;
            int rs0 = R0 - 4; rs0 = rs0 < 0 ? 0 : (rs0 > rows - 8 ? rows - 8 : rs0);
            int rs1 = R0 + 1 - 4; rs1 = rs1 < 0 ? 0 : (rs1 > rows - 8 ? rows - 8 : rs1);
            __syncthreads();
            float* biasL = (float*)(smem + 24576);
            for (int i = tid; i < 465; i += 256) biasL[i] = p.in[3][head * 465 + i] * LOG2E;
            a.Q = (const hf*)(ws + OFF_QA) + head * 64; a.qs = 512;
            a.K = (const hf*)(ws + OFF_KA) + head * 64; a.ks = 512;
            a.Vt = (const hf*)(ws + OFF_VAT) + (size_t)head * 64 * T;
            a.O += head * 64;
            a.t0 = t0; a.kt0 = s0 + 64 * rs0; a.nkt = rs1 + 8 - rs0;
            a.R0 = R0; a.rows = rows; a.kr0 = rs0;
            attn_item<64, AT_NA>(a, smem);
        }
    }
}

__device__ void phase_res(const Params& p, char* smem, const hf* A, int K, const hf* W, bool res_from_input) {
    const float* C = (const float*)smem;
    const int tid = threadIdx.x, cc = tid & 15, rb = tid >> 4;
    for (int tile = blockIdx.x; tile < 384 * 8; tile += gridDim.x) {
        const int tm = tile >> 3, tn = tile & 7, m0 = tm * 128;
        gemm_tile_to_lds(A, K, m0, 0, T - 1, W, K, tn * 128, smem);
#pragma unroll
        for (int i = 0; i < 8; ++i) {
            const int r = rb + 16 * i, t = m0 + r, n = tn * 128 + 8 * cc;
            f4 a, b; ld8(C, r, 8 * cc, a, b);
            float* yp = p.out + (size_t)t * DM + n;
            const float* rp = res_from_input ? (xrow(p, t) + n) : yp;
            const f4 r0 = *(const f4*)rp, r1 = *(const f4*)(rp + 4);
            *(f4*)yp = r0 * ALPHA + a; *(f4*)(yp + 4) = r1 * ALPHA + b;
        }
    }
}

__device__ void phase_ln(const Params& p, const float* g, const float* b, hf* Xh) {
    const int lane = threadIdx.x & 63;
    const int gw = (blockIdx.x * 256 + threadIdx.x) >> 6, nw = gridDim.x * 4;
    f4 gg[4], bb[4];
#pragma unroll
    for (int i = 0; i < 4; ++i) { gg[i] = *(const f4*)(g + i * 256 + lane * 4); bb[i] = *(const f4*)(b + i * 256 + lane * 4); }
    for (int row = gw; row < T; row += nw) {
        float* y = p.out + (size_t)row * DM;
        f4 v[4];
#pragma unroll
        for (int i = 0; i < 4; ++i) v[i] = *(const f4*)(y + i * 256 + lane * 4);
        float s = 0.f;
#pragma unroll
        for (int i = 0; i < 4; ++i) s += v[i][0] + v[i][1] + v[i][2] + v[i][3];
        const float mu = wave_sum(s) * (1.f / 1024.f);
        float q = 0.f;
#pragma unroll
        for (int i = 0; i < 4; ++i) { v[i] = v[i] - mu; q += v[i][0] * v[i][0] + v[i][1] * v[i][1] + v[i][2] * v[i][2] + v[i][3] * v[i][3]; }
        const float rstd = rsqrtf(wave_sum(q) * (1.f / 1024.f) + EPS);
#pragma unroll
        for (int i = 0; i < 4; ++i) {
            const f4 o = v[i] * rstd * gg[i] + bb[i];
            *(f4*)(y + i * 256 + lane * 4) = o;
            if (Xh) { h4 hv; hv[0] = (hf)o[0]; hv[1] = (hf)o[1]; hv[2] = (hf)o[2]; hv[3] = (hf)o[3]; *(h4*)(Xh + (size_t)row * DM + i * 256 + lane * 4) = hv; }
        }
    }
}

DI float gelu_exact(float x) { return 0.5f * x * (1.f + erff(x * 0.70710678118654752f)); }
__device__ void phase_ffn_up(const Params& p, char* smem, const hf* W, const float* cw, const float* cb) {
    const hf* Xh = (const hf*)(p.ws + OFF_XH); hf* U = (hf*)(p.ws + OFF_U);
    const float* C = (const float*)smem;
    const int tid = threadIdx.x, cc = tid & 7, rb = tid >> 3;
    for (int tile = blockIdx.x; tile < 395 * 44; tile += gridDim.x) {
        const int rt = tile / 44, tn = tile % 44;
        int s0, L, ti;
        if (rt < 264) { s0 = (rt / 66) * 8192; L = 8192; ti = rt % 66; } else { s0 = TP; L = 16384; ti = rt - 264; }
        const int pos0 = 126 * ti - 1;
        gemm_tile_to_lds(Xh, DM, s0 + pos0, s0, s0 + L - 1, W, 1024, tn * 128, smem);
#pragma unroll 1
        for (int hh = 0; hh < 2; ++hh) {
            const int lc = 8 * cc + 4 * hh, gc = tn * 64 + lc;
            const f4 wg0 = *(const f4*)(cw + gc), wg1 = *(const f4*)(cw + 5632 + gc), wg2 = *(const f4*)(cw + 2 * 5632 + gc), bg = *(const f4*)(cb + gc);
            const f4 wv0 = *(const f4*)(cw + DFF + gc), wv1 = *(const f4*)(cw + 5632 + DFF + gc), wv2 = *(const f4*)(cw + 2 * 5632 + DFF + gc), bv = *(const f4*)(cb + DFF + gc);
#pragma unroll 1
            for (int i = 0; i < 4; ++i) {
                const int lr = rb + 32 * i, pos = pos0 + lr;
                if (lr >= 1 && lr <= 126 && pos < L) {
                    const float vm = pos - 1 >= 0 ? 1.f : 0.f, vp = pos + 1 < L ? 1.f : 0.f;
                    const f4 g0 = *(const f4*)(C + (lr - 1) * CST + lc), g1 = *(const f4*)(C + lr * CST + lc), g2 = *(const f4*)(C + (lr + 1) * CST + lc);
                    const f4 v0 = *(const f4*)(C + (lr - 1) * CST + 64 + lc), v1 = *(const f4*)(C + lr * CST + 64 + lc), v2 = *(const f4*)(C + (lr + 1) * CST + 64 + lc);
                    const f4 gt = wg0 * g0 * vm + wg1 * g1 + wg2 * g2 * vp + bg;
                    const f4 vl = wv0 * v0 * vm + wv1 * v1 + wv2 * v2 * vp + bv;
                    h4 o;
#pragma unroll
                    for (int j = 0; j < 4; ++j) o[j] = (hf)(gelu_exact(gt[j]) * vl[j]);
                    *(h4*)(U + (size_t)(s0 + pos) * DFF + gc) = o;
                }
            }
        }
    }
}

__device__ void phase_in1(const Params& p, char* smem) {
    char* ws = p.ws;
    const hf* Xh = (const hf*)(ws + OFF_XH); const hf* W = (const hf*)(ws + OFF_WIN1);
    hf* Q1 = (hf*)(ws + OFF_Q1); hf* K1 = (hf*)(ws + OFF_K1); hf* V1t = (hf*)(ws + OFF_V1T);
    const float* rg = (const float*)(ws + OFF_ROPEG);
    const float* C = (const float*)smem;
    const int tid = threadIdx.x, cc = tid & 15, rb = tid >> 4;
    for (int tile = blockIdx.x; tile < 384 * 12; tile += gridDim.x) {
        const int tm = tile / 12, tn = tile % 12, m0 = tm * 128;
        gemm_tile_to_lds(Xh, DM, m0, 0, T - 1, W, 1024, tn * 128, smem);
        if (tn >= 10) { store_transposed<128, false>(C, 0, V1t + (size_t)(tn - 10) * 128 * T, m0); continue; }
        int s0, L; seq_of(m0, s0, L);
        const int cw8 = cc & 7;
        hf* dst = tn < 8 ? Q1 : K1; const int ld = tn < 8 ? 1024 : 256, cbase = (tn < 8 ? tn : tn - 8) * 128;
        const float scale = tn < 8 ? 0.125f * LOG2E : 1.f;
#pragma unroll
        for (int i = 0; i < 8; ++i) {
            const int r = rb + 16 * i, t = m0 + r, pos = t - s0;
            f4 a, b; ld8(C, r, 8 * cc, a, b);
            if (cw8 < 2) {
                f4 pa, pb;
                if (cw8 == 0) ld8(C, r, 8 * cc + 8, pa, pb); else ld8(C, r, 8 * cc - 8, pa, pb);
                const float* cs = rg + (size_t)pos * 16;
                const float sg = cw8 == 0 ? -1.f : 1.f;
#pragma unroll
                for (int j = 0; j < 4; ++j) {
                    a[j] = a[j] * cs[j] + sg * pa[j] * cs[8 + j];
                    b[j] = b[j] * cs[4 + j] + sg * pb[j] * cs[12 + j];
                }
            }
            *(h8*)(dst + (size_t)t * ld + cbase + 8 * cc) = cvt8(a, b, scale);
        }
    }
}

__device__ void phase_attn1(const Params& p, char* smem) {
    char* ws = p.ws;
    for (int it = blockIdx.x; it < 384 * 16; it += gridDim.x) {
        const int hq = it & 15, qblk = it >> 4, t0 = qblk * 128, hkv = hq >> 2;
        int s0, L; seq_of(t0, s0, L);
        const int qpos0 = t0 - s0;
        const int ks = qpos0 - 128 < 0 ? 0 : qpos0 - 128, ke = qpos0 + 256 > L ? L : qpos0 + 256;
        AttnArgs a{};
        a.Q = (const hf*)(ws + OFF_Q1) + hq * 64; a.qs = 1024;
        a.K = (const hf*)(ws + OFF_K1) + hkv * 64; a.ks = 256;
        a.Vt = (const hf*)(ws + OFF_V1T) + (size_t)hkv * 64 * T;
        a.O = (hf*)(ws + OFF_AO) + hq * 64;
        a.t0 = t0; a.kt0 = s0 + ks; a.nkt = (ke - ks) / 64;
        a.qpos0 = qpos0; a.kpos0 = ks; a.sink = p.in[18][hq] * LOG2E;
        attn_item<64, AT_SWA>(a, smem);
    }
}

constexpr int NPHASE = 16;
template <int PH> DI void run_phase(const Params& p, char* smem) {
    char* ws = p.ws;
    if (PH == 0) phase_prep(p);
    else if (PH == 1) phase_in0(p, smem);
    else if (PH == 2) phase_up(p, smem);
    else if (PH == 3) phase_attn0(p, smem);
    else if (PH == 4) phase_res(p, smem, (const hf*)(ws + OFF_AO), 1024, (const hf*)(ws + OFF_WOUT0), true);
    else if (PH == 5) phase_ln(p, p.in[9], p.in[10], (hf*)(ws + OFF_XH));
    else if (PH == 6) phase_ffn_up(p, smem, (const hf*)(ws + OFF_WUP0), p.in[12], p.in[13]);
    else if (PH == 7) phase_res(p, smem, (const hf*)(ws + OFF_U), 2816, (const hf*)(ws + OFF_WDN0), false);
    else if (PH == 8) phase_ln(p, p.in[15], p.in[16], (hf*)(ws + OFF_XH));
    else if (PH == 9) phase_in1(p, smem);
    else if (PH == 10) phase_attn1(p, smem);
    else if (PH == 11) phase_res(p, smem, (const hf*)(ws + OFF_AO), 1024, (const hf*)(ws + OFF_WOUT1), false);
    else if (PH == 12) phase_ln(p, p.in[20], p.in[21], (hf*)(ws + OFF_XH));
    else if (PH == 13) phase_ffn_up(p, smem, (const hf*)(ws + OFF_WUP1), p.in[23], p.in[24]);
    else if (PH == 14) phase_res(p, smem, (const hf*)(ws + OFF_U), 2816, (const hf*)(ws + OFF_WDN1), false);
    else if (PH == 15) phase_ln(p, p.in[26], p.in[27], nullptr);
}

template <int LO, int HI> struct PhaseLoop {
    static DI void run(const Params& p, char* smem) {
        run_phase<LO>(p, smem);
        if (LO + 1 < HI) { cg::this_grid().sync(); PhaseLoop<LO + 1, HI>::run(p, smem); }
    }
};
template <int HI> struct PhaseLoop<HI, HI> { static DI void run(const Params&, char*) {} };

__global__ void __launch_bounds__(256, 2) mega_kernel(Params p) {
    extern __shared__ __attribute__((aligned(16))) char smem[];
    PhaseLoop<0, NPHASE>::run(p, smem);
}
template <int PH> __global__ void __launch_bounds__(256, 2) phase_kernel(Params p) {
    extern __shared__ __attribute__((aligned(16))) char smem[];
    run_phase<PH>(p, smem);
}

template <int PH> static void launch_phases(const Params& p, int grid, hipStream_t stream) {
    static bool attr = false;
    if (!attr) { (void)hipFuncSetAttribute((const void*)phase_kernel<PH>, hipFuncAttributeMaxDynamicSharedMemorySize, LDS_BYTES); attr = true; }
    hipLaunchKernelGGL(phase_kernel<PH>, dim3(grid), dim3(256), LDS_BYTES, stream, p);
    if constexpr (PH + 1 < NPHASE) launch_phases<PH + 1>(p, grid, stream);
}

extern "C" void kernel_launch(void* const* d_in, const int* in_sizes, int n_in, void* d_out, int out_size, void* d_ws, size_t ws_size, hipStream_t stream) {
    static int grid = 0;
    if (grid == 0) {
        if (n_in != 28 || out_size != T * DM || ws_size < WS_END) { fprintf(stderr, "kernel_launch: unexpected shapes (n_in %d out %d ws %zu need %zu)\n", n_in, out_size, ws_size, (size_t)WS_END); grid = -1; return; }
        int dev = 0, cus = 0, per_cu = 0;
        (void)hipGetDevice(&dev);
        (void)hipDeviceGetAttribute(&cus, hipDeviceAttributeMultiprocessorCount, dev);
        if (hipFuncSetAttribute((const void*)mega_kernel, hipFuncAttributeMaxDynamicSharedMemorySize, LDS_BYTES) != hipSuccess) fprintf(stderr, "kernel_launch: hipFuncSetAttribute failed\n");
        if (hipOccupancyMaxActiveBlocksPerMultiprocessor(&per_cu, (const void*)mega_kernel, 256, LDS_BYTES) != hipSuccess || per_cu < 1) { fprintf(stderr, "kernel_launch: occupancy query failed (%d)\n", per_cu); per_cu = 1; }
        if (per_cu > 2) per_cu = 2;
        grid = cus * per_cu;
    }
    if (grid < 0) return;
    Params p{};
    for (int i = 0; i < 28; ++i) p.in[i] = (const float*)d_in[i];
    p.out = (float*)d_out; p.ws = (char*)d_ws;
#if MEGA
    void* args[] = {&p};
    hipError_t e = hipLaunchCooperativeKernel((const void*)mega_kernel, dim3(grid), dim3(256), args, LDS_BYTES, stream);
    if (e != hipSuccess) fprintf(stderr, "cooperative launch failed: %s (grid %d)\n", hipGetErrorString(e), grid);
#else
    launch_phases<0>(p, grid, stream);
#endif
}
```

```cpp
#include <hip/hip_runtime.h>
#include <hip/hip_cooperative_groups.h>
#include <cstdio>
namespace cg = cooperative_groups;

#ifndef PROBE_MASK
#define PROBE_MASK 0x0
#endif
#ifndef PROBE_SYNCS
#define PROBE_SYNCS 0
#endif
#ifndef MEGA
#define MEGA 1
#endif

typedef _Float16 hf;
typedef _Float16 h8 __attribute__((ext_vector_type(8)));
typedef _Float16 h4 __attribute__((ext_vector_type(4)));
typedef float f4 __attribute__((ext_vector_type(4)));
typedef float f16v __attribute__((ext_vector_type(16)));
#define MFMA32(a, b, c) __builtin_amdgcn_mfma_f32_32x32x16_f16((a), (b), (c), 0, 0, 0)
#define MFMA16(a, b, c) __builtin_amdgcn_mfma_f32_16x16x32_f16((a), (b), (c), 0, 0, 0)
#define DI __device__ __forceinline__
#define LAS __attribute__((address_space(3)))

constexpr int NT = 512;
constexpr int T = 49152;
constexpr int TP = 32768;
constexpr int DM = 1024;
constexpr int DFF = 2816;
constexpr float LOG2E = 1.4426950408889634f;
constexpr float ALPHA = 1.4142135623730951f;
constexpr float EPS = 1e-5f;
constexpr float NEG_BIG = -1e30f;

constexpr size_t SZ_WIN0 = (size_t)2304 * 1024 * 2, SZ_WQUP = (size_t)768 * 384 * 2, SZ_WKVUP = (size_t)1024 * 256 * 2,
                 SZ_WOUT = (size_t)1024 * 1024 * 2, SZ_WUP = (size_t)5632 * 1024 * 2, SZ_WDN = (size_t)1024 * 2816 * 2,
                 SZ_WIN1 = (size_t)1536 * 1024 * 2;
constexpr size_t OFF_WIN0 = 0, OFF_WQUP = OFF_WIN0 + SZ_WIN0, OFF_WKVUP = OFF_WQUP + SZ_WQUP, OFF_WOUT0 = OFF_WKVUP + SZ_WKVUP,
                 OFF_WUP0 = OFF_WOUT0 + SZ_WOUT, OFF_WDN0 = OFF_WUP0 + SZ_WUP, OFF_WIN1 = OFF_WDN0 + SZ_WDN, OFF_WOUT1 = OFF_WIN1 + SZ_WIN1,
                 OFF_WUP1 = OFF_WOUT1 + SZ_WOUT, OFF_WDN1 = OFF_WUP1 + SZ_WUP, OFF_ROPEM = OFF_WDN1 + SZ_WDN;
constexpr size_t SZ_ROPEM = (size_t)16384 * 16 * 4 * 2, SZ_ROPEG = (size_t)16384 * 8 * 4 * 2;
constexpr size_t OFF_ROPEG = OFF_ROPEM + SZ_ROPEM, OFF_SS = OFF_ROPEG + SZ_ROPEG, SZ_SS = (size_t)T * 8 * 4;
constexpr size_t OFF_R1 = OFF_SS + SZ_SS, SZ_R1 = (size_t)T * 1024 * 2;
constexpr size_t OFF_R2 = OFF_R1 + SZ_R1, SZ_R2 = (size_t)T * 1024 * 2;
constexpr size_t OFF_R3 = OFF_R2 + SZ_R2, SZ_R3 = (size_t)T * 2816 * 2;
constexpr size_t OFF_BAR = OFF_R3 + SZ_R3;
constexpr size_t WS_END = OFF_BAR + 16384;
constexpr size_t OFF_XH = OFF_R1, OFF_QM = OFF_R1;
constexpr size_t OFF_AO = OFF_R2, OFF_QL = OFF_R2, OFF_KVL = OFF_R2 + (size_t)T * 384 * 2;
constexpr size_t OFF_U = OFF_R3;
constexpr size_t OFF_QA = OFF_R3, OFF_KA = OFF_QA + (size_t)T * 512 * 2, OFF_VAT = OFF_KA + (size_t)T * 512 * 2, OFF_KN = OFF_VAT + (size_t)T * 512 * 2,
                 OFF_VMT = OFF_KN + (size_t)T * 512 * 2, OFF_KR = OFF_VMT + (size_t)T * 512 * 2;
constexpr size_t OFF_Q1 = OFF_R3, OFF_K1 = OFF_Q1 + (size_t)T * 1024 * 2, OFF_V1T = OFF_K1 + (size_t)T * 256 * 2;
static_assert(OFF_KR + (size_t)T * 32 * 2 <= WS_END, "L0 attention buffers overflow R3");
static_assert(OFF_V1T + (size_t)T * 256 * 2 <= WS_END, "L1 attention buffers overflow R3");

constexpr int CST = 132;
constexpr int LDS_BYTES = 256 * CST * 4;
constexpr int LDS_CW = LDS_BYTES + 16;
constexpr int LDS_TOTAL = LDS_CW + 4096;

struct Params {
    const float* in[28];
    float* out;
    char* ws;
};

DI void seq_of(int t, int& s0, int& L) { if (t < TP) { s0 = t & ~8191; L = 8192; } else { s0 = TP; L = 16384; } }
DI const float* xrow(const Params& p, int t) { return t < TP ? p.in[0] + (size_t)t * DM : p.in[1] + (size_t)(t - TP) * DM; }
DI h8 cvt8(f4 a, f4 b, float s) { h8 v; v[0] = (hf)(a[0] * s); v[1] = (hf)(a[1] * s); v[2] = (hf)(a[2] * s); v[3] = (hf)(a[3] * s); v[4] = (hf)(b[0] * s); v[5] = (hf)(b[1] * s); v[6] = (hf)(b[2] * s); v[7] = (hf)(b[3] * s); return v; }
DI int tid_opaque() { int t = threadIdx.x; asm volatile("" : "+v"(t)); return t; }
DI float wave_sum(float v) { v += __shfl_xor(v, 32); v += __shfl_xor(v, 16); v += __shfl_xor(v, 8); v += __shfl_xor(v, 4); v += __shfl_xor(v, 2); v += __shfl_xor(v, 1); return v; }

DI void prep_weight(const float* __restrict__ src, const float* __restrict__ g, hf* __restrict__ dst, int K, int Nsrc, int Npad, int mode, char* smem) {
    hf* tl = (hf*)smem;
    const int tid = tid_opaque(), nn = tid & 63, kq = tid >> 6, on = tid >> 3, oc = tid & 7;
    const int ntn = Npad >> 6, ntk = K >> 6;
    for (int tile = blockIdx.x; tile < ntn * ntk; tile += gridDim.x) {
        const int tn = tile % ntn, tk = tile / ntn, n0 = tn * 64, k0 = tk * 64;
        int c0 = n0;
        if (mode == 1) { const int t = n0 >> 7; c0 = (n0 & 64) ? (DFF + t * 64) : (t * 64); }
        const int col = c0 + nn;
        __syncthreads();
#pragma unroll
        for (int r = 0; r < 8; ++r) {
            const int kk = kq + 8 * r;
            float x = 0.f;
            if (col < Nsrc) { x = src[(size_t)(k0 + kk) * Nsrc + col]; if (g) x *= g[k0 + kk]; }
            tl[nn * 72 + kk] = (hf)x;
        }
        __syncthreads();
        *(h8*)(dst + (size_t)(n0 + on) * K + k0 + oc * 8) = *(const h8*)(tl + on * 72 + oc * 8);
    }
}

__device__ void phase_prep(const Params& p, char* smem) {
    const long gtid = (long)blockIdx.x * NT + tid_opaque(), gs = (long)gridDim.x * NT;
    char* ws = p.ws;
    prep_weight(p.in[2], nullptr, (hf*)(ws + OFF_WIN0), 1024, 2208, 2304, 0, smem);
    prep_weight(p.in[5], p.in[4], (hf*)(ws + OFF_WQUP), 384, 768, 768, 0, smem);
    prep_weight(p.in[7], p.in[6], (hf*)(ws + OFF_WKVUP), 256, 1024, 1024, 0, smem);
    prep_weight(p.in[8], nullptr, (hf*)(ws + OFF_WOUT0), 1024, 1024, 1024, 0, smem);
    prep_weight(p.in[11], nullptr, (hf*)(ws + OFF_WUP0), 1024, 5632, 5632, 1, smem);
    prep_weight(p.in[14], nullptr, (hf*)(ws + OFF_WDN0), 2816, 1024, 1024, 0, smem);
    prep_weight(p.in[17], nullptr, (hf*)(ws + OFF_WIN1), 1024, 1536, 1536, 0, smem);
    prep_weight(p.in[19], nullptr, (hf*)(ws + OFF_WOUT1), 1024, 1024, 1024, 0, smem);
    prep_weight(p.in[22], nullptr, (hf*)(ws + OFF_WUP1), 1024, 5632, 5632, 1, smem);
    prep_weight(p.in[25], nullptr, (hf*)(ws + OFF_WDN1), 2816, 1024, 1024, 0, smem);
    hf* xh = (hf*)(ws + OFF_XH);
    for (long idx = gtid; idx < (long)T * 128; idx += gs) {
        const int t = (int)(idx >> 7), c = (int)(idx & 127) * 8;
        const float* xr = xrow(p, t) + c;
        const f4 a = *(const f4*)xr, b = *(const f4*)(xr + 4);
        *(h8*)(xh + (size_t)t * DM + c) = cvt8(a, b, 1.f);
    }
    float* rm = (float*)(ws + OFF_ROPEM); float* rg = (float*)(ws + OFF_ROPEG);
    for (long idx = gtid; idx < 16384L * 24; idx += gs) {
        const int pos = (int)(idx / 24), i = (int)(idx % 24);
        double inv;
        if (i < 16) inv = exp2(-(double)i / 16.0 * 13.287712379549449);
        else inv = exp2(-(double)(i - 16) / 8.0 * 18.931568569324174);
        const float angf = (float)pos * (float)inv;
        const double ang = (double)angf;
        const float c = (float)cos(ang), s = (float)sin(ang);
        if (i < 16) { rm[(size_t)pos * 32 + i] = c; rm[(size_t)pos * 32 + 16 + i] = s; }
        else { rg[(size_t)pos * 16 + (i - 16)] = c; rg[(size_t)pos * 16 + 8 + (i - 16)] = s; }
    }
}

constexpr int HTB = 128 * 64 * 2;
DI int lds_byte(int r, int c) { const int st = (r >> 4) * 2 + (c >> 5), rr = r & 15, cc = c & 31, ob = rr * 64 + cc * 2; return st * 1024 + (ob ^ (((ob >> 9) & 1) << 5)); }
DI void stage_rc(int b, int& R, int& C) { const int st = b / 1024, sb = b % 1024, swz = sb ^ (((sb >> 9) & 1) << 5); R = (st >> 1) * 16 + swz / 64; C = (st & 1) * 32 + (swz % 64) / 2; }

DI void tile_coords(int L, int nM, int nN, int& pm, int& pn) {
    const int nwg = nM * nN;
    int wgid = L; { const int q = nwg / 8, r = nwg % 8, xcd = wgid % 8, off = wgid / 8; wgid = (xcd < r ? xcd * (q + 1) : r * (q + 1) + (xcd - r) * q) + off; }
    const int nig = 8 * nN, gid = wgid / nig, fm = gid * 8, gsz = (nM - fm) < 8 ? (nM - fm) : 8;
    pm = fm + ((wgid % nig) % gsz); pn = (wgid % nig) / gsz;
}

DI void gemm256(const hf* __restrict__ A, int lda, int arow0, const hf* __restrict__ Bt, int K, int bcol, LAS char* lds, f4 (&acc)[2][2][4][2], const float* cw = nullptr, const float* cb = nullptr, int tn0 = 0) {
    const int tid = tid_opaque(), wid = __builtin_amdgcn_readfirstlane(tid >> 6), lane = tid & 63, wr = wid >> 2, wc = wid & 3, fr = lane & 15, fq = lane >> 4;
    const int nt = K >> 6;
    unsigned offA[2], offB[2];
#pragma unroll
    for (int i = 0; i < 2; ++i) {
        int R, C; stage_rc(tid * 16 + i * 8192, R, C);
        offA[i] = (unsigned)(R * lda + C) * 2u;
        offB[i] = (unsigned)(R * K + C) * 2u;
    }
    const char* Ab = (const char*)(A + (long)arow0 * lda);
    const char* Bb = (const char*)(Bt + (long)bcol * K);
    const size_t hA = (size_t)128 * lda * 2, hB = (size_t)128 * K * 2;
    const unsigned ldsw = (unsigned)wid * 1024u;
    const int aoff = lds_byte(wr * 64 + fr, fq * 8), boff = lds_byte(wc * 32 + fr, fq * 8);
#define SA(b, h) (((b) * 2 + (h)) * HTB)
#define SB(b, h) ((4 + (b) * 2 + (h)) * HTB)
#define STAGE_A(b, h, kt) do { _Pragma("unroll") for (int _i = 0; _i < 2; ++_i) \
        __builtin_amdgcn_global_load_lds((const unsigned*)(Ab + (h) * hA + (size_t)(kt) * 128 + offA[_i]), (LAS unsigned*)(lds + SA(b, h) + ldsw + _i * 8192), 16, 0, 0); } while (0)
#define STAGE_B(b, h, kt) do { _Pragma("unroll") for (int _i = 0; _i < 2; ++_i) \
        __builtin_amdgcn_global_load_lds((const unsigned*)(Bb + (h) * hB + (size_t)(kt) * 128 + offB[_i]), (LAS unsigned*)(lds + SB(b, h) + ldsw + _i * 8192), 16, 0, 0); } while (0)
#define LDA(dst, b, h) do { _Pragma("unroll") for (int m = 0; m < 4; ++m) _Pragma("unroll") for (int k = 0; k < 2; ++k) dst[m][k] = *(const LAS h8*)(lds + SA(b, h) + aoff + m * 2048 + k * 1024); } while (0)
#define LDB(dst, b, h) do { _Pragma("unroll") for (int n = 0; n < 2; ++n) _Pragma("unroll") for (int k = 0; k < 2; ++k) dst[n][k] = *(const LAS h8*)(lds + SB(b, h) + boff + n * 2048 + k * 1024); } while (0)
#define MMA(ai, bj, At_, Bt_) do { __builtin_amdgcn_s_setprio(1); _Pragma("unroll") for (int m = 0; m < 4; ++m) _Pragma("unroll") for (int n = 0; n < 2; ++n) _Pragma("unroll") for (int k = 0; k < 2; ++k) \
        acc[ai][bj][m][n] = MFMA16(At_[m][k], Bt_[n][k], acc[ai][bj][m][n]); __builtin_amdgcn_s_setprio(0); } while (0)
#define WAIT_V(n) asm volatile("s_waitcnt vmcnt(" #n ")" ::: "memory")
#define WAIT_L(n) asm volatile("s_waitcnt lgkmcnt(" #n ")" ::: "memory")
#define BAR __builtin_amdgcn_s_barrier()
#define SCHED __builtin_amdgcn_sched_barrier(0)
#pragma unroll
    for (int a_ = 0; a_ < 2; ++a_)
#pragma unroll
        for (int b_ = 0; b_ < 2; ++b_)
#pragma unroll
            for (int m = 0; m < 4; ++m)
#pragma unroll
                for (int n = 0; n < 2; ++n) acc[a_][b_][m][n] = (f4){0.f, 0.f, 0.f, 0.f};
    h8 At[4][2], B0[2][2], B1[2][2];
    WAIT_V(0);
    __syncthreads();
    STAGE_B(0, 0, 0); STAGE_A(0, 0, 0);
    STAGE_B(0, 1, 0); STAGE_A(0, 1, 0);
    if (cw) {
#pragma unroll
        for (int hh = 0; hh < 2; ++hh) {
            const int which = (tid >> 7) & 3, c = tid & 127, tn = tn0 + hh;
            const int col = c < 64 ? tn * 64 + c : DFF + tn * 64 + (c - 64);
            const float v = which < 3 ? cw[which * 5632 + col] : cb[col];
            *(LAS float*)(lds + LDS_CW + (hh * 512 + tid) * 4) = v;
        }
    }
    if (wr == 1) BAR;
    WAIT_V(4); BAR;
    STAGE_B(1, 0, 1); STAGE_A(1, 0, 1); STAGE_B(1, 1, 1);
    WAIT_V(6); BAR;
    for (int t = 0; t < nt - 2; t += 2) {
        LDB(B0, 0, 0); SCHED; LDA(At, 0, 0); STAGE_A(1, 1, t + 1);
        WAIT_L(8); BAR; WAIT_L(0); MMA(0, 0, At, B0); BAR; SCHED;
        LDB(B1, 0, 1); STAGE_B(0, 0, t + 2);
        BAR; WAIT_L(0); MMA(0, 1, At, B1); BAR;
        LDA(At, 0, 1); STAGE_A(0, 0, t + 2);
        BAR; WAIT_L(0); MMA(1, 0, At, B0); BAR; SCHED;
        STAGE_B(0, 1, t + 2);
        WAIT_V(6); BAR; MMA(1, 1, At, B1); BAR;
        LDB(B0, 1, 0); SCHED; LDA(At, 1, 0); STAGE_A(0, 1, t + 2);
        WAIT_L(8); BAR; WAIT_L(0); MMA(0, 0, At, B0); BAR; SCHED;
        LDB(B1, 1, 1); STAGE_B(1, 0, t + 3);
        BAR; WAIT_L(0); MMA(0, 1, At, B1); BAR;
        LDA(At, 1, 1); STAGE_A(1, 0, t + 3);
        BAR; WAIT_L(0); MMA(1, 0, At, B0); BAR; SCHED;
        STAGE_B(1, 1, t + 3);
        WAIT_V(6); BAR; MMA(1, 1, At, B1); BAR;
    }
    { LDB(B0, 0, 0); LDA(At, 0, 0); STAGE_A(1, 1, nt - 1);
      BAR; WAIT_L(0); MMA(0, 0, At, B0); BAR;
      LDB(B1, 0, 1); BAR; WAIT_L(0); MMA(0, 1, At, B1); BAR;
      LDA(At, 0, 1); WAIT_V(4); BAR; WAIT_L(0); MMA(1, 0, At, B0); MMA(1, 1, At, B1); BAR; }
    { LDB(B0, 1, 0); LDA(At, 1, 0); WAIT_V(2); BAR; WAIT_L(0); MMA(0, 0, At, B0); BAR;
      LDB(B1, 1, 1); WAIT_V(0); BAR; WAIT_L(0); MMA(0, 1, At, B1); BAR;
      LDA(At, 1, 1); BAR; WAIT_L(0); MMA(1, 0, At, B0); MMA(1, 1, At, B1); BAR; }
    if (wr == 0) BAR;
#undef SA
#undef SB
#undef STAGE_A
#undef STAGE_B
#undef LDA
#undef LDB
#undef MMA
}

template <int BJ> DI void stage_half(const f4 (&acc)[2][2][4][2], float* C) {
    __syncthreads();
    const int tid = tid_opaque(), wid = tid >> 6, lane = tid & 63, wr = wid >> 2, wc = wid & 3, fr = lane & 15, fq = lane >> 4;
#pragma unroll
    for (int ai = 0; ai < 2; ++ai)
#pragma unroll
        for (int m = 0; m < 4; ++m)
#pragma unroll
            for (int n = 0; n < 2; ++n)
#pragma unroll
                for (int j = 0; j < 4; ++j) C[(ai * 128 + wr * 64 + m * 16 + fq * 4 + j) * CST + wc * 32 + n * 16 + fr] = acc[ai][BJ][m][n][j];
    __syncthreads();
}

DI void ld8(const float* C, int r, int c, f4& a, f4& b) { a = *(const f4*)(C + r * CST + c); b = *(const f4*)(C + r * CST + c + 4); }

template <int NCOLS, bool RSCALE>
DI void store_transposed(const float* C, int c0, hf* dst  , int tok0) {
    const int tid = tid_opaque();
    const int col = tid % NCOLS, rc0 = tid / NCOLS;
    constexpr int STEP = NT / NCOLS;
#pragma unroll
    for (int rc = rc0; rc < 32; rc += STEP) {
        h8 v;
#pragma unroll
        for (int j = 0; j < 8; ++j) { float x = C[(8 * rc + j) * CST + c0 + col]; if (RSCALE) x *= C[(8 * rc + j) * CST + 128]; v[j] = (hf)x; }
        *(h8*)(dst + (size_t)col * T + tok0 + 8 * rc) = v;
    }
}

DI void epi_in0(const Params& p, const float* C, int m0, int tn) {
    char* ws = p.ws;
    hf* Qa = (hf*)(ws + OFF_QA); hf* Ka = (hf*)(ws + OFF_KA); hf* VaT = (hf*)(ws + OFF_VAT);
    hf* QL = (hf*)(ws + OFF_QL); hf* KVL = (hf*)(ws + OFF_KVL); hf* Kr = (hf*)(ws + OFF_KR);
    float* SS = (float*)(ws + OFF_SS); const float* rm = (const float*)(ws + OFF_ROPEM);
    const int tid = tid_opaque(), cc = tid & 15, rb = tid >> 4;
    if (tn >= 8 && tn < 12) {
        store_transposed<128, false>(C, 0, VaT + (size_t)(tn - 8) * 128 * T, m0);
    } else if (tn == 17) {
        if (cc < 2) {
            int s0, L; seq_of(m0, s0, L);
#pragma unroll
            for (int i = 0; i < 8; ++i) {
                const int r = rb + 32 * i, t = m0 + r, pos = t - s0;
                f4 a0, a1, b0, b1; ld8(C, r, 8 * cc, a0, a1); ld8(C, r, 16 + 8 * cc, b0, b1);
                const float* cs = rm + (size_t)pos * 32 + 8 * cc;
                h8 o1, o2;
#pragma unroll
                for (int j = 0; j < 8; ++j) {
                    const float x1 = j < 4 ? a0[j & 3] : a1[j & 3], x2 = j < 4 ? b0[j & 3] : b1[j & 3];
                    const float c = cs[j], s = cs[16 + j];
                    o1[j] = (hf)(x1 * c - x2 * s); o2[j] = (hf)(x2 * c + x1 * s);
                }
                *(h8*)(Kr + (size_t)t * 32 + 8 * cc) = o1; *(h8*)(Kr + (size_t)t * 32 + 16 + 8 * cc) = o2;
            }
        }
    } else {
        hf* dst; int ld, cbase, ssidx = -1; float scale = 1.f;
        if (tn < 4) { dst = Qa; ld = 512; cbase = tn * 128; scale = 0.125f * LOG2E; }
        else if (tn < 8) { dst = Ka; ld = 512; cbase = (tn - 4) * 128; }
        else if (tn < 15) { dst = QL; ld = 384; cbase = (tn - 12) * 128; ssidx = tn - 12; }
        else { dst = KVL; ld = 256; cbase = (tn - 15) * 128; ssidx = 3 + (tn - 15); }
#pragma unroll
        for (int i = 0; i < 8; ++i) {
            const int r = rb + 32 * i, t = m0 + r;
            f4 a, b; ld8(C, r, 8 * cc, a, b);
            *(h8*)(dst + (size_t)t * ld + cbase + 8 * cc) = cvt8(a, b, scale);
            if (ssidx >= 0) {
                float ss = a[0] * a[0] + a[1] * a[1] + a[2] * a[2] + a[3] * a[3] + b[0] * b[0] + b[1] * b[1] + b[2] * b[2] + b[3] * b[3];
                ss += __shfl_xor(ss, 1); ss += __shfl_xor(ss, 2); ss += __shfl_xor(ss, 4); ss += __shfl_xor(ss, 8);
                if (cc == 0) SS[(size_t)t * 8 + ssidx] = ss;
            }
        }
    }
}

DI void epi_qup(const Params& p, float* C, int m0, int tn) {
    char* ws = p.ws;
    hf* Qm = (hf*)p.out;
    const float* SS = (const float*)(ws + OFF_SS); const float* rm = (const float*)(ws + OFF_ROPEM);
    const int tid = tid_opaque();
    const float QSC = 0.10206207261596575f * LOG2E;
    if (tid < 256) { const float* s = SS + (size_t)(m0 + tid) * 8; C[tid * CST + 128] = rsqrtf((s[0] + s[1] + s[2]) * (1.f / 384.f) + EPS); }
    __syncthreads();
    const int cc = tid & 15, rb = tid >> 4;
    const int n = tn * 128 + 8 * cc, hd = n / 96, w = n - hd * 96;
    int s0, L; seq_of(m0, s0, L);
#pragma unroll
    for (int i = 0; i < 8; ++i) {
        const int r = rb + 32 * i, t = m0 + r, pos = t - s0;
        const float rq = C[r * CST + 128] * QSC;
        f4 a, b; ld8(C, r, 8 * cc, a, b);
        if (w >= 64) {
            const int iw = w - 64;
            f4 pa, pb;
            if (iw < 16) ld8(C, r, 8 * cc + 16, pa, pb); else ld8(C, r, 8 * cc - 16, pa, pb);
            const float* cs = rm + (size_t)pos * 32 + (iw & 15);
            const float sg = iw < 16 ? -1.f : 1.f;
#pragma unroll
            for (int j = 0; j < 4; ++j) {
                a[j] = a[j] * cs[j] + sg * pa[j] * cs[16 + j];
                b[j] = b[j] * cs[4 + j] + sg * pb[j] * cs[20 + j];
            }
        }
        *(h8*)(Qm + (size_t)t * 768 + n) = cvt8(a, b, rq);
    }
}
DI void epi_kvup(const Params& p, float* C, int m0, int tn  ) {
    char* ws = p.ws;
    hf* Kn = (hf*)(ws + OFF_KN); hf* VmT = (hf*)(ws + OFF_VMT);
    const float* SS = (const float*)(ws + OFF_SS);
    const int tid = tid_opaque();
    if (tid < 256) { const float* s = SS + (size_t)(m0 + tid) * 8; C[tid * CST + 128] = rsqrtf((s[3] + s[4]) * (1.f / 256.f) + EPS); }
    __syncthreads();
    const int cc = tid & 7, rb = tid >> 3;
#pragma unroll
    for (int i = 0; i < 4; ++i) {
        const int r = rb + 64 * i, t = m0 + r;
        f4 a, b; ld8(C, r, 8 * cc, a, b);
        *(h8*)(Kn + (size_t)t * 512 + tn * 64 + 8 * cc) = cvt8(a, b, C[r * CST + 128]);
    }
    store_transposed<64, true>(C, 64, VmT + (size_t)tn * 64 * T, m0);
}

DI void epi_res(const Params& p, const float* C, int m0, int tn, bool res_from_input) {
    const int tid = tid_opaque(), cc = tid & 15, rb = tid >> 4;
    hf* Xh = (hf*)(p.ws + OFF_XH);
#pragma unroll
    for (int i = 0; i < 8; ++i) {
        const int r = rb + 32 * i, t = m0 + r, n = tn * 128 + 8 * cc;
        f4 a, b; ld8(C, r, 8 * cc, a, b);
        hf* yp = Xh + (size_t)t * DM + n;
        f4 r0, r1;
        if (res_from_input) { const float* rp = xrow(p, t) + n; r0 = *(const f4*)rp; r1 = *(const f4*)(rp + 4); }
        else { const h8 rv = *(const h8*)yp; r0 = (f4){(float)rv[0], (float)rv[1], (float)rv[2], (float)rv[3]}; r1 = (f4){(float)rv[4], (float)rv[5], (float)rv[6], (float)rv[7]}; }
        *(h8*)yp = cvt8(r0 * ALPHA + a, r1 * ALPHA + b, 1.f);
    }
}

DI float gelu_exact(float v) {
    const float t = __builtin_amdgcn_rcpf(fmaf(fabsf(v), 0.2316418882f, 1.0f));
    float q = fmaf(t, 0.5307027145f, -0.7265760135f); q = fmaf(q, t, 0.7107068705f); q = fmaf(q, t, -0.142248368f); q = fmaf(q, t, 0.127414796f); q *= t;
    const float e = __builtin_amdgcn_exp2f(v * v * -0.72134752044f);
    const float m = v * (q * e);
    return v < 0.f ? m : v - m;
}
DI void epi_ffn(const Params& p, const float* C, int s0, int L, int pos0, int tn, const float* cw, const float* cb) {
    hf* U = (hf*)(p.ws + OFF_U);
    const int tid = tid_opaque(), cc = tid & 7, rb = tid >> 3;
#pragma unroll 1
    for (int hh = 0; hh < 2; ++hh) {
        const int lc = 8 * cc + 4 * hh, gc = tn * 64 + lc;
        const float* st = (const float*)((const char*)C + LDS_CW) + (tn & 1) * 512;
        const f4 wg0 = *(const f4*)(st + lc), wg1 = *(const f4*)(st + 128 + lc), wg2 = *(const f4*)(st + 256 + lc), bg = *(const f4*)(st + 384 + lc);
        const f4 wv0 = *(const f4*)(st + 64 + lc), wv1 = *(const f4*)(st + 128 + 64 + lc), wv2 = *(const f4*)(st + 256 + 64 + lc), bv = *(const f4*)(st + 384 + 64 + lc);
#pragma unroll 1
        for (int i = 0; i < 4; ++i) {
            const int lr = rb + 64 * i, pos = pos0 + lr;
            if (lr >= 1 && lr <= 254 && pos < L) {
                const f4 zero = {0.f, 0.f, 0.f, 0.f};
                const bool hm = pos - 1 >= 0, hp = pos + 1 < L;
                const f4 g0 = hm ? *(const f4*)(C + (lr - 1) * CST + lc) : zero, g1 = *(const f4*)(C + lr * CST + lc), g2 = hp ? *(const f4*)(C + (lr + 1) * CST + lc) : zero;
                const f4 v0 = hm ? *(const f4*)(C + (lr - 1) * CST + 64 + lc) : zero, v1 = *(const f4*)(C + lr * CST + 64 + lc), v2 = hp ? *(const f4*)(C + (lr + 1) * CST + 64 + lc) : zero;
                const f4 gt = wg0 * g0 + wg1 * g1 + wg2 * g2 + bg;
                const f4 vl = wv0 * v0 + wv1 * v1 + wv2 * v2 + bv;
                h4 o;
#pragma unroll
                for (int j = 0; j < 4; ++j) o[j] = (hf)(gelu_exact(gt[j]) * vl[j]);
                *(h4*)(U + (size_t)(s0 + pos) * DFF + gc) = o;
            }
        }
    }
}

DI void epi_in1(const Params& p, const float* C, int m0, int tn) {
    char* ws = p.ws;
    hf* Q1 = (hf*)(ws + OFF_Q1); hf* K1 = (hf*)(ws + OFF_K1); hf* V1t = (hf*)(ws + OFF_V1T);
    const float* rg = (const float*)(ws + OFF_ROPEG);
    const int tid = tid_opaque(), cc = tid & 15, rb = tid >> 4;
    if (tn >= 10) { store_transposed<128, false>(C, 0, V1t + (size_t)(tn - 10) * 128 * T, m0); return; }
    int s0, L; seq_of(m0, s0, L);
    const int cw8 = cc & 7;
    hf* dst = tn < 8 ? Q1 : K1; const int ld = tn < 8 ? 1024 : 256, cbase = (tn < 8 ? tn : tn - 8) * 128;
    const float scale = tn < 8 ? 0.125f * LOG2E : 1.f;
#pragma unroll
    for (int i = 0; i < 8; ++i) {
        const int r = rb + 32 * i, t = m0 + r, pos = t - s0;
        f4 a, b; ld8(C, r, 8 * cc, a, b);
        if (cw8 < 2) {
            f4 pa, pb;
            if (cw8 == 0) ld8(C, r, 8 * cc + 8, pa, pb); else ld8(C, r, 8 * cc - 8, pa, pb);
            const float* cs = rg + (size_t)pos * 16;
            const float sg = cw8 == 0 ? -1.f : 1.f;
#pragma unroll
            for (int j = 0; j < 4; ++j) {
                a[j] = a[j] * cs[j] + sg * pa[j] * cs[8 + j];
                b[j] = b[j] * cs[4 + j] + sg * pb[j] * cs[12 + j];
            }
        }
        *(h8*)(dst + (size_t)t * ld + cbase + 8 * cc) = cvt8(a, b, scale);
    }
}

enum { G_IN0 = 0, G_UP = 1, G_RES_IN = 2, G_RES = 3, G_FFN = 4, G_IN1 = 5 };
template <int KIND, int HALF_> DI void run_epi(const Params& p, float* C, int m0, int pn, bool second, int s0, int L, int pos0, const float* cw, const float* cb) {
    const int tn = pn * 2 + HALF_;
    if (KIND == G_IN0) epi_in0(p, C, m0, tn);
    else if (KIND == G_UP) { if (!second) epi_qup(p, C, m0, tn); else epi_kvup(p, C, m0, tn); }
    else if (KIND == G_RES_IN) epi_res(p, C, m0, tn, true);
    else if (KIND == G_RES) epi_res(p, C, m0, tn, false);
    else if (KIND == G_FFN) epi_ffn(p, C, s0, L, pos0, tn, cw, cb);
    else epi_in1(p, C, m0, tn);
}
template <int KIND>
__device__ void phase_gemm(const Params& p, char* smem, const hf* A, int K, const hf* W, int nN, const float* cw, const float* cb) {
    LAS char* lds = (LAS char*)smem;
    float* C = (float*)smem;
    const int nM = KIND == G_FFN ? 197 : 192;
    const int ntile = KIND == G_UP ? 192 * 7 : nM * nN;
    for (int Lx = blockIdx.x; Lx < ntile; Lx += gridDim.x) {
        int pm, pn; const hf* Ax = A; const hf* Wx = W; int Kx = K; bool second = false;
        if (KIND == G_UP) {
            if (Lx < 192 * 3) tile_coords(Lx, 192, 3, pm, pn);
            else { tile_coords(Lx - 192 * 3, 192, 4, pm, pn); second = true; Ax = (const hf*)(p.ws + OFF_KVL); Wx = (const hf*)(p.ws + OFF_WKVUP); Kx = 256; }
        } else tile_coords(Lx, nM, nN, pm, pn);
        int arow0 = pm * 256, s0 = 0, L = 0, pos0 = 0;
        if (KIND == G_FFN) {
            int ti;
            if (pm < 132) { s0 = (pm / 33) * 8192; L = 8192; ti = pm % 33; } else { s0 = TP; L = 16384; ti = pm - 132; }
            pos0 = 254 * ti - 1; arow0 = s0 + pos0;
        }
        f4 acc[2][2][4][2];
        gemm256(Ax, Kx, arow0, Wx, Kx, pn * 256, lds, acc, KIND == G_FFN ? cw : nullptr, cb, pn * 2);
        const int m0 = pm * 256;
        stage_half<0>(acc, C);
        run_epi<KIND, 0>(p, C, m0, pn, second, s0, L, pos0, cw, cb);
        stage_half<1>(acc, C);
        run_epi<KIND, 1>(p, C, m0, pn, second, s0, L, pos0, cw, cb);
    }
}

enum { AT_MLA = 0, AT_NA = 1, AT_SWA = 2 };
struct AttnArgs {
    const hf* Q; int qs;
    const hf* K; int ks;
    const hf* Kx;
    const hf* Vt;
    hf* O;
    int t0;
    int kt0;
    int nkt;
    int R0, rows, kr0;
    int qpos0, kpos0; float sink;
};

template <int DQK, int MODE>
DI void attn_item(const AttnArgs& a, char* smem) {
    constexpr int KST = DQK + 8, VST = 68, KCH = 64 * DQK / 8;
    constexpr int NKC = (KCH + NT - 1) / NT;
    hf* Ks = (hf*)smem;
    hf* Vs = Ks + 64 * KST;
    const float* biasL = (const float*)(smem + 24576);
    const int tid = tid_opaque(), lane = tid & 63, wave = tid >> 6, ql = lane & 31, h = lane >> 5;
    const int qrow = 32 * wave + ql;
    h8 qf[DQK / 16];
    {
        const hf* qp = a.Q + (size_t)(a.t0 + qrow) * a.qs + 8 * h;
#pragma unroll
        for (int s = 0; s < DQK / 16; ++s) qf[s] = *(const h8*)(qp + 16 * s);
    }
    float m = NEG_BIG, l = 0.f;
    if (MODE == AT_SWA) { m = a.sink; l = (h == 0) ? 1.f : 0.f; }
    f16v o[2];
#pragma unroll
    for (int e = 0; e < 16; ++e) { o[0][e] = 0.f; o[1][e] = 0.f; }
    int qr = 0, qc = 0, rsq = 0, csq = 0;
    if (MODE == AT_NA) {
        qr = a.R0 + (qrow >> 6); qc = qrow & 63;
        rsq = qr - 4; rsq = rsq < 0 ? 0 : (rsq > a.rows - 8 ? a.rows - 8 : rsq);
        csq = qc - 8; csq = csq < 0 ? 0 : (csq > 48 ? 48 : csq);
    }
    const int pq = a.qpos0 + qrow;
    const int pqw = a.qpos0 + 32 * wave;
    h8 rk[NKC], rv;
    auto load_tile = [&](int kt) {
        const int tok0 = a.kt0 + 64 * kt;
#pragma unroll
        for (int i = 0; i < NKC; ++i) {
            const int c = tid + NT * i, row = c / (DQK / 8), kc = c % (DQK / 8);
            if (c < KCH) {
                if (MODE == AT_MLA && kc >= 8) rk[i] = *(const h8*)(a.Kx + (size_t)(tok0 + row) * 32 + (kc - 8) * 8);
                else rk[i] = *(const h8*)(a.K + (size_t)(tok0 + row) * a.ks + kc * 8);
            }
        }
        { const int d = tid >> 3, kc = tid & 7; rv = *(const h8*)(a.Vt + (size_t)d * T + tok0 + kc * 8); }
    };
    load_tile(0);
    for (int kt = 0; kt < a.nkt; ++kt) {
        __syncthreads();
#pragma unroll
        for (int i = 0; i < NKC; ++i) {
            const int c = tid + NT * i, row = c / (DQK / 8), kc = c % (DQK / 8);
            if (c < KCH) *(h8*)(Ks + row * KST + kc * 8) = rk[i];
        }
        {
            const int d = tid >> 3, kc = tid & 7;
            h4 lo, hi; lo[0] = rv[0]; lo[1] = rv[1]; lo[2] = rv[2]; lo[3] = rv[3]; hi[0] = rv[4]; hi[1] = rv[5]; hi[2] = rv[6]; hi[3] = rv[7];
            *(h4*)(Vs + d * VST + kc * 8) = lo; *(h4*)(Vs + d * VST + kc * 8 + 4) = hi;
        }
        __syncthreads();
        if (kt + 1 < a.nkt) load_tile(kt + 1);
        bool active = true;
        if (MODE == AT_NA) { const int kr = a.kr0 + kt; active = (kr >= rsq) && (kr < rsq + 8); }
        if (MODE == AT_SWA) { const int pk0 = a.kpos0 + 64 * kt; active = (pk0 <= pqw + 31 + 128) && (pk0 + 63 >= pqw - 128); }
        if (active) {
            f16v x[2];
#pragma unroll
            for (int i = 0; i < 2; ++i) {
#pragma unroll
                for (int e = 0; e < 16; ++e) x[i][e] = 0.f;
                const hf* kp = Ks + (32 * i + ql) * KST + 8 * h;
#pragma unroll
                for (int s = 0; s < DQK / 16; ++s) { const h8 kf = *(const h8*)(kp + 16 * s); x[i] = MFMA32(kf, qf[s], x[i]); }
            }
            if (MODE == AT_NA) {
                const int kr = a.kr0 + kt;
                const int brow = (kr - qr + 7) * 31;
#pragma unroll
                for (int i = 0; i < 2; ++i)
#pragma unroll
                    for (int e = 0; e < 16; ++e) {
                        const int kcol = 32 * i + (e & 3) + 8 * (e >> 2) + 4 * h;
                        const bool v = (kcol >= csq) && (kcol < csq + 16);
                        const int bi = v ? (brow + kcol - qc + 15) : 0;
                        const float bb = biasL[bi];
                        x[i][e] = v ? (x[i][e] + bb) : NEG_BIG;
                    }
            } else if (MODE == AT_SWA) {
                const int pk0 = a.kpos0 + 64 * kt;
#pragma unroll
                for (int i = 0; i < 2; ++i)
#pragma unroll
                    for (int e = 0; e < 16; ++e) {
                        const int pk = pk0 + 32 * i + (e & 3) + 8 * (e >> 2) + 4 * h;
                        const int dd = pq - pk;
                        const bool v = (dd <= 128) && (dd >= -128);
                        x[i][e] = v ? x[i][e] : NEG_BIG;
                    }
            }
            float mx = x[0][0];
#pragma unroll
            for (int e = 1; e < 16; ++e) mx = fmaxf(mx, x[0][e]);
#pragma unroll
            for (int e = 0; e < 16; ++e) mx = fmaxf(mx, x[1][e]);
            mx = fmaxf(mx, __shfl_xor(mx, 32));
            const float mnew = fmaxf(m, mx);
            const float alpha = __builtin_amdgcn_exp2f(m - mnew);
            m = mnew;
            float ps = 0.f;
#pragma unroll
            for (int i = 0; i < 2; ++i)
#pragma unroll
                for (int e = 0; e < 16; ++e) { const float pv = __builtin_amdgcn_exp2f(x[i][e] - mnew); x[i][e] = pv; ps += pv; }
            l = l * alpha + ps;
#pragma unroll
            for (int e = 0; e < 16; ++e) { o[0][e] *= alpha; o[1][e] *= alpha; }
#pragma unroll
            for (int i = 0; i < 2; ++i)
#pragma unroll
                for (int sp = 0; sp < 2; ++sp) {
                    h8 pf;
#pragma unroll
                    for (int j = 0; j < 8; ++j) pf[j] = (hf)x[i][8 * sp + j];
#pragma unroll
                    for (int dt = 0; dt < 2; ++dt) {
                        const hf* vp = Vs + (32 * dt + ql) * VST + 32 * i + 16 * sp + 4 * h;
                        const h4 v0 = *(const h4*)vp, v1 = *(const h4*)(vp + 8);
                        h8 vf; vf[0] = v0[0]; vf[1] = v0[1]; vf[2] = v0[2]; vf[3] = v0[3]; vf[4] = v1[0]; vf[5] = v1[1]; vf[6] = v1[2]; vf[7] = v1[3];
                        o[dt] = MFMA32(vf, pf, o[dt]);
                    }
                }
        }
    }
    l += __shfl_xor(l, 32);
    const float inv = 1.f / l;
    hf* op = a.O + (size_t)(a.t0 + qrow) * 1024;
#pragma unroll
    for (int dt = 0; dt < 2; ++dt)
#pragma unroll
        for (int g = 0; g < 4; ++g) {
            h4 v; v[0] = (hf)(o[dt][4 * g] * inv); v[1] = (hf)(o[dt][4 * g + 1] * inv); v[2] = (hf)(o[dt][4 * g + 2] * inv); v[3] = (hf)(o[dt][4 * g + 3] * inv);
            *(h4*)(op + 32 * dt + 8 * g + 4 * h) = v;
        }
}


#define SBAR __builtin_amdgcn_sched_barrier(0)
DI void mla_item(const AttnArgs& a, char* smem) {
    constexpr int KROWB = 208, VROWB = 144;
    constexpr int KSLOT = 64 * KROWB, VSLOT = 64 * VROWB, SLOT = KSLOT + VSLOT, NST = 5, DUMP = NST * SLOT;
    LAS char* lds = (LAS char*)smem;
    const int tid = tid_opaque(), lane = tid & 63, wid = __builtin_amdgcn_readfirstlane(tid >> 6), ql = lane & 31, h = lane >> 5;
    const int qrow = 32 * wid + ql;
    h8 qf[6];
    {
        const hf* qp = a.Q + (size_t)(a.t0 + qrow) * a.qs + 8 * h;
#pragma unroll
        for (int s = 0; s < 6; ++s) qf[s] = *(const h8*)(qp + 16 * s);
    }
    float mref = 0.f, l = 0.f;
    f16v o0, o1;
#pragma unroll
    for (int e = 0; e < 16; ++e) { o0[e] = 0.f; o1[e] = 0.f; }
    const hf *kq0, *kq1, *vq0, *vq1; int kst0, kst1;
    {
        int row = tid / 13, kc = tid % 13; if (kc == 12) kc = 0;
        if (kc < 8) { kq0 = a.K + (size_t)row * a.ks + kc * 8; kst0 = a.ks; } else { kq0 = a.Kx + (size_t)row * 32 + (kc - 8) * 8; kst0 = 32; }
        const int p1 = tid + NT < 832 ? tid + NT : tid;
        row = p1 / 13; kc = p1 % 13; if (kc == 12) kc = 0;
        if (kc < 8) { kq1 = a.K + (size_t)row * a.ks + kc * 8; kst1 = a.ks; } else { kq1 = a.Kx + (size_t)row * 32 + (kc - 8) * 8; kst1 = 32; }
        int d = tid / 9, c = tid % 9; if (c == 8) c = 0;
        vq0 = a.Vt + (size_t)d * T + c * 8;
        const int p2 = tid + NT < 576 ? tid + NT : tid;
        d = p2 / 9; c = p2 % 9; if (c == 8) c = 0;
        vq1 = a.Vt + (size_t)d * T + c * 8;
    }
    const unsigned k1dst = wid < 5 ? (unsigned)(8192 + wid * 1024) : 0xffffffffu, v1dst = wid < 1 ? (unsigned)(KSLOT + 8192 + wid * 1024) : 0xffffffffu;
    auto issue = [&](int kt) {
        const int ktc = kt < a.nkt ? kt : a.nkt - 1;
        const size_t tok0 = (size_t)(a.kt0 + 64 * ktc);
        const unsigned sb = (unsigned)((kt % NST) * SLOT), dump = (unsigned)(DUMP + wid * 1024);
        __builtin_amdgcn_global_load_lds((const unsigned*)(kq0 + tok0 * kst0), (LAS unsigned*)(lds + sb + wid * 1024), 16, 0, 0);
        __builtin_amdgcn_global_load_lds((const unsigned*)(kq1 + tok0 * kst1), (LAS unsigned*)(lds + (k1dst != 0xffffffffu ? sb + k1dst : dump)), 16, 0, 0);
        __builtin_amdgcn_global_load_lds((const unsigned*)(vq0 + tok0), (LAS unsigned*)(lds + sb + KSLOT + wid * 1024), 16, 0, 0);
        __builtin_amdgcn_global_load_lds((const unsigned*)(vq1 + tok0), (LAS unsigned*)(lds + (v1dst != 0xffffffffu ? sb + v1dst : dump)), 16, 0, 0);
    };
    asm volatile("s_waitcnt vmcnt(0)" ::: "memory");
    __syncthreads();
    issue(0); issue(1); issue(2); issue(3);
    asm volatile("s_waitcnt vmcnt(8)" ::: "memory");
    __builtin_amdgcn_s_barrier();
    asm volatile("" ::: "memory");
    const int koff = ql * KROWB + 16 * h, voff = KSLOT + ql * VROWB + 8 * h;
#define KFR(slot, i, s) (*(const LAS h8*)(lds + (slot) * SLOT + koff + (i) * 32 * KROWB + 32 * (s)))
#define VLD(dst, slot, dt, i, sp) { const LAS char* vp_ = lds + (slot) * SLOT + voff + (dt) * 32 * VROWB + 64 * (i) + 32 * (sp); const h4 v0_ = *(const LAS h4*)vp_, v1_ = *(const LAS h4*)(vp_ + 16); \
        dst[0] = v0_[0]; dst[1] = v0_[1]; dst[2] = v0_[2]; dst[3] = v0_[3]; dst[4] = v1_[0]; dst[5] = v1_[1]; dst[6] = v1_[2]; dst[7] = v1_[3]; }
#define EX2(x, e, P, j) { const float p0_ = __builtin_amdgcn_exp2f(x[e]); const float p1_ = __builtin_amdgcn_exp2f(x[(e) + 1]); psA += p0_; psB += p1_; P[j] = (hf)p0_; P[(j) + 1] = (hf)p1_; }
    f16v xc0, xc1, xn0, xn1;
    {
#pragma unroll
        for (int e = 0; e < 16; ++e) { xc0[e] = 0.f; xc1[e] = 0.f; }
#pragma unroll
        for (int s = 0; s < 6; ++s) { const h8 kf = KFR(0, 0, s); xc0 = MFMA32(kf, qf[s], xc0); }
#pragma unroll
        for (int s = 0; s < 6; ++s) { const h8 kf = KFR(0, 1, s); xc1 = MFMA32(kf, qf[s], xc1); }
    }
    float tmax;
    {
        float mx = xc0[0];
#pragma unroll
        for (int e = 1; e < 16; ++e) mx = fmaxf(mx, xc0[e]);
#pragma unroll
        for (int e = 0; e < 16; ++e) mx = fmaxf(mx, xc1[e]);
        mx = fmaxf(mx, __shfl_xor(mx, 32));
        mref = mx;
#pragma unroll
        for (int e = 0; e < 16; ++e) { xc0[e] -= mx; xc1[e] -= mx; }
        tmax = 0.f;
    }
    int cb = 0;
    for (int kt = 0; kt + 1 < a.nkt; ++kt) {
        if (__any(tmax > 8.f)) {
            const float delta = tmax > 8.f ? tmax : 0.f;
            mref += delta;
            const float alpha = __builtin_amdgcn_exp2f(-delta);
            l *= alpha;
#pragma unroll
            for (int e = 0; e < 16; ++e) { xc0[e] -= delta; xc1[e] -= delta; o0[e] *= alpha; o1[e] *= alpha; }
        }
        const int nb = cb == NST - 1 ? 0 : cb + 1;
        issue(kt + 4);
        h8 kA0 = KFR(nb, 0, 0), kA1 = KFR(nb, 0, 1), kA2 = KFR(nb, 0, 2), kB0 = KFR(nb, 0, 3), kB1 = KFR(nb, 0, 4), kB2 = KFR(nb, 0, 5);
        const float ini = -mref;
#pragma unroll
        for (int e = 0; e < 16; ++e) { xn0[e] = ini; xn1[e] = ini; }
        float psA = 0.f, psB = 0.f;
        h8 P00, P01, P10, P11, vA0, vA1, vB0, vB1;
        SBAR;
        xn0 = MFMA32(kA0, qf[0], xn0); SBAR; EX2(xc0, 0, P00, 0); SBAR;
        xn0 = MFMA32(kA1, qf[1], xn0); SBAR; EX2(xc0, 2, P00, 2); SBAR;
        xn0 = MFMA32(kA2, qf[2], xn0); SBAR; kA0 = KFR(nb, 1, 0); kA1 = KFR(nb, 1, 1); kA2 = KFR(nb, 1, 2); EX2(xc0, 4, P00, 4); SBAR;
        xn0 = MFMA32(kB0, qf[3], xn0); SBAR; EX2(xc0, 6, P00, 6); SBAR;
        xn0 = MFMA32(kB1, qf[4], xn0); SBAR; EX2(xc0, 8, P01, 0); SBAR;
        xn0 = MFMA32(kB2, qf[5], xn0); SBAR; kB0 = KFR(nb, 1, 3); kB1 = KFR(nb, 1, 4); kB2 = KFR(nb, 1, 5); EX2(xc0, 10, P01, 2); SBAR;
        xn1 = MFMA32(kA0, qf[0], xn1); SBAR; EX2(xc0, 12, P01, 4); SBAR;
        xn1 = MFMA32(kA1, qf[1], xn1); SBAR; EX2(xc0, 14, P01, 6); SBAR;
        xn1 = MFMA32(kA2, qf[2], xn1); SBAR; VLD(vA0, cb, 0, 0, 0); VLD(vA1, cb, 1, 0, 0); EX2(xc1, 0, P10, 0); SBAR;
        xn1 = MFMA32(kB0, qf[3], xn1); SBAR; EX2(xc1, 2, P10, 2); SBAR;
        xn1 = MFMA32(kB1, qf[4], xn1); SBAR; VLD(vB0, cb, 0, 0, 1); VLD(vB1, cb, 1, 0, 1); EX2(xc1, 4, P10, 4); SBAR;
        xn1 = MFMA32(kB2, qf[5], xn1); SBAR; EX2(xc1, 6, P10, 6); SBAR;
        o0 = MFMA32(vA0, P00, o0); SBAR; EX2(xc1, 8, P11, 0); SBAR;
        o1 = MFMA32(vA1, P00, o1); SBAR; VLD(vA0, cb, 0, 1, 0); VLD(vA1, cb, 1, 1, 0); EX2(xc1, 10, P11, 2); SBAR;
        o0 = MFMA32(vB0, P01, o0); SBAR; EX2(xc1, 12, P11, 4); SBAR;
        o1 = MFMA32(vB1, P01, o1); SBAR; VLD(vB0, cb, 0, 1, 1); VLD(vB1, cb, 1, 1, 1); EX2(xc1, 14, P11, 6); SBAR;
        float mx;
        o0 = MFMA32(vA0, P10, o0); SBAR; mx = fmaxf(fmaxf(xn0[0], xn0[1]), xn0[2]); mx = fmaxf(fmaxf(mx, xn0[3]), xn0[4]); mx = fmaxf(fmaxf(mx, xn0[5]), xn0[6]); mx = fmaxf(fmaxf(mx, xn0[7]), xn0[8]); SBAR;
        o1 = MFMA32(vA1, P10, o1); SBAR; mx = fmaxf(fmaxf(mx, xn0[9]), xn0[10]); mx = fmaxf(fmaxf(mx, xn0[11]), xn0[12]); mx = fmaxf(fmaxf(mx, xn0[13]), xn0[14]); mx = fmaxf(fmaxf(mx, xn0[15]), xn1[0]); SBAR;
        o0 = MFMA32(vB0, P11, o0); SBAR; mx = fmaxf(fmaxf(mx, xn1[1]), xn1[2]); mx = fmaxf(fmaxf(mx, xn1[3]), xn1[4]); mx = fmaxf(fmaxf(mx, xn1[5]), xn1[6]); mx = fmaxf(fmaxf(mx, xn1[7]), xn1[8]); SBAR;
        o1 = MFMA32(vB1, P11, o1); SBAR; mx = fmaxf(fmaxf(mx, xn1[9]), xn1[10]); mx = fmaxf(fmaxf(mx, xn1[11]), xn1[12]); mx = fmaxf(fmaxf(mx, xn1[13]), xn1[14]); mx = fmaxf(mx, xn1[15]); SBAR;
        tmax = fmaxf(mx, __shfl_xor(mx, 32));
        l += psA + psB;
        asm volatile("s_waitcnt vmcnt(8)" ::: "memory");
        __builtin_amdgcn_s_barrier();
        asm volatile("" ::: "memory");
        xc0 = xn0; xc1 = xn1; cb = nb;
    }
    {
        if (__any(tmax > 8.f)) {
            const float delta = tmax > 8.f ? tmax : 0.f;
            mref += delta;
            const float alpha = __builtin_amdgcn_exp2f(-delta);
            l *= alpha;
#pragma unroll
            for (int e = 0; e < 16; ++e) { xc0[e] -= delta; xc1[e] -= delta; o0[e] *= alpha; o1[e] *= alpha; }
        }
        float psA = 0.f, psB = 0.f;
        h8 P00, P01, P10, P11, vA0, vA1;
        EX2(xc0, 0, P00, 0); EX2(xc0, 2, P00, 2); EX2(xc0, 4, P00, 4); EX2(xc0, 6, P00, 6);
        EX2(xc0, 8, P01, 0); EX2(xc0, 10, P01, 2); EX2(xc0, 12, P01, 4); EX2(xc0, 14, P01, 6);
        EX2(xc1, 0, P10, 0); EX2(xc1, 2, P10, 2); EX2(xc1, 4, P10, 4); EX2(xc1, 6, P10, 6);
        EX2(xc1, 8, P11, 0); EX2(xc1, 10, P11, 2); EX2(xc1, 12, P11, 4); EX2(xc1, 14, P11, 6);
        l += psA + psB;
        VLD(vA0, cb, 0, 0, 0); VLD(vA1, cb, 1, 0, 0); o0 = MFMA32(vA0, P00, o0); o1 = MFMA32(vA1, P00, o1);
        VLD(vA0, cb, 0, 0, 1); VLD(vA1, cb, 1, 0, 1); o0 = MFMA32(vA0, P01, o0); o1 = MFMA32(vA1, P01, o1);
        VLD(vA0, cb, 0, 1, 0); VLD(vA1, cb, 1, 1, 0); o0 = MFMA32(vA0, P10, o0); o1 = MFMA32(vA1, P10, o1);
        VLD(vA0, cb, 0, 1, 1); VLD(vA1, cb, 1, 1, 1); o0 = MFMA32(vA0, P11, o0); o1 = MFMA32(vA1, P11, o1);
    }
#undef KFR
#undef VLD
#undef EX2
    asm volatile("s_waitcnt vmcnt(0)" ::: "memory");
    l += __shfl_xor(l, 32);
    const float inv = 1.f / l;
    hf* op = a.O + (size_t)(a.t0 + qrow) * 1024;
#pragma unroll
    for (int g = 0; g < 4; ++g) {
        h4 v; v[0] = (hf)(o0[4 * g] * inv); v[1] = (hf)(o0[4 * g + 1] * inv); v[2] = (hf)(o0[4 * g + 2] * inv); v[3] = (hf)(o0[4 * g + 3] * inv);
        *(h4*)(op + 8 * g + 4 * h) = v;
        h4 w; w[0] = (hf)(o1[4 * g] * inv); w[1] = (hf)(o1[4 * g + 1] * inv); w[2] = (hf)(o1[4 * g + 2] * inv); w[3] = (hf)(o1[4 * g + 3] * inv);
        *(h4*)(op + 32 + 8 * g + 4 * h) = w;
    }
}

DI void mla_item64(const AttnArgs& a, char* smem) {
    constexpr int KROWB = 208, VROWB = 144;
    constexpr int KSLOT = 64 * KROWB, VSLOT = 64 * VROWB, SLOT = KSLOT + VSLOT, NST = 5, DUMP = NST * SLOT;
    LAS char* lds = (LAS char*)smem;
    const int tid = tid_opaque(), lane = tid & 63, wid = __builtin_amdgcn_readfirstlane(tid >> 6), ql = lane & 31, h = lane >> 5;
    const int rowA = 64 * wid + ql, rowB = rowA + 32;
    h8 qA[6], qB[6];
    {
        const hf* qp = a.Q + (size_t)(a.t0 + rowA) * a.qs + 8 * h;
#pragma unroll
        for (int s = 0; s < 6; ++s) { qA[s] = *(const h8*)(qp + 16 * s); qB[s] = *(const h8*)(qp + (size_t)32 * a.qs + 16 * s); }
    }
    float mA = NEG_BIG, lA = 0.f, mB = NEG_BIG, lB = 0.f;
    f16v oA0, oA1, oB0, oB1;
#pragma unroll
    for (int e = 0; e < 16; ++e) { oA0[e] = 0.f; oA1[e] = 0.f; oB0[e] = 0.f; oB1[e] = 0.f; }
    const hf *kq0, *kq1, *vq0, *vq1; int kst0, kst1;
    {
        int row = tid / 13, kc = tid % 13; if (kc == 12) kc = 0;
        if (kc < 8) { kq0 = a.K + (size_t)row * a.ks + kc * 8; kst0 = a.ks; } else { kq0 = a.Kx + (size_t)row * 32 + (kc - 8) * 8; kst0 = 32; }
        const int p1 = tid + NT < 832 ? tid + NT : tid;
        row = p1 / 13; kc = p1 % 13; if (kc == 12) kc = 0;
        if (kc < 8) { kq1 = a.K + (size_t)row * a.ks + kc * 8; kst1 = a.ks; } else { kq1 = a.Kx + (size_t)row * 32 + (kc - 8) * 8; kst1 = 32; }
        int d = tid / 9, c = tid % 9; if (c == 8) c = 0;
        vq0 = a.Vt + (size_t)d * T + c * 8;
        const int p2 = tid + NT < 576 ? tid + NT : tid;
        d = p2 / 9; c = p2 % 9; if (c == 8) c = 0;
        vq1 = a.Vt + (size_t)d * T + c * 8;
    }
    const unsigned k1dst = wid < 5 ? (unsigned)(8192 + wid * 1024) : 0xffffffffu, v1dst = wid < 1 ? (unsigned)(KSLOT + 8192 + wid * 1024) : 0xffffffffu;
    auto issue = [&](int kt) {
        const int ktc = kt < a.nkt ? kt : a.nkt - 1;
        const size_t tok0 = (size_t)(a.kt0 + 64 * ktc);
        const unsigned sb = (unsigned)((kt % NST) * SLOT), dump = (unsigned)(DUMP + wid * 1024);
        __builtin_amdgcn_global_load_lds((const unsigned*)(kq0 + tok0 * kst0), (LAS unsigned*)(lds + sb + wid * 1024), 16, 0, 0);
        __builtin_amdgcn_global_load_lds((const unsigned*)(kq1 + tok0 * kst1), (LAS unsigned*)(lds + (k1dst != 0xffffffffu ? sb + k1dst : dump)), 16, 0, 0);
        __builtin_amdgcn_global_load_lds((const unsigned*)(vq0 + tok0), (LAS unsigned*)(lds + sb + KSLOT + wid * 1024), 16, 0, 0);
        __builtin_amdgcn_global_load_lds((const unsigned*)(vq1 + tok0), (LAS unsigned*)(lds + (v1dst != 0xffffffffu ? sb + v1dst : dump)), 16, 0, 0);
    };
#pragma unroll
    for (int s = 0; s < 6; ++s) asm volatile("" :: "v"(qA[s]), "v"(qB[s]));
    asm volatile("s_waitcnt vmcnt(0)" ::: "memory");
    __syncthreads();
    issue(0); issue(1); issue(2); issue(3);
    asm volatile("s_waitcnt vmcnt(12)" ::: "memory");
    __builtin_amdgcn_s_barrier();
    asm volatile("" ::: "memory");
    const int koff = ql * KROWB + 16 * h, voff = KSLOT + ql * VROWB + 8 * h;
    int cb = 0;
    for (int kt = 0; kt < a.nkt; ++kt) {
        issue(kt + 4);
        const LAS char* kb = lds + cb * SLOT + koff;
        const LAS char* vb = lds + cb * SLOT + voff;
        f16v xA0, xA1, xB0, xB1;
#pragma unroll
        for (int e = 0; e < 16; ++e) { xA0[e] = 0.f; xA1[e] = 0.f; xB0[e] = 0.f; xB1[e] = 0.f; }
        h8 k0 = *(const LAS h8*)kb, k1 = *(const LAS h8*)(kb + 32 * KROWB);
#pragma unroll
        for (int s = 0; s < 6; ++s) {
            h8 n0 = k0, n1 = k1;
            if (s < 5) { n0 = *(const LAS h8*)(kb + 32 * (s + 1)); n1 = *(const LAS h8*)(kb + 32 * KROWB + 32 * (s + 1)); }
            xA0 = MFMA32(k0, qA[s], xA0); xB0 = MFMA32(k0, qB[s], xB0);
            xA1 = MFMA32(k1, qA[s], xA1); xB1 = MFMA32(k1, qB[s], xB1);
            k0 = n0; k1 = n1;
        }
        float alA, alB;
        {
            float mx = xA0[0];
#pragma unroll
            for (int e = 1; e < 16; ++e) mx = fmaxf(mx, xA0[e]);
#pragma unroll
            for (int e = 0; e < 16; ++e) mx = fmaxf(mx, xA1[e]);
            mx = fmaxf(mx, __shfl_xor(mx, 32));
            const float mn = fmaxf(mA, mx); alA = __builtin_amdgcn_exp2f(mA - mn); mA = mn;
            float ps = 0.f;
#pragma unroll
            for (int e = 0; e < 16; ++e) { const float p0 = __builtin_amdgcn_exp2f(xA0[e] - mn); xA0[e] = p0; const float p1 = __builtin_amdgcn_exp2f(xA1[e] - mn); xA1[e] = p1; ps += p0 + p1; }
            lA = lA * alA + ps;
#pragma unroll
            for (int e = 0; e < 16; ++e) { oA0[e] *= alA; oA1[e] *= alA; }
        }
        {
            float mx = xB0[0];
#pragma unroll
            for (int e = 1; e < 16; ++e) mx = fmaxf(mx, xB0[e]);
#pragma unroll
            for (int e = 0; e < 16; ++e) mx = fmaxf(mx, xB1[e]);
            mx = fmaxf(mx, __shfl_xor(mx, 32));
            const float mn = fmaxf(mB, mx); alB = __builtin_amdgcn_exp2f(mB - mn); mB = mn;
            float ps = 0.f;
#pragma unroll
            for (int e = 0; e < 16; ++e) { const float p0 = __builtin_amdgcn_exp2f(xB0[e] - mn); xB0[e] = p0; const float p1 = __builtin_amdgcn_exp2f(xB1[e] - mn); xB1[e] = p1; ps += p0 + p1; }
            lB = lB * alB + ps;
#pragma unroll
            for (int e = 0; e < 16; ++e) { oB0[e] *= alB; oB1[e] *= alB; }
        }
#pragma unroll
        for (int i = 0; i < 2; ++i)
#pragma unroll
            for (int sp = 0; sp < 2; ++sp) {
                h8 pA, pB;
#pragma unroll
                for (int j = 0; j < 8; ++j) { pA[j] = (hf)(i == 0 ? xA0[8 * sp + j] : xA1[8 * sp + j]); pB[j] = (hf)(i == 0 ? xB0[8 * sp + j] : xB1[8 * sp + j]); }
#pragma unroll
                for (int dt = 0; dt < 2; ++dt) {
                    const LAS char* vp = vb + dt * 32 * VROWB + 64 * i + 32 * sp;
                    const h4 v0 = *(const LAS h4*)vp, v1 = *(const LAS h4*)(vp + 16);
                    h8 vf; vf[0] = v0[0]; vf[1] = v0[1]; vf[2] = v0[2]; vf[3] = v0[3]; vf[4] = v1[0]; vf[5] = v1[1]; vf[6] = v1[2]; vf[7] = v1[3];
                    if (dt == 0) { oA0 = MFMA32(vf, pA, oA0); oB0 = MFMA32(vf, pB, oB0); } else { oA1 = MFMA32(vf, pA, oA1); oB1 = MFMA32(vf, pB, oB1); }
                }
            }
        asm volatile("s_waitcnt vmcnt(12)" ::: "memory");
        __builtin_amdgcn_s_barrier();
        asm volatile("" ::: "memory");
        cb = cb == NST - 1 ? 0 : cb + 1;
    }
    asm volatile("s_waitcnt vmcnt(0)" ::: "memory");
    lA += __shfl_xor(lA, 32); lB += __shfl_xor(lB, 32);
    const float ia = 1.f / lA, ib = 1.f / lB;
    hf* opA = a.O + (size_t)(a.t0 + rowA) * 1024; hf* opB = opA + (size_t)32 * 1024;
#pragma unroll
    for (int g = 0; g < 4; ++g) {
        h4 v;
        v[0] = (hf)(oA0[4 * g] * ia); v[1] = (hf)(oA0[4 * g + 1] * ia); v[2] = (hf)(oA0[4 * g + 2] * ia); v[3] = (hf)(oA0[4 * g + 3] * ia); *(h4*)(opA + 8 * g + 4 * h) = v;
        v[0] = (hf)(oA1[4 * g] * ia); v[1] = (hf)(oA1[4 * g + 1] * ia); v[2] = (hf)(oA1[4 * g + 2] * ia); v[3] = (hf)(oA1[4 * g + 3] * ia); *(h4*)(opA + 32 + 8 * g + 4 * h) = v;
        v[0] = (hf)(oB0[4 * g] * ib); v[1] = (hf)(oB0[4 * g + 1] * ib); v[2] = (hf)(oB0[4 * g + 2] * ib); v[3] = (hf)(oB0[4 * g + 3] * ib); *(h4*)(opB + 8 * g + 4 * h) = v;
        v[0] = (hf)(oB1[4 * g] * ib); v[1] = (hf)(oB1[4 * g + 1] * ib); v[2] = (hf)(oB1[4 * g + 2] * ib); v[3] = (hf)(oB1[4 * g + 3] * ib); *(h4*)(opB + 32 + 8 * g + 4 * h) = v;
    }
}

__device__ void phase_attn0(const Params& p, char* smem) {
    char* ws = p.ws;
    const int tid = tid_opaque();
    for (int it = blockIdx.x; it < 768 + 1536; it += gridDim.x) {
        AttnArgs a{};
        a.O = (hf*)(ws + OFF_AO);
        if (it < 768) {
            int head, s0, L, t0;
            if (it < 512) { const int u = (it & 7) + 8 * (it >> 7), qb = (it >> 3) & 15; const int sq = u >> 3; head = u & 7; s0 = sq * 8192; L = 8192; t0 = s0 + qb * 512; }
            else { const int j = it - 512; head = j & 7; s0 = TP; L = 16384; t0 = s0 + (j >> 3) * 512; }
            a.Q = (const hf*)p.out + head * 96; a.qs = 768;
            a.K = (const hf*)(ws + OFF_KN) + head * 64; a.ks = 512;
            a.Kx = (const hf*)(ws + OFF_KR);
            a.Vt = (const hf*)(ws + OFF_VMT) + (size_t)head * 64 * T;
            a.O += 512 + head * 64;
            a.t0 = t0; a.kt0 = s0; a.nkt = L / 64;
            mla_item64(a, smem);
        } else {
            const int i2 = it - 768, head = i2 & 7, qblk = i2 >> 3, t0 = qblk * 256;
            int s0, L; seq_of(t0, s0, L);
            const int rows = L / 64, R0 = (t0 - s0) / 64;
            int rs0 = R0 - 4; rs0 = rs0 < 0 ? 0 : (rs0 > rows - 8 ? rows - 8 : rs0);
            int rs1 = R0 + 3 - 4; rs1 = rs1 < 0 ? 0 : (rs1 > rows - 8 ? rows - 8 : rs1);
            __syncthreads();
            float* biasL = (float*)(smem + 24576);
            for (int i = tid; i < 465; i += NT) biasL[i] = p.in[3][head * 465 + i] * LOG2E;
            a.Q = (const hf*)(ws + OFF_QA) + head * 64; a.qs = 512;
            a.K = (const hf*)(ws + OFF_KA) + head * 64; a.ks = 512;
            a.Vt = (const hf*)(ws + OFF_VAT) + (size_t)head * 64 * T;
            a.O += head * 64;
            a.t0 = t0; a.kt0 = s0 + 64 * rs0; a.nkt = rs1 + 8 - rs0;
            a.R0 = R0; a.rows = rows; a.kr0 = rs0;
            attn_item<64, AT_NA>(a, smem);
        }
    }
}

__device__ void phase_attn1(const Params& p, char* smem) {
    char* ws = p.ws;
    for (int it = blockIdx.x; it < 192 * 16; it += gridDim.x) {
        const int hq = it & 15, qblk = it >> 4, t0 = qblk * 256, hkv = hq >> 2;
        int s0, L; seq_of(t0, s0, L);
        const int qpos0 = t0 - s0;
        const int ks = qpos0 - 128 < 0 ? 0 : qpos0 - 128, ke = qpos0 + 384 > L ? L : qpos0 + 384;
        AttnArgs a{};
        a.Q = (const hf*)(ws + OFF_Q1) + hq * 64; a.qs = 1024;
        a.K = (const hf*)(ws + OFF_K1) + hkv * 64; a.ks = 256;
        a.Vt = (const hf*)(ws + OFF_V1T) + (size_t)hkv * 64 * T;
        a.O = (hf*)(ws + OFF_AO) + hq * 64;
        a.t0 = t0; a.kt0 = s0 + ks; a.nkt = (ke - ks) / 64;
        a.qpos0 = qpos0; a.kpos0 = ks; a.sink = p.in[18][hq] * LOG2E;
        attn_item<64, AT_SWA>(a, smem);
    }
}

__device__ void phase_ln(const Params& p, const float* g, const float* b, bool last) {
    const int lane = tid_opaque() & 63;
    const int gw = (blockIdx.x * NT + tid_opaque()) >> 6, nw = gridDim.x * (NT / 64);
    hf* Xh = (hf*)(p.ws + OFF_XH);
    f4 gg[4], bb[4];
#pragma unroll
    for (int i = 0; i < 2; ++i) { gg[2 * i] = *(const f4*)(g + i * 512 + lane * 8); gg[2 * i + 1] = *(const f4*)(g + i * 512 + lane * 8 + 4); bb[2 * i] = *(const f4*)(b + i * 512 + lane * 8); bb[2 * i + 1] = *(const f4*)(b + i * 512 + lane * 8 + 4); }
    for (int row = gw; row < T; row += nw) {
        hf* y = Xh + (size_t)row * DM;
        f4 v[4];
#pragma unroll
        for (int i = 0; i < 2; ++i) {
            const h8 hv = *(const h8*)(y + i * 512 + lane * 8);
            v[2 * i] = (f4){(float)hv[0], (float)hv[1], (float)hv[2], (float)hv[3]}; v[2 * i + 1] = (f4){(float)hv[4], (float)hv[5], (float)hv[6], (float)hv[7]};
        }
        float s = 0.f;
#pragma unroll
        for (int i = 0; i < 4; ++i) s += v[i][0] + v[i][1] + v[i][2] + v[i][3];
        const float mu = wave_sum(s) * (1.f / 1024.f);
        float q = 0.f;
#pragma unroll
        for (int i = 0; i < 4; ++i) { v[i] = v[i] - mu; q += v[i][0] * v[i][0] + v[i][1] * v[i][1] + v[i][2] * v[i][2] + v[i][3] * v[i][3]; }
        const float rstd = rsqrtf(wave_sum(q) * (1.f / 1024.f) + EPS);
#pragma unroll
        for (int i = 0; i < 2; ++i) {
            const f4 o0 = v[2 * i] * rstd * gg[2 * i] + bb[2 * i], o1 = v[2 * i + 1] * rstd * gg[2 * i + 1] + bb[2 * i + 1];
            if (last) { float* op = p.out + (size_t)row * DM + i * 512 + lane * 8; *(f4*)op = o0; *(f4*)(op + 4) = o1; }
            else *(h8*)(y + i * 512 + lane * 8) = cvt8(o0, o1, 1.f);
        }
    }
}


#define XB_TMO      128
#define XB_XCNT(j)  (256  + 64 * (j))
#define XB_XSUB(j)  (1280 + 64 * (j))
#define XB_XGEN(j)  (2304 + 64 * (j))
#define XB_TOP      3328
#define XB_TOPGEN   3392
#define XCD_BAR_WORDS 3456
#define XB_SPIN_CAP (1u << 18)
DI unsigned xb_ld(unsigned* p)              { return __hip_atomic_load(p, __ATOMIC_RELAXED, __HIP_MEMORY_SCOPE_AGENT); }
DI unsigned xb_add(unsigned* p, unsigned v) { return __hip_atomic_fetch_add(p, v, __ATOMIC_RELAXED, __HIP_MEMORY_SCOPE_AGENT); }
DI unsigned xb_xcc_id() { return (unsigned)__builtin_amdgcn_s_getreg((3 << 11) | 20) & 0xFu; }
#define XB_SPIN(cond, bar) do { unsigned _sp = 0; while (cond) { __builtin_amdgcn_s_sleep(1); \
    if ((++_sp & 255u) == 0u) { if (xb_ld(&(bar)[XB_TMO])) break; if (_sp > XB_SPIN_CAP) { atomicAdd(&(bar)[XB_TMO], 1u); break; } } } } while (0)
struct XcdBarrier { unsigned* bar; unsigned x; volatile LAS unsigned* st; };
DI XcdBarrier xcd_barrier_post(unsigned* bar, volatile LAS unsigned* st) {
    XcdBarrier b; b.bar = bar; b.x = xb_xcc_id(); b.st = st;
    if (threadIdx.x == 0) (void)xb_add(&bar[XB_XCNT(b.x)], 1u);
    return b;
}
DI void xcd_barrier_complete(unsigned* bar, unsigned x, unsigned& nloc, unsigned& nx) {
    const unsigned G = gridDim.x * gridDim.y * gridDim.z;
    unsigned sum, cnt, mine, sp = 0u;
    for (;;) {
        sum = 0u; cnt = 0u; mine = 0u;
#pragma unroll
        for (unsigned j = 0; j < 16; ++j) { const unsigned c = xb_ld(&bar[XB_XCNT(j)]); sum += c; cnt += (c > 0u) ? 1u : 0u; mine = (j == x) ? c : mine; }
        if (sum == G) break;
        __builtin_amdgcn_s_sleep(1);
        if ((++sp & 255u) == 0u) { if (xb_ld(&bar[XB_TMO])) break; if (sp > XB_SPIN_CAP) { atomicAdd(&bar[XB_TMO], 1u); break; } }
    }
    nloc = mine > 0u ? mine : 1u; nx = cnt > 0u ? cnt : 1u;
}
DI void xcd_barrier(const XcdBarrier& b) {
    asm volatile("s_waitcnt vmcnt(0)" ::: "memory");
    __syncthreads();
    if (threadIdx.x == 0) {
        unsigned* bar = b.bar;
        __builtin_amdgcn_s_waitcnt(0);
        unsigned nloc = b.st[0], nx = b.st[1];
        if (nloc == 0u) { xcd_barrier_complete(bar, b.x, nloc, nx); b.st[0] = nloc; b.st[1] = nx; }
        const unsigned old = xb_add(&bar[XB_XSUB(b.x)], 1u);
        const unsigned gen = old / nloc;
        if (old + 1u == (gen + 1u) * nloc) {
            __builtin_amdgcn_fence(__ATOMIC_RELEASE, "agent");
            asm volatile("s_waitcnt vmcnt(0)" ::: "memory");
            const unsigned og = xb_add(&bar[XB_TOP], 1u);
            const unsigned tg = og / nx;
            if (og + 1u == (tg + 1u) * nx) xb_add(&bar[XB_TOPGEN], 1u);
            else XB_SPIN(xb_ld(&bar[XB_TOPGEN]) == tg, bar);
            __builtin_amdgcn_fence(__ATOMIC_ACQUIRE, "agent");
            xb_add(&bar[XB_XGEN(b.x)], 1u);
            asm volatile("s_waitcnt vmcnt(0)" ::: "memory");
        } else {
            XB_SPIN(xb_ld(&bar[XB_XGEN(b.x)]) == gen, bar);
            __builtin_amdgcn_fence(__ATOMIC_ACQUIRE, "agent");
            asm volatile("s_waitcnt vmcnt(0)" ::: "memory");
        }
    }
    __syncthreads();
}

constexpr int NPHASE = 16;
template <int PH> DI void run_phase(const Params& p, char* smem) {
    char* ws = p.ws;
    if (PH == 0) phase_prep(p, smem);
    else if (PH == 1) phase_gemm<G_IN0>(p, smem, (const hf*)(ws + OFF_XH), 1024, (const hf*)(ws + OFF_WIN0), 9, nullptr, nullptr);
    else if (PH == 2) phase_gemm<G_UP>(p, smem, (const hf*)(ws + OFF_QL), 384, (const hf*)(ws + OFF_WQUP), 3, nullptr, nullptr);
    else if (PH == 3) phase_attn0(p, smem);
    else if (PH == 4) phase_gemm<G_RES>(p, smem, (const hf*)(ws + OFF_AO), 1024, (const hf*)(ws + OFF_WOUT0), 4, nullptr, nullptr);
    else if (PH == 5) phase_ln(p, p.in[9], p.in[10], false);
    else if (PH == 6) phase_gemm<G_FFN>(p, smem, (const hf*)(ws + OFF_XH), 1024, (const hf*)(ws + OFF_WUP0), 22, p.in[12], p.in[13]);
    else if (PH == 7) phase_gemm<G_RES>(p, smem, (const hf*)(ws + OFF_U), 2816, (const hf*)(ws + OFF_WDN0), 4, nullptr, nullptr);
    else if (PH == 8) phase_ln(p, p.in[15], p.in[16], false);
    else if (PH == 9) phase_gemm<G_IN1>(p, smem, (const hf*)(ws + OFF_XH), 1024, (const hf*)(ws + OFF_WIN1), 6, nullptr, nullptr);
    else if (PH == 10) phase_attn1(p, smem);
    else if (PH == 11) phase_gemm<G_RES>(p, smem, (const hf*)(ws + OFF_AO), 1024, (const hf*)(ws + OFF_WOUT1), 4, nullptr, nullptr);
    else if (PH == 12) phase_ln(p, p.in[20], p.in[21], false);
    else if (PH == 13) phase_gemm<G_FFN>(p, smem, (const hf*)(ws + OFF_XH), 1024, (const hf*)(ws + OFF_WUP1), 22, p.in[23], p.in[24]);
    else if (PH == 14) phase_gemm<G_RES>(p, smem, (const hf*)(ws + OFF_U), 2816, (const hf*)(ws + OFF_WDN1), 4, nullptr, nullptr);
    else if (PH == 15) phase_ln(p, p.in[26], p.in[27], true);
}

template <int LO, int HI> struct PhaseLoop {
    static DI void run(const Params& p, char* smem, const XcdBarrier& xb) {
        for (int r = 0; r < ((PROBE_MASK >> LO) & 1) + 1; ++r) run_phase<LO>(p, smem);
        if (LO + 1 < HI) {
            if (LO == 0) cg::this_grid().sync(); else xcd_barrier(xb);
            for (int r = 0; r < PROBE_SYNCS; ++r) xcd_barrier(xb);
            PhaseLoop<LO + 1, HI>::run(p, smem, xb);
        }
    }
};
template <int HI> struct PhaseLoop<HI, HI> { static DI void run(const Params&, char*, const XcdBarrier&) {} };

__global__ void __launch_bounds__(NT) mega_kernel(Params p) {
    extern __shared__ __attribute__((aligned(16))) char smem[];
    volatile LAS unsigned* st = (volatile LAS unsigned*)(LAS char*)(smem + LDS_BYTES);
    if (threadIdx.x == 0) { st[0] = 0u; st[1] = 0u; }
    __syncthreads();
    const XcdBarrier xb = xcd_barrier_post((unsigned*)(p.ws + OFF_BAR), st);
    PhaseLoop<0, NPHASE>::run(p, smem, xb);
}
extern "C" void kernel_launch(void* const* d_in, const int* in_sizes, int n_in, void* d_out, int out_size, void* d_ws, size_t ws_size, hipStream_t stream) {
    static int grid = 0;
    if (grid == 0) {
        if (n_in != 28 || out_size != T * DM || ws_size < WS_END) { fprintf(stderr, "kernel_launch: unexpected shapes (n_in %d out %d ws %zu need %zu)\n", n_in, out_size, ws_size, (size_t)WS_END); grid = -1; return; }
        int dev = 0, cus = 0, per_cu = 0;
        (void)hipGetDevice(&dev);
        (void)hipDeviceGetAttribute(&cus, hipDeviceAttributeMultiprocessorCount, dev);
        if (hipFuncSetAttribute((const void*)mega_kernel, hipFuncAttributeMaxDynamicSharedMemorySize, LDS_TOTAL) != hipSuccess) fprintf(stderr, "kernel_launch: hipFuncSetAttribute failed\n");
        if (hipOccupancyMaxActiveBlocksPerMultiprocessor(&per_cu, (const void*)mega_kernel, NT, LDS_TOTAL) != hipSuccess || per_cu < 1) { fprintf(stderr, "kernel_launch: occupancy query failed (%d)\n", per_cu); per_cu = 1; }
        grid = cus;
    }
    if (grid < 0) return;
    Params p{};
    for (int i = 0; i < 28; ++i) p.in[i] = (const float*)d_in[i];
    p.out = (float*)d_out; p.ws = (char*)d_ws;
#if MEGA
    if (hipMemsetAsync((char*)d_ws + OFF_BAR, 0, XCD_BAR_WORDS * 4, stream) != hipSuccess) { fprintf(stderr, "kernel_launch: hipMemsetAsync of the barrier words failed\n"); return; }
    void* args[] = {&p};
    hipError_t e = hipLaunchCooperativeKernel((const void*)mega_kernel, dim3(grid), dim3(NT), args, LDS_TOTAL, stream);
    if (e != hipSuccess) fprintf(stderr, "cooperative launch failed: %s (grid %d)\n", hipGetErrorString(e), grid);
#endif
}
```

```cpp
#include <hip/hip_runtime.h>
#include <hip/hip_cooperative_groups.h>
#include <cstdio>
namespace cg = cooperative_groups;

#ifndef PROBE_MASK
#define PROBE_MASK 0x0
#endif
#ifndef PROBE_SYNCS
#define PROBE_SYNCS 0
#endif
#ifndef MEGA
#define MEGA 1
#endif

typedef _Float16 hf;
typedef _Float16 h8 __attribute__((ext_vector_type(8)));
typedef _Float16 h4 __attribute__((ext_vector_type(4)));
typedef float f4 __attribute__((ext_vector_type(4)));
typedef float f16v __attribute__((ext_vector_type(16)));
#define MFMA32(a, b, c) __builtin_amdgcn_mfma_f32_32x32x16_f16((a), (b), (c), 0, 0, 0)
#define MFMA16(a, b, c) __builtin_amdgcn_mfma_f32_16x16x32_f16((a), (b), (c), 0, 0, 0)
#define DI __device__ __forceinline__
#define LAS __attribute__((address_space(3)))

constexpr int NT = 512;
constexpr int T = 49152;
constexpr int TP = 32768;
constexpr int DM = 1024;
constexpr int DFF = 2816;
constexpr float LOG2E = 1.4426950408889634f;
constexpr float ALPHA = 1.4142135623730951f;
constexpr float EPS = 1e-5f;
constexpr float NEG_BIG = -1e30f;

constexpr size_t SZ_WIN0 = (size_t)2304 * 1024 * 2, SZ_WQUP = (size_t)768 * 384 * 2, SZ_WKVUP = (size_t)1024 * 256 * 2,
                 SZ_WOUT = (size_t)1024 * 1024 * 2, SZ_WUP = (size_t)5632 * 1024 * 2, SZ_WDN = (size_t)1024 * 2816 * 2,
                 SZ_WIN1 = (size_t)1536 * 1024 * 2;
constexpr size_t OFF_WIN0 = 0, OFF_WQUP = OFF_WIN0 + SZ_WIN0, OFF_WKVUP = OFF_WQUP + SZ_WQUP, OFF_WOUT0 = OFF_WKVUP + SZ_WKVUP,
                 OFF_WUP0 = OFF_WOUT0 + SZ_WOUT, OFF_WDN0 = OFF_WUP0 + SZ_WUP, OFF_WIN1 = OFF_WDN0 + SZ_WDN, OFF_WOUT1 = OFF_WIN1 + SZ_WIN1,
                 OFF_WUP1 = OFF_WOUT1 + SZ_WOUT, OFF_WDN1 = OFF_WUP1 + SZ_WUP, OFF_ROPEM = OFF_WDN1 + SZ_WDN;
constexpr size_t SZ_ROPEM = (size_t)16384 * 16 * 4 * 2, SZ_ROPEG = (size_t)16384 * 8 * 4 * 2;
constexpr size_t OFF_ROPEG = OFF_ROPEM + SZ_ROPEM, OFF_SS = OFF_ROPEG + SZ_ROPEG, SZ_SS = (size_t)T * 8 * 4;
constexpr size_t OFF_R1 = OFF_SS + SZ_SS, SZ_R1 = (size_t)T * 1024 * 2;
constexpr size_t OFF_R2 = OFF_R1 + SZ_R1, SZ_R2 = (size_t)T * 1024 * 2;
constexpr size_t OFF_R3 = OFF_R2 + SZ_R2, SZ_R3 = (size_t)T * 2816 * 2;
constexpr size_t OFF_BAR = OFF_R3 + SZ_R3;
constexpr size_t WS_END = OFF_BAR + 16384;
constexpr size_t OFF_XH = OFF_R1, OFF_QM = OFF_R1;
constexpr size_t OFF_AO = OFF_R2, OFF_QL = OFF_R2, OFF_KVL = OFF_R2 + (size_t)T * 384 * 2;
constexpr size_t OFF_U = OFF_R3;
constexpr size_t OFF_QA = OFF_R3, OFF_KA = OFF_QA + (size_t)T * 512 * 2, OFF_VAT = OFF_KA + (size_t)T * 512 * 2, OFF_KN = OFF_VAT + (size_t)T * 512 * 2,
                 OFF_VMT = OFF_KN + (size_t)T * 512 * 2, OFF_KR = OFF_VMT + (size_t)T * 512 * 2;
constexpr size_t OFF_Q1 = OFF_R3, OFF_K1 = OFF_Q1 + (size_t)T * 1024 * 2, OFF_V1T = OFF_K1 + (size_t)T * 256 * 2;
static_assert(OFF_KR + (size_t)T * 32 * 2 <= WS_END, "L0 attention buffers overflow R3");
static_assert(OFF_V1T + (size_t)T * 256 * 2 <= WS_END, "L1 attention buffers overflow R3");

constexpr int CST = 132;
constexpr int LDS_BYTES = 256 * CST * 4;
constexpr int LDS_TOTAL = LDS_BYTES + 16;

struct Params {
    const float* in[28];
    float* out;
    char* ws;
};

DI void seq_of(int t, int& s0, int& L) { if (t < TP) { s0 = t & ~8191; L = 8192; } else { s0 = TP; L = 16384; } }
DI const float* xrow(const Params& p, int t) { return t < TP ? p.in[0] + (size_t)t * DM : p.in[1] + (size_t)(t - TP) * DM; }
DI h8 cvt8(f4 a, f4 b, float s) { h8 v; v[0] = (hf)(a[0] * s); v[1] = (hf)(a[1] * s); v[2] = (hf)(a[2] * s); v[3] = (hf)(a[3] * s); v[4] = (hf)(b[0] * s); v[5] = (hf)(b[1] * s); v[6] = (hf)(b[2] * s); v[7] = (hf)(b[3] * s); return v; }
DI int tid_opaque() { int t = threadIdx.x; asm volatile("" : "+v"(t)); return t; }
DI float wave_sum(float v) { v += __shfl_xor(v, 32); v += __shfl_xor(v, 16); v += __shfl_xor(v, 8); v += __shfl_xor(v, 4); v += __shfl_xor(v, 2); v += __shfl_xor(v, 1); return v; }

DI void prep_weight(const float* __restrict__ src, const float* __restrict__ g, hf* __restrict__ dst, int K, int Nsrc, int Npad, int mode, char* smem) {
    hf* tl = (hf*)smem;
    const int tid = tid_opaque(), nn = tid & 63, kq = tid >> 6, on = tid >> 3, oc = tid & 7;
    const int ntn = Npad >> 6, ntk = K >> 6;
    for (int tile = blockIdx.x; tile < ntn * ntk; tile += gridDim.x) {
        const int tn = tile % ntn, tk = tile / ntn, n0 = tn * 64, k0 = tk * 64;
        int c0 = n0;
        if (mode == 1) { const int t = n0 >> 7; c0 = (n0 & 64) ? (DFF + t * 64) : (t * 64); }
        const int col = c0 + nn;
        __syncthreads();
#pragma unroll
        for (int r = 0; r < 8; ++r) {
            const int kk = kq + 8 * r;
            float x = 0.f;
            if (col < Nsrc) { x = src[(size_t)(k0 + kk) * Nsrc + col]; if (g) x *= g[k0 + kk]; }
            tl[nn * 72 + kk] = (hf)x;
        }
        __syncthreads();
        *(h8*)(dst + (size_t)(n0 + on) * K + k0 + oc * 8) = *(const h8*)(tl + on * 72 + oc * 8);
    }
}

__device__ void phase_prep(const Params& p, char* smem) {
    const long gtid = (long)blockIdx.x * NT + tid_opaque(), gs = (long)gridDim.x * NT;
    char* ws = p.ws;
    prep_weight(p.in[2], nullptr, (hf*)(ws + OFF_WIN0), 1024, 2208, 2304, 0, smem);
    prep_weight(p.in[5], p.in[4], (hf*)(ws + OFF_WQUP), 384, 768, 768, 0, smem);
    prep_weight(p.in[7], p.in[6], (hf*)(ws + OFF_WKVUP), 256, 1024, 1024, 0, smem);
    prep_weight(p.in[8], nullptr, (hf*)(ws + OFF_WOUT0), 1024, 1024, 1024, 0, smem);
    prep_weight(p.in[11], nullptr, (hf*)(ws + OFF_WUP0), 1024, 5632, 5632, 1, smem);
    prep_weight(p.in[14], nullptr, (hf*)(ws + OFF_WDN0), 2816, 1024, 1024, 0, smem);
    prep_weight(p.in[17], nullptr, (hf*)(ws + OFF_WIN1), 1024, 1536, 1536, 0, smem);
    prep_weight(p.in[19], nullptr, (hf*)(ws + OFF_WOUT1), 1024, 1024, 1024, 0, smem);
    prep_weight(p.in[22], nullptr, (hf*)(ws + OFF_WUP1), 1024, 5632, 5632, 1, smem);
    prep_weight(p.in[25], nullptr, (hf*)(ws + OFF_WDN1), 2816, 1024, 1024, 0, smem);
    hf* xh = (hf*)(ws + OFF_XH);
    for (long idx = gtid; idx < (long)T * 128; idx += gs) {
        const int t = (int)(idx >> 7), c = (int)(idx & 127) * 8;
        const float* xr = xrow(p, t) + c;
        const f4 a = *(const f4*)xr, b = *(const f4*)(xr + 4);
        *(h8*)(xh + (size_t)t * DM + c) = cvt8(a, b, 1.f);
    }
    float* rm = (float*)(ws + OFF_ROPEM); float* rg = (float*)(ws + OFF_ROPEG);
    for (long idx = gtid; idx < 16384L * 24; idx += gs) {
        const int pos = (int)(idx / 24), i = (int)(idx % 24);
        double inv;
        if (i < 16) inv = exp2(-(double)i / 16.0 * 13.287712379549449);
        else inv = exp2(-(double)(i - 16) / 8.0 * 18.931568569324174);
        const float angf = (float)pos * (float)inv;
        const double ang = (double)angf;
        const float c = (float)cos(ang), s = (float)sin(ang);
        if (i < 16) { rm[(size_t)pos * 32 + i] = c; rm[(size_t)pos * 32 + 16 + i] = s; }
        else { rg[(size_t)pos * 16 + (i - 16)] = c; rg[(size_t)pos * 16 + 8 + (i - 16)] = s; }
    }
}

constexpr int HTB = 128 * 64 * 2;
DI int lds_byte(int r, int c) { const int st = (r >> 4) * 2 + (c >> 5), rr = r & 15, cc = c & 31, ob = rr * 64 + cc * 2; return st * 1024 + (ob ^ (((ob >> 9) & 1) << 5)); }
DI void stage_rc(int b, int& R, int& C) { const int st = b / 1024, sb = b % 1024, swz = sb ^ (((sb >> 9) & 1) << 5); R = (st >> 1) * 16 + swz / 64; C = (st & 1) * 32 + (swz % 64) / 2; }

DI void tile_coords(int L, int nM, int nN, int& pm, int& pn) {
    const int nwg = nM * nN;
    int wgid = L; { const int q = nwg / 8, r = nwg % 8, xcd = wgid % 8, off = wgid / 8; wgid = (xcd < r ? xcd * (q + 1) : r * (q + 1) + (xcd - r) * q) + off; }
    const int nig = 8 * nN, gid = wgid / nig, fm = gid * 8, gsz = (nM - fm) < 8 ? (nM - fm) : 8;
    pm = fm + ((wgid % nig) % gsz); pn = (wgid % nig) / gsz;
}

DI void gemm256(const hf* __restrict__ A, int lda, int arow0, const hf* __restrict__ Bt, int K, int bcol, LAS char* lds, f4 (&acc)[2][2][4][2]) {
    const int tid = tid_opaque(), wid = __builtin_amdgcn_readfirstlane(tid >> 6), lane = tid & 63, wr = wid >> 2, wc = wid & 3, fr = lane & 15, fq = lane >> 4;
    const int nt = K >> 6;
    unsigned offA[2], offB[2];
#pragma unroll
    for (int i = 0; i < 2; ++i) {
        int R, C; stage_rc(tid * 16 + i * 8192, R, C);
        offA[i] = (unsigned)(R * lda + C) * 2u;
        offB[i] = (unsigned)(R * K + C) * 2u;
    }
    const char* Ab = (const char*)(A + (long)arow0 * lda);
    const char* Bb = (const char*)(Bt + (long)bcol * K);
    const size_t hA = (size_t)128 * lda * 2, hB = (size_t)128 * K * 2;
    const unsigned ldsw = (unsigned)wid * 1024u;
    const int aoff = lds_byte(wr * 64 + fr, fq * 8), boff = lds_byte(wc * 32 + fr, fq * 8);
#define SA(b, h) (((b) * 2 + (h)) * HTB)
#define SB(b, h) ((4 + (b) * 2 + (h)) * HTB)
#define STAGE_A(b, h, kt) do { _Pragma("unroll") for (int _i = 0; _i < 2; ++_i) \
        __builtin_amdgcn_global_load_lds((const unsigned*)(Ab + (h) * hA + (size_t)(kt) * 128 + offA[_i]), (LAS unsigned*)(lds + SA(b, h) + ldsw + _i * 8192), 16, 0, 0); } while (0)
#define STAGE_B(b, h, kt) do { _Pragma("unroll") for (int _i = 0; _i < 2; ++_i) \
        __builtin_amdgcn_global_load_lds((const unsigned*)(Bb + (h) * hB + (size_t)(kt) * 128 + offB[_i]), (LAS unsigned*)(lds + SB(b, h) + ldsw + _i * 8192), 16, 0, 0); } while (0)
#define LDA(dst, b, h) do { _Pragma("unroll") for (int m = 0; m < 4; ++m) _Pragma("unroll") for (int k = 0; k < 2; ++k) dst[m][k] = *(const LAS h8*)(lds + SA(b, h) + aoff + m * 2048 + k * 1024); } while (0)
#define LDB(dst, b, h) do { _Pragma("unroll") for (int n = 0; n < 2; ++n) _Pragma("unroll") for (int k = 0; k < 2; ++k) dst[n][k] = *(const LAS h8*)(lds + SB(b, h) + boff + n * 2048 + k * 1024); } while (0)
#define MMA(ai, bj, At_, Bt_) do { __builtin_amdgcn_s_setprio(1); _Pragma("unroll") for (int m = 0; m < 4; ++m) _Pragma("unroll") for (int n = 0; n < 2; ++n) _Pragma("unroll") for (int k = 0; k < 2; ++k) \
        acc[ai][bj][m][n] = MFMA16(At_[m][k], Bt_[n][k], acc[ai][bj][m][n]); __builtin_amdgcn_s_setprio(0); } while (0)
#define WAIT_V(n) asm volatile("s_waitcnt vmcnt(" #n ")" ::: "memory")
#define WAIT_L(n) asm volatile("s_waitcnt lgkmcnt(" #n ")" ::: "memory")
#define BAR __builtin_amdgcn_s_barrier()
#define SCHED __builtin_amdgcn_sched_barrier(0)
#pragma unroll
    for (int a_ = 0; a_ < 2; ++a_)
#pragma unroll
        for (int b_ = 0; b_ < 2; ++b_)
#pragma unroll
            for (int m = 0; m < 4; ++m)
#pragma unroll
                for (int n = 0; n < 2; ++n) acc[a_][b_][m][n] = (f4){0.f, 0.f, 0.f, 0.f};
    h8 At[4][2], B0[2][2], B1[2][2];
    WAIT_V(0);
    __syncthreads();
    STAGE_B(0, 0, 0); STAGE_A(0, 0, 0);
    STAGE_B(0, 1, 0); STAGE_A(0, 1, 0);
    if (wr == 1) BAR;
    WAIT_V(4); BAR;
    STAGE_B(1, 0, 1); STAGE_A(1, 0, 1); STAGE_B(1, 1, 1);
    WAIT_V(6); BAR;
    for (int t = 0; t < nt - 2; t += 2) {
        LDB(B0, 0, 0); SCHED; LDA(At, 0, 0); STAGE_A(1, 1, t + 1);
        WAIT_L(8); BAR; WAIT_L(0); MMA(0, 0, At, B0); BAR; SCHED;
        LDB(B1, 0, 1); STAGE_B(0, 0, t + 2);
        BAR; WAIT_L(0); MMA(0, 1, At, B1); BAR;
        LDA(At, 0, 1); STAGE_A(0, 0, t + 2);
        BAR; WAIT_L(0); MMA(1, 0, At, B0); BAR; SCHED;
        STAGE_B(0, 1, t + 2);
        WAIT_V(6); BAR; MMA(1, 1, At, B1); BAR;
        LDB(B0, 1, 0); SCHED; LDA(At, 1, 0); STAGE_A(0, 1, t + 2);
        WAIT_L(8); BAR; WAIT_L(0); MMA(0, 0, At, B0); BAR; SCHED;
        LDB(B1, 1, 1); STAGE_B(1, 0, t + 3);
        BAR; WAIT_L(0); MMA(0, 1, At, B1); BAR;
        LDA(At, 1, 1); STAGE_A(1, 0, t + 3);
        BAR; WAIT_L(0); MMA(1, 0, At, B0); BAR; SCHED;
        STAGE_B(1, 1, t + 3);
        WAIT_V(6); BAR; MMA(1, 1, At, B1); BAR;
    }
    { LDB(B0, 0, 0); LDA(At, 0, 0); STAGE_A(1, 1, nt - 1);
      BAR; WAIT_L(0); MMA(0, 0, At, B0); BAR;
      LDB(B1, 0, 1); BAR; WAIT_L(0); MMA(0, 1, At, B1); BAR;
      LDA(At, 0, 1); WAIT_V(4); BAR; WAIT_L(0); MMA(1, 0, At, B0); MMA(1, 1, At, B1); BAR; }
    { LDB(B0, 1, 0); LDA(At, 1, 0); WAIT_V(2); BAR; WAIT_L(0); MMA(0, 0, At, B0); BAR;
      LDB(B1, 1, 1); WAIT_V(0); BAR; WAIT_L(0); MMA(0, 1, At, B1); BAR;
      LDA(At, 1, 1); BAR; WAIT_L(0); MMA(1, 0, At, B0); MMA(1, 1, At, B1); BAR; }
    if (wr == 0) BAR;
#undef SA
#undef SB
#undef STAGE_A
#undef STAGE_B
#undef LDA
#undef LDB
#undef MMA
}

template <int BJ> DI void stage_half(const f4 (&acc)[2][2][4][2], float* C) {
    __syncthreads();
    const int tid = tid_opaque(), wid = tid >> 6, lane = tid & 63, wr = wid >> 2, wc = wid & 3, fr = lane & 15, fq = lane >> 4;
#pragma unroll
    for (int ai = 0; ai < 2; ++ai)
#pragma unroll
        for (int m = 0; m < 4; ++m)
#pragma unroll
            for (int n = 0; n < 2; ++n)
#pragma unroll
                for (int j = 0; j < 4; ++j) C[(ai * 128 + wr * 64 + m * 16 + fq * 4 + j) * CST + wc * 32 + n * 16 + fr] = acc[ai][BJ][m][n][j];
    __syncthreads();
}

DI void ld8(const float* C, int r, int c, f4& a, f4& b) { a = *(const f4*)(C + r * CST + c); b = *(const f4*)(C + r * CST + c + 4); }

template <int NCOLS, bool RSCALE>
DI void store_transposed(const float* C, int c0, hf* dst  , int tok0) {
    const int tid = tid_opaque();
    const int col = tid % NCOLS, rc0 = tid / NCOLS;
    constexpr int STEP = NT / NCOLS;
#pragma unroll
    for (int rc = rc0; rc < 32; rc += STEP) {
        h8 v;
#pragma unroll
        for (int j = 0; j < 8; ++j) { float x = C[(8 * rc + j) * CST + c0 + col]; if (RSCALE) x *= C[(8 * rc + j) * CST + 128]; v[j] = (hf)x; }
        *(h8*)(dst + (size_t)col * T + tok0 + 8 * rc) = v;
    }
}

DI void epi_in0(const Params& p, const float* C, int m0, int tn) {
    char* ws = p.ws;
    hf* Qa = (hf*)(ws + OFF_QA); hf* Ka = (hf*)(ws + OFF_KA); hf* VaT = (hf*)(ws + OFF_VAT);
    hf* QL = (hf*)(ws + OFF_QL); hf* KVL = (hf*)(ws + OFF_KVL); hf* Kr = (hf*)(ws + OFF_KR);
    float* SS = (float*)(ws + OFF_SS); const float* rm = (const float*)(ws + OFF_ROPEM);
    const int tid = tid_opaque(), cc = tid & 15, rb = tid >> 4;
    if (tn >= 8 && tn < 12) {
        store_transposed<128, false>(C, 0, VaT + (size_t)(tn - 8) * 128 * T, m0);
    } else if (tn == 17) {
        if (cc < 2) {
            int s0, L; seq_of(m0, s0, L);
#pragma unroll
            for (int i = 0; i < 8; ++i) {
                const int r = rb + 32 * i, t = m0 + r, pos = t - s0;
                f4 a0, a1, b0, b1; ld8(C, r, 8 * cc, a0, a1); ld8(C, r, 16 + 8 * cc, b0, b1);
                const float* cs = rm + (size_t)pos * 32 + 8 * cc;
                h8 o1, o2;
#pragma unroll
                for (int j = 0; j < 8; ++j) {
                    const float x1 = j < 4 ? a0[j & 3] : a1[j & 3], x2 = j < 4 ? b0[j & 3] : b1[j & 3];
                    const float c = cs[j], s = cs[16 + j];
                    o1[j] = (hf)(x1 * c - x2 * s); o2[j] = (hf)(x2 * c + x1 * s);
                }
                *(h8*)(Kr + (size_t)t * 32 + 8 * cc) = o1; *(h8*)(Kr + (size_t)t * 32 + 16 + 8 * cc) = o2;
            }
        }
    } else {
        hf* dst; int ld, cbase, ssidx = -1; float scale = 1.f;
        if (tn < 4) { dst = Qa; ld = 512; cbase = tn * 128; scale = 0.125f * LOG2E; }
        else if (tn < 8) { dst = Ka; ld = 512; cbase = (tn - 4) * 128; }
        else if (tn < 15) { dst = QL; ld = 384; cbase = (tn - 12) * 128; ssidx = tn - 12; }
        else { dst = KVL; ld = 256; cbase = (tn - 15) * 128; ssidx = 3 + (tn - 15); }
#pragma unroll
        for (int i = 0; i < 8; ++i) {
            const int r = rb + 32 * i, t = m0 + r;
            f4 a, b; ld8(C, r, 8 * cc, a, b);
            *(h8*)(dst + (size_t)t * ld + cbase + 8 * cc) = cvt8(a, b, scale);
            if (ssidx >= 0) {
                float ss = a[0] * a[0] + a[1] * a[1] + a[2] * a[2] + a[3] * a[3] + b[0] * b[0] + b[1] * b[1] + b[2] * b[2] + b[3] * b[3];
                ss += __shfl_xor(ss, 1); ss += __shfl_xor(ss, 2); ss += __shfl_xor(ss, 4); ss += __shfl_xor(ss, 8);
                if (cc == 0) SS[(size_t)t * 8 + ssidx] = ss;
            }
        }
    }
}

DI void epi_qup(const Params& p, float* C, int m0, int tn) {
    char* ws = p.ws;
    hf* Qm = (hf*)p.out;
    const float* SS = (const float*)(ws + OFF_SS); const float* rm = (const float*)(ws + OFF_ROPEM);
    const int tid = tid_opaque();
    const float QSC = 0.10206207261596575f * LOG2E;
    if (tid < 256) { const float* s = SS + (size_t)(m0 + tid) * 8; C[tid * CST + 128] = rsqrtf((s[0] + s[1] + s[2]) * (1.f / 384.f) + EPS); }
    __syncthreads();
    const int cc = tid & 15, rb = tid >> 4;
    const int n = tn * 128 + 8 * cc, hd = n / 96, w = n - hd * 96;
    int s0, L; seq_of(m0, s0, L);
#pragma unroll
    for (int i = 0; i < 8; ++i) {
        const int r = rb + 32 * i, t = m0 + r, pos = t - s0;
        const float rq = C[r * CST + 128] * QSC;
        f4 a, b; ld8(C, r, 8 * cc, a, b);
        if (w >= 64) {
            const int iw = w - 64;
            f4 pa, pb;
            if (iw < 16) ld8(C, r, 8 * cc + 16, pa, pb); else ld8(C, r, 8 * cc - 16, pa, pb);
            const float* cs = rm + (size_t)pos * 32 + (iw & 15);
            const float sg = iw < 16 ? -1.f : 1.f;
#pragma unroll
            for (int j = 0; j < 4; ++j) {
                a[j] = a[j] * cs[j] + sg * pa[j] * cs[16 + j];
                b[j] = b[j] * cs[4 + j] + sg * pb[j] * cs[20 + j];
            }
        }
        *(h8*)(Qm + (size_t)t * 768 + n) = cvt8(a, b, rq);
    }
}
DI void epi_kvup(const Params& p, float* C, int m0, int tn  ) {
    char* ws = p.ws;
    hf* Kn = (hf*)(ws + OFF_KN); hf* VmT = (hf*)(ws + OFF_VMT);
    const float* SS = (const float*)(ws + OFF_SS);
    const int tid = tid_opaque();
    if (tid < 256) { const float* s = SS + (size_t)(m0 + tid) * 8; C[tid * CST + 128] = rsqrtf((s[3] + s[4]) * (1.f / 256.f) + EPS); }
    __syncthreads();
    const int cc = tid & 7, rb = tid >> 3;
#pragma unroll
    for (int i = 0; i < 4; ++i) {
        const int r = rb + 64 * i, t = m0 + r;
        f4 a, b; ld8(C, r, 8 * cc, a, b);
        *(h8*)(Kn + (size_t)t * 512 + tn * 64 + 8 * cc) = cvt8(a, b, C[r * CST + 128]);
    }
    store_transposed<64, true>(C, 64, VmT + (size_t)tn * 64 * T, m0);
}

DI void epi_res(const Params& p, const float* C, int m0, int tn, bool res_from_input) {
    const int tid = tid_opaque(), cc = tid & 15, rb = tid >> 4;
    hf* Xh = (hf*)(p.ws + OFF_XH);
#pragma unroll
    for (int i = 0; i < 8; ++i) {
        const int r = rb + 32 * i, t = m0 + r, n = tn * 128 + 8 * cc;
        f4 a, b; ld8(C, r, 8 * cc, a, b);
        hf* yp = Xh + (size_t)t * DM + n;
        f4 r0, r1;
        if (res_from_input) { const float* rp = xrow(p, t) + n; r0 = *(const f4*)rp; r1 = *(const f4*)(rp + 4); }
        else { const h8 rv = *(const h8*)yp; r0 = (f4){(float)rv[0], (float)rv[1], (float)rv[2], (float)rv[3]}; r1 = (f4){(float)rv[4], (float)rv[5], (float)rv[6], (float)rv[7]}; }
        *(h8*)yp = cvt8(r0 * ALPHA + a, r1 * ALPHA + b, 1.f);
    }
}

DI float gelu_exact(float v) {
    const float t = __builtin_amdgcn_rcpf(fmaf(fabsf(v), 0.2316418882f, 1.0f));
    float q = fmaf(t, 0.5307027145f, -0.7265760135f); q = fmaf(q, t, 0.7107068705f); q = fmaf(q, t, -0.142248368f); q = fmaf(q, t, 0.127414796f); q *= t;
    const float e = __builtin_amdgcn_exp2f(v * v * -0.72134752044f);
    const float m = v * (q * e);
    return v < 0.f ? m : v - m;
}
DI void epi_ffn(const Params& p, const float* C, int s0, int L, int pos0, int tn, const float* cw, const float* cb) {
    hf* U = (hf*)(p.ws + OFF_U);
    const int tid = tid_opaque(), cc = tid & 7, rb = tid >> 3;
#pragma unroll 1
    for (int hh = 0; hh < 2; ++hh) {
        const int lc = 8 * cc + 4 * hh, gc = tn * 64 + lc;
        const f4 wg0 = *(const f4*)(cw + gc), wg1 = *(const f4*)(cw + 5632 + gc), wg2 = *(const f4*)(cw + 2 * 5632 + gc), bg = *(const f4*)(cb + gc);
        const f4 wv0 = *(const f4*)(cw + DFF + gc), wv1 = *(const f4*)(cw + 5632 + DFF + gc), wv2 = *(const f4*)(cw + 2 * 5632 + DFF + gc), bv = *(const f4*)(cb + DFF + gc);
#pragma unroll 1
        for (int i = 0; i < 4; ++i) {
            const int lr = rb + 64 * i, pos = pos0 + lr;
            if (lr >= 1 && lr <= 254 && pos < L) {
                const f4 zero = {0.f, 0.f, 0.f, 0.f};
                const bool hm = pos - 1 >= 0, hp = pos + 1 < L;
                const f4 g0 = hm ? *(const f4*)(C + (lr - 1) * CST + lc) : zero, g1 = *(const f4*)(C + lr * CST + lc), g2 = hp ? *(const f4*)(C + (lr + 1) * CST + lc) : zero;
                const f4 v0 = hm ? *(const f4*)(C + (lr - 1) * CST + 64 + lc) : zero, v1 = *(const f4*)(C + lr * CST + 64 + lc), v2 = hp ? *(const f4*)(C + (lr + 1) * CST + 64 + lc) : zero;
                const f4 gt = wg0 * g0 + wg1 * g1 + wg2 * g2 + bg;
                const f4 vl = wv0 * v0 + wv1 * v1 + wv2 * v2 + bv;
                h4 o;
#pragma unroll
                for (int j = 0; j < 4; ++j) o[j] = (hf)(gelu_exact(gt[j]) * vl[j]);
                *(h4*)(U + (size_t)(s0 + pos) * DFF + gc) = o;
            }
        }
    }
}

DI void epi_in1(const Params& p, const float* C, int m0, int tn) {
    char* ws = p.ws;
    hf* Q1 = (hf*)(ws + OFF_Q1); hf* K1 = (hf*)(ws + OFF_K1); hf* V1t = (hf*)(ws + OFF_V1T);
    const float* rg = (const float*)(ws + OFF_ROPEG);
    const int tid = tid_opaque(), cc = tid & 15, rb = tid >> 4;
    if (tn >= 10) { store_transposed<128, false>(C, 0, V1t + (size_t)(tn - 10) * 128 * T, m0); return; }
    int s0, L; seq_of(m0, s0, L);
    const int cw8 = cc & 7;
    hf* dst = tn < 8 ? Q1 : K1; const int ld = tn < 8 ? 1024 : 256, cbase = (tn < 8 ? tn : tn - 8) * 128;
    const float scale = tn < 8 ? 0.125f * LOG2E : 1.f;
#pragma unroll
    for (int i = 0; i < 8; ++i) {
        const int r = rb + 32 * i, t = m0 + r, pos = t - s0;
        f4 a, b; ld8(C, r, 8 * cc, a, b);
        if (cw8 < 2) {
            f4 pa, pb;
            if (cw8 == 0) ld8(C, r, 8 * cc + 8, pa, pb); else ld8(C, r, 8 * cc - 8, pa, pb);
            const float* cs = rg + (size_t)pos * 16;
            const float sg = cw8 == 0 ? -1.f : 1.f;
#pragma unroll
            for (int j = 0; j < 4; ++j) {
                a[j] = a[j] * cs[j] + sg * pa[j] * cs[8 + j];
                b[j] = b[j] * cs[4 + j] + sg * pb[j] * cs[12 + j];
            }
        }
        *(h8*)(dst + (size_t)t * ld + cbase + 8 * cc) = cvt8(a, b, scale);
    }
}

enum { G_IN0 = 0, G_UP = 1, G_RES_IN = 2, G_RES = 3, G_FFN = 4, G_IN1 = 5 };
template <int KIND, int HALF_> DI void run_epi(const Params& p, float* C, int m0, int pn, bool second, int s0, int L, int pos0, const float* cw, const float* cb) {
    const int tn = pn * 2 + HALF_;
    if (KIND == G_IN0) epi_in0(p, C, m0, tn);
    else if (KIND == G_UP) { if (!second) epi_qup(p, C, m0, tn); else epi_kvup(p, C, m0, tn); }
    else if (KIND == G_RES_IN) epi_res(p, C, m0, tn, true);
    else if (KIND == G_RES) epi_res(p, C, m0, tn, false);
    else if (KIND == G_FFN) epi_ffn(p, C, s0, L, pos0, tn, cw, cb);
    else epi_in1(p, C, m0, tn);
}
template <int KIND>
__device__ void phase_gemm(const Params& p, char* smem, const hf* A, int K, const hf* W, int nN, const float* cw, const float* cb) {
    LAS char* lds = (LAS char*)smem;
    float* C = (float*)smem;
    const int nM = KIND == G_FFN ? 197 : 192;
    const int ntile = KIND == G_UP ? 192 * 7 : nM * nN;
    for (int Lx = blockIdx.x; Lx < ntile; Lx += gridDim.x) {
        int pm, pn; const hf* Ax = A; const hf* Wx = W; int Kx = K; bool second = false;
        if (KIND == G_UP) {
            if (Lx < 192 * 3) tile_coords(Lx, 192, 3, pm, pn);
            else { tile_coords(Lx - 192 * 3, 192, 4, pm, pn); second = true; Ax = (const hf*)(p.ws + OFF_KVL); Wx = (const hf*)(p.ws + OFF_WKVUP); Kx = 256; }
        } else tile_coords(Lx, nM, nN, pm, pn);
        int arow0 = pm * 256, s0 = 0, L = 0, pos0 = 0;
        if (KIND == G_FFN) {
            int ti;
            if (pm < 132) { s0 = (pm / 33) * 8192; L = 8192; ti = pm % 33; } else { s0 = TP; L = 16384; ti = pm - 132; }
            pos0 = 254 * ti - 1; arow0 = s0 + pos0;
        }
        f4 acc[2][2][4][2];
        gemm256(Ax, Kx, arow0, Wx, Kx, pn * 256, lds, acc);
        const int m0 = pm * 256;
        stage_half<0>(acc, C);
        run_epi<KIND, 0>(p, C, m0, pn, second, s0, L, pos0, cw, cb);
        stage_half<1>(acc, C);
        run_epi<KIND, 1>(p, C, m0, pn, second, s0, L, pos0, cw, cb);
    }
}

enum { AT_MLA = 0, AT_NA = 1, AT_SWA = 2 };
struct AttnArgs {
    const hf* Q; int qs;
    const hf* K; int ks;
    const hf* Kx;
    const hf* Vt;
    hf* O;
    int t0;
    int kt0;
    int nkt;
    int R0, rows, kr0;
    int qpos0, kpos0; float sink;
};

template <int DQK, int MODE>
DI void attn_item(const AttnArgs& a, char* smem) {
    constexpr int KST = DQK + 8, VST = 68, KCH = 64 * DQK / 8;
    constexpr int NKC = (KCH + NT - 1) / NT;
    hf* Ks = (hf*)smem;
    hf* Vs = Ks + 64 * KST;
    const float* biasL = (const float*)(smem + 24576);
    const int tid = tid_opaque(), lane = tid & 63, wave = tid >> 6, ql = lane & 31, h = lane >> 5;
    const int qrow = 32 * wave + ql;
    h8 qf[DQK / 16];
    {
        const hf* qp = a.Q + (size_t)(a.t0 + qrow) * a.qs + 8 * h;
#pragma unroll
        for (int s = 0; s < DQK / 16; ++s) qf[s] = *(const h8*)(qp + 16 * s);
    }
    float m = NEG_BIG, l = 0.f;
    if (MODE == AT_SWA) { m = a.sink; l = (h == 0) ? 1.f : 0.f; }
    f16v o[2];
#pragma unroll
    for (int e = 0; e < 16; ++e) { o[0][e] = 0.f; o[1][e] = 0.f; }
    int qr = 0, qc = 0, rsq = 0, csq = 0;
    if (MODE == AT_NA) {
        qr = a.R0 + (qrow >> 6); qc = qrow & 63;
        rsq = qr - 4; rsq = rsq < 0 ? 0 : (rsq > a.rows - 8 ? a.rows - 8 : rsq);
        csq = qc - 8; csq = csq < 0 ? 0 : (csq > 48 ? 48 : csq);
    }
    const int pq = a.qpos0 + qrow;
    const int pqw = a.qpos0 + 32 * wave;
    h8 rk[NKC], rv;
    auto load_tile = [&](int kt) {
        const int tok0 = a.kt0 + 64 * kt;
#pragma unroll
        for (int i = 0; i < NKC; ++i) {
            const int c = tid + NT * i, row = c / (DQK / 8), kc = c % (DQK / 8);
            if (c < KCH) {
                if (MODE == AT_MLA && kc >= 8) rk[i] = *(const h8*)(a.Kx + (size_t)(tok0 + row) * 32 + (kc - 8) * 8);
                else rk[i] = *(const h8*)(a.K + (size_t)(tok0 + row) * a.ks + kc * 8);
            }
        }
        { const int d = tid >> 3, kc = tid & 7; rv = *(const h8*)(a.Vt + (size_t)d * T + tok0 + kc * 8); }
    };
    load_tile(0);
    for (int kt = 0; kt < a.nkt; ++kt) {
        __syncthreads();
#pragma unroll
        for (int i = 0; i < NKC; ++i) {
            const int c = tid + NT * i, row = c / (DQK / 8), kc = c % (DQK / 8);
            if (c < KCH) *(h8*)(Ks + row * KST + kc * 8) = rk[i];
        }
        {
            const int d = tid >> 3, kc = tid & 7;
            h4 lo, hi; lo[0] = rv[0]; lo[1] = rv[1]; lo[2] = rv[2]; lo[3] = rv[3]; hi[0] = rv[4]; hi[1] = rv[5]; hi[2] = rv[6]; hi[3] = rv[7];
            *(h4*)(Vs + d * VST + kc * 8) = lo; *(h4*)(Vs + d * VST + kc * 8 + 4) = hi;
        }
        __syncthreads();
        if (kt + 1 < a.nkt) load_tile(kt + 1);
        bool active = true;
        if (MODE == AT_NA) { const int kr = a.kr0 + kt; active = (kr >= rsq) && (kr < rsq + 8); }
        if (MODE == AT_SWA) { const int pk0 = a.kpos0 + 64 * kt; active = (pk0 <= pqw + 31 + 128) && (pk0 + 63 >= pqw - 128); }
        if (active) {
            f16v x[2];
#pragma unroll
            for (int i = 0; i < 2; ++i) {
#pragma unroll
                for (int e = 0; e < 16; ++e) x[i][e] = 0.f;
                const hf* kp = Ks + (32 * i + ql) * KST + 8 * h;
#pragma unroll
                for (int s = 0; s < DQK / 16; ++s) { const h8 kf = *(const h8*)(kp + 16 * s); x[i] = MFMA32(kf, qf[s], x[i]); }
            }
            if (MODE == AT_NA) {
                const int kr = a.kr0 + kt;
                const int brow = (kr - qr + 7) * 31;
#pragma unroll
                for (int i = 0; i < 2; ++i)
#pragma unroll
                    for (int e = 0; e < 16; ++e) {
                        const int kcol = 32 * i + (e & 3) + 8 * (e >> 2) + 4 * h;
                        const bool v = (kcol >= csq) && (kcol < csq + 16);
                        const int bi = v ? (brow + kcol - qc + 15) : 0;
                        const float bb = biasL[bi];
                        x[i][e] = v ? (x[i][e] + bb) : NEG_BIG;
                    }
            } else if (MODE == AT_SWA) {
                const int pk0 = a.kpos0 + 64 * kt;
#pragma unroll
                for (int i = 0; i < 2; ++i)
#pragma unroll
                    for (int e = 0; e < 16; ++e) {
                        const int pk = pk0 + 32 * i + (e & 3) + 8 * (e >> 2) + 4 * h;
                        const int dd = pq - pk;
                        const bool v = (dd <= 128) && (dd >= -128);
                        x[i][e] = v ? x[i][e] : NEG_BIG;
                    }
            }
            float mx = x[0][0];
#pragma unroll
            for (int e = 1; e < 16; ++e) mx = fmaxf(mx, x[0][e]);
#pragma unroll
            for (int e = 0; e < 16; ++e) mx = fmaxf(mx, x[1][e]);
            mx = fmaxf(mx, __shfl_xor(mx, 32));
            const float mnew = fmaxf(m, mx);
            const float alpha = __builtin_amdgcn_exp2f(m - mnew);
            m = mnew;
            float ps = 0.f;
#pragma unroll
            for (int i = 0; i < 2; ++i)
#pragma unroll
                for (int e = 0; e < 16; ++e) { const float pv = __builtin_amdgcn_exp2f(x[i][e] - mnew); x[i][e] = pv; ps += pv; }
            l = l * alpha + ps;
#pragma unroll
            for (int e = 0; e < 16; ++e) { o[0][e] *= alpha; o[1][e] *= alpha; }
#pragma unroll
            for (int i = 0; i < 2; ++i)
#pragma unroll
                for (int sp = 0; sp < 2; ++sp) {
                    h8 pf;
#pragma unroll
                    for (int j = 0; j < 8; ++j) pf[j] = (hf)x[i][8 * sp + j];
#pragma unroll
                    for (int dt = 0; dt < 2; ++dt) {
                        const hf* vp = Vs + (32 * dt + ql) * VST + 32 * i + 16 * sp + 4 * h;
                        const h4 v0 = *(const h4*)vp, v1 = *(const h4*)(vp + 8);
                        h8 vf; vf[0] = v0[0]; vf[1] = v0[1]; vf[2] = v0[2]; vf[3] = v0[3]; vf[4] = v1[0]; vf[5] = v1[1]; vf[6] = v1[2]; vf[7] = v1[3];
                        o[dt] = MFMA32(vf, pf, o[dt]);
                    }
                }
        }
    }
    l += __shfl_xor(l, 32);
    const float inv = 1.f / l;
    hf* op = a.O + (size_t)(a.t0 + qrow) * 1024;
#pragma unroll
    for (int dt = 0; dt < 2; ++dt)
#pragma unroll
        for (int g = 0; g < 4; ++g) {
            h4 v; v[0] = (hf)(o[dt][4 * g] * inv); v[1] = (hf)(o[dt][4 * g + 1] * inv); v[2] = (hf)(o[dt][4 * g + 2] * inv); v[3] = (hf)(o[dt][4 * g + 3] * inv);
            *(h4*)(op + 32 * dt + 8 * g + 4 * h) = v;
        }
}


#define SBAR __builtin_amdgcn_sched_barrier(0)
DI void mla_item(const AttnArgs& a, char* smem) {
    constexpr int KROWB = 208, VROWB = 144;
    constexpr int KSLOT = 64 * KROWB, VSLOT = 64 * VROWB, SLOT = KSLOT + VSLOT, NST = 5, DUMP = NST * SLOT;
    LAS char* lds = (LAS char*)smem;
    const int tid = tid_opaque(), lane = tid & 63, wid = __builtin_amdgcn_readfirstlane(tid >> 6), ql = lane & 31, h = lane >> 5;
    const int qrow = 32 * wid + ql;
    h8 qf[6];
    {
        const hf* qp = a.Q + (size_t)(a.t0 + qrow) * a.qs + 8 * h;
#pragma unroll
        for (int s = 0; s < 6; ++s) qf[s] = *(const h8*)(qp + 16 * s);
    }
    float mref = 0.f, l = 0.f;
    f16v o0, o1;
#pragma unroll
    for (int e = 0; e < 16; ++e) { o0[e] = 0.f; o1[e] = 0.f; }
    const hf *kq0, *kq1, *vq0, *vq1; int kst0, kst1;
    {
        int row = tid / 13, kc = tid % 13; if (kc == 12) kc = 0;
        if (kc < 8) { kq0 = a.K + (size_t)row * a.ks + kc * 8; kst0 = a.ks; } else { kq0 = a.Kx + (size_t)row * 32 + (kc - 8) * 8; kst0 = 32; }
        const int p1 = tid + NT < 832 ? tid + NT : tid;
        row = p1 / 13; kc = p1 % 13; if (kc == 12) kc = 0;
        if (kc < 8) { kq1 = a.K + (size_t)row * a.ks + kc * 8; kst1 = a.ks; } else { kq1 = a.Kx + (size_t)row * 32 + (kc - 8) * 8; kst1 = 32; }
        int d = tid / 9, c = tid % 9; if (c == 8) c = 0;
        vq0 = a.Vt + (size_t)d * T + c * 8;
        const int p2 = tid + NT < 576 ? tid + NT : tid;
        d = p2 / 9; c = p2 % 9; if (c == 8) c = 0;
        vq1 = a.Vt + (size_t)d * T + c * 8;
    }
    const unsigned k1dst = wid < 5 ? (unsigned)(8192 + wid * 1024) : 0xffffffffu, v1dst = wid < 1 ? (unsigned)(KSLOT + 8192 + wid * 1024) : 0xffffffffu;
    auto issue = [&](int kt) {
        const int ktc = kt < a.nkt ? kt : a.nkt - 1;
        const size_t tok0 = (size_t)(a.kt0 + 64 * ktc);
        const unsigned sb = (unsigned)((kt % NST) * SLOT), dump = (unsigned)(DUMP + wid * 1024);
        __builtin_amdgcn_global_load_lds((const unsigned*)(kq0 + tok0 * kst0), (LAS unsigned*)(lds + sb + wid * 1024), 16, 0, 0);
        __builtin_amdgcn_global_load_lds((const unsigned*)(kq1 + tok0 * kst1), (LAS unsigned*)(lds + (k1dst != 0xffffffffu ? sb + k1dst : dump)), 16, 0, 0);
        __builtin_amdgcn_global_load_lds((const unsigned*)(vq0 + tok0), (LAS unsigned*)(lds + sb + KSLOT + wid * 1024), 16, 0, 0);
        __builtin_amdgcn_global_load_lds((const unsigned*)(vq1 + tok0), (LAS unsigned*)(lds + (v1dst != 0xffffffffu ? sb + v1dst : dump)), 16, 0, 0);
    };
    asm volatile("s_waitcnt vmcnt(0)" ::: "memory");
    __syncthreads();
    issue(0); issue(1); issue(2); issue(3);
    asm volatile("s_waitcnt vmcnt(8)" ::: "memory");
    __builtin_amdgcn_s_barrier();
    asm volatile("" ::: "memory");
    const int koff = ql * KROWB + 16 * h, voff = KSLOT + ql * VROWB + 8 * h;
#define KFR(slot, i, s) (*(const LAS h8*)(lds + (slot) * SLOT + koff + (i) * 32 * KROWB + 32 * (s)))
#define VLD(dst, slot, dt, i, sp) { const LAS char* vp_ = lds + (slot) * SLOT + voff + (dt) * 32 * VROWB + 64 * (i) + 32 * (sp); const h4 v0_ = *(const LAS h4*)vp_, v1_ = *(const LAS h4*)(vp_ + 16); \
        dst[0] = v0_[0]; dst[1] = v0_[1]; dst[2] = v0_[2]; dst[3] = v0_[3]; dst[4] = v1_[0]; dst[5] = v1_[1]; dst[6] = v1_[2]; dst[7] = v1_[3]; }
#define EX2(x, e, P, j) { const float p0_ = __builtin_amdgcn_exp2f(x[e]); const float p1_ = __builtin_amdgcn_exp2f(x[(e) + 1]); psA += p0_; psB += p1_; P[j] = (hf)p0_; P[(j) + 1] = (hf)p1_; }
    f16v xc0, xc1, xn0, xn1;
    {
#pragma unroll
        for (int e = 0; e < 16; ++e) { xc0[e] = 0.f; xc1[e] = 0.f; }
#pragma unroll
        for (int s = 0; s < 6; ++s) { const h8 kf = KFR(0, 0, s); xc0 = MFMA32(kf, qf[s], xc0); }
#pragma unroll
        for (int s = 0; s < 6; ++s) { const h8 kf = KFR(0, 1, s); xc1 = MFMA32(kf, qf[s], xc1); }
    }
    float tmax;
    {
        float mx = xc0[0];
#pragma unroll
        for (int e = 1; e < 16; ++e) mx = fmaxf(mx, xc0[e]);
#pragma unroll
        for (int e = 0; e < 16; ++e) mx = fmaxf(mx, xc1[e]);
        mx = fmaxf(mx, __shfl_xor(mx, 32));
        mref = mx;
#pragma unroll
        for (int e = 0; e < 16; ++e) { xc0[e] -= mx; xc1[e] -= mx; }
        tmax = 0.f;
    }
    int cb = 0;
    for (int kt = 0; kt + 1 < a.nkt; ++kt) {
        if (__any(tmax > 8.f)) {
            const float delta = tmax > 8.f ? tmax : 0.f;
            mref += delta;
            const float alpha = __builtin_amdgcn_exp2f(-delta);
            l *= alpha;
#pragma unroll
            for (int e = 0; e < 16; ++e) { xc0[e] -= delta; xc1[e] -= delta; o0[e] *= alpha; o1[e] *= alpha; }
        }
        const int nb = cb == NST - 1 ? 0 : cb + 1;
        issue(kt + 4);
        h8 kA0 = KFR(nb, 0, 0), kA1 = KFR(nb, 0, 1), kA2 = KFR(nb, 0, 2), kB0 = KFR(nb, 0, 3), kB1 = KFR(nb, 0, 4), kB2 = KFR(nb, 0, 5);
        const float ini = -mref;
#pragma unroll
        for (int e = 0; e < 16; ++e) { xn0[e] = ini; xn1[e] = ini; }
        float psA = 0.f, psB = 0.f;
        h8 P00, P01, P10, P11, vA0, vA1, vB0, vB1;
        SBAR;
        xn0 = MFMA32(kA0, qf[0], xn0); SBAR; EX2(xc0, 0, P00, 0); SBAR;
        xn0 = MFMA32(kA1, qf[1], xn0); SBAR; EX2(xc0, 2, P00, 2); SBAR;
        xn0 = MFMA32(kA2, qf[2], xn0); SBAR; kA0 = KFR(nb, 1, 0); kA1 = KFR(nb, 1, 1); kA2 = KFR(nb, 1, 2); EX2(xc0, 4, P00, 4); SBAR;
        xn0 = MFMA32(kB0, qf[3], xn0); SBAR; EX2(xc0, 6, P00, 6); SBAR;
        xn0 = MFMA32(kB1, qf[4], xn0); SBAR; EX2(xc0, 8, P01, 0); SBAR;
        xn0 = MFMA32(kB2, qf[5], xn0); SBAR; kB0 = KFR(nb, 1, 3); kB1 = KFR(nb, 1, 4); kB2 = KFR(nb, 1, 5); EX2(xc0, 10, P01, 2); SBAR;
        xn1 = MFMA32(kA0, qf[0], xn1); SBAR; EX2(xc0, 12, P01, 4); SBAR;
        xn1 = MFMA32(kA1, qf[1], xn1); SBAR; EX2(xc0, 14, P01, 6); SBAR;
        xn1 = MFMA32(kA2, qf[2], xn1); SBAR; VLD(vA0, cb, 0, 0, 0); VLD(vA1, cb, 1, 0, 0); EX2(xc1, 0, P10, 0); SBAR;
        xn1 = MFMA32(kB0, qf[3], xn1); SBAR; EX2(xc1, 2, P10, 2); SBAR;
        xn1 = MFMA32(kB1, qf[4], xn1); SBAR; VLD(vB0, cb, 0, 0, 1); VLD(vB1, cb, 1, 0, 1); EX2(xc1, 4, P10, 4); SBAR;
        xn1 = MFMA32(kB2, qf[5], xn1); SBAR; EX2(xc1, 6, P10, 6); SBAR;
        o0 = MFMA32(vA0, P00, o0); SBAR; EX2(xc1, 8, P11, 0); SBAR;
        o1 = MFMA32(vA1, P00, o1); SBAR; VLD(vA0, cb, 0, 1, 0); VLD(vA1, cb, 1, 1, 0); EX2(xc1, 10, P11, 2); SBAR;
        o0 = MFMA32(vB0, P01, o0); SBAR; EX2(xc1, 12, P11, 4); SBAR;
        o1 = MFMA32(vB1, P01, o1); SBAR; VLD(vB0, cb, 0, 1, 1); VLD(vB1, cb, 1, 1, 1); EX2(xc1, 14, P11, 6); SBAR;
        float mx;
        o0 = MFMA32(vA0, P10, o0); SBAR; mx = fmaxf(fmaxf(xn0[0], xn0[1]), xn0[2]); mx = fmaxf(fmaxf(mx, xn0[3]), xn0[4]); mx = fmaxf(fmaxf(mx, xn0[5]), xn0[6]); mx = fmaxf(fmaxf(mx, xn0[7]), xn0[8]); SBAR;
        o1 = MFMA32(vA1, P10, o1); SBAR; mx = fmaxf(fmaxf(mx, xn0[9]), xn0[10]); mx = fmaxf(fmaxf(mx, xn0[11]), xn0[12]); mx = fmaxf(fmaxf(mx, xn0[13]), xn0[14]); mx = fmaxf(fmaxf(mx, xn0[15]), xn1[0]); SBAR;
        o0 = MFMA32(vB0, P11, o0); SBAR; mx = fmaxf(fmaxf(mx, xn1[1]), xn1[2]); mx = fmaxf(fmaxf(mx, xn1[3]), xn1[4]); mx = fmaxf(fmaxf(mx, xn1[5]), xn1[6]); mx = fmaxf(fmaxf(mx, xn1[7]), xn1[8]); SBAR;
        o1 = MFMA32(vB1, P11, o1); SBAR; mx = fmaxf(fmaxf(mx, xn1[9]), xn1[10]); mx = fmaxf(fmaxf(mx, xn1[11]), xn1[12]); mx = fmaxf(fmaxf(mx, xn1[13]), xn1[14]); mx = fmaxf(mx, xn1[15]); SBAR;
        tmax = fmaxf(mx, __shfl_xor(mx, 32));
        l += psA + psB;
        asm volatile("s_waitcnt vmcnt(8)" ::: "memory");
        __builtin_amdgcn_s_barrier();
        asm volatile("" ::: "memory");
        xc0 = xn0; xc1 = xn1; cb = nb;
    }
    {
        if (__any(tmax > 8.f)) {
            const float delta = tmax > 8.f ? tmax : 0.f;
            mref += delta;
            const float alpha = __builtin_amdgcn_exp2f(-delta);
            l *= alpha;
#pragma unroll
            for (int e = 0; e < 16; ++e) { xc0[e] -= delta; xc1[e] -= delta; o0[e] *= alpha; o1[e] *= alpha; }
        }
        float psA = 0.f, psB = 0.f;
        h8 P00, P01, P10, P11, vA0, vA1;
        EX2(xc0, 0, P00, 0); EX2(xc0, 2, P00, 2); EX2(xc0, 4, P00, 4); EX2(xc0, 6, P00, 6);
        EX2(xc0, 8, P01, 0); EX2(xc0, 10, P01, 2); EX2(xc0, 12, P01, 4); EX2(xc0, 14, P01, 6);
        EX2(xc1, 0, P10, 0); EX2(xc1, 2, P10, 2); EX2(xc1, 4, P10, 4); EX2(xc1, 6, P10, 6);
        EX2(xc1, 8, P11, 0); EX2(xc1, 10, P11, 2); EX2(xc1, 12, P11, 4); EX2(xc1, 14, P11, 6);
        l += psA + psB;
        VLD(vA0, cb, 0, 0, 0); VLD(vA1, cb, 1, 0, 0); o0 = MFMA32(vA0, P00, o0); o1 = MFMA32(vA1, P00, o1);
        VLD(vA0, cb, 0, 0, 1); VLD(vA1, cb, 1, 0, 1); o0 = MFMA32(vA0, P01, o0); o1 = MFMA32(vA1, P01, o1);
        VLD(vA0, cb, 0, 1, 0); VLD(vA1, cb, 1, 1, 0); o0 = MFMA32(vA0, P10, o0); o1 = MFMA32(vA1, P10, o1);
        VLD(vA0, cb, 0, 1, 1); VLD(vA1, cb, 1, 1, 1); o0 = MFMA32(vA0, P11, o0); o1 = MFMA32(vA1, P11, o1);
    }
#undef KFR
#undef VLD
#undef EX2
    asm volatile("s_waitcnt vmcnt(0)" ::: "memory");
    l += __shfl_xor(l, 32);
    const float inv = 1.f / l;
    hf* op = a.O + (size_t)(a.t0 + qrow) * 1024;
#pragma unroll
    for (int g = 0; g < 4; ++g) {
        h4 v; v[0] = (hf)(o0[4 * g] * inv); v[1] = (hf)(o0[4 * g + 1] * inv); v[2] = (hf)(o0[4 * g + 2] * inv); v[3] = (hf)(o0[4 * g + 3] * inv);
        *(h4*)(op + 8 * g + 4 * h) = v;
        h4 w; w[0] = (hf)(o1[4 * g] * inv); w[1] = (hf)(o1[4 * g + 1] * inv); w[2] = (hf)(o1[4 * g + 2] * inv); w[3] = (hf)(o1[4 * g + 3] * inv);
        *(h4*)(op + 32 + 8 * g + 4 * h) = w;
    }
}

DI void mla_item64(const AttnArgs& a, char* smem) {
    constexpr int KROWB = 208, VROWB = 144;
    constexpr int KSLOT = 64 * KROWB, VSLOT = 64 * VROWB, SLOT = KSLOT + VSLOT, NST = 5, DUMP = NST * SLOT;
    LAS char* lds = (LAS char*)smem;
    const int tid = tid_opaque(), lane = tid & 63, wid = __builtin_amdgcn_readfirstlane(tid >> 6), ql = lane & 31, h = lane >> 5;
    const int rowA = 64 * wid + ql, rowB = rowA + 32;
    h8 qA[6], qB[6];
    {
        const hf* qp = a.Q + (size_t)(a.t0 + rowA) * a.qs + 8 * h;
#pragma unroll
        for (int s = 0; s < 6; ++s) { qA[s] = *(const h8*)(qp + 16 * s); qB[s] = *(const h8*)(qp + (size_t)32 * a.qs + 16 * s); }
    }
    float mA = NEG_BIG, lA = 0.f, mB = NEG_BIG, lB = 0.f;
    f16v oA0, oA1, oB0, oB1;
#pragma unroll
    for (int e = 0; e < 16; ++e) { oA0[e] = 0.f; oA1[e] = 0.f; oB0[e] = 0.f; oB1[e] = 0.f; }
    const hf *kq0, *kq1, *vq0, *vq1; int kst0, kst1;
    {
        int row = tid / 13, kc = tid % 13; if (kc == 12) kc = 0;
        if (kc < 8) { kq0 = a.K + (size_t)row * a.ks + kc * 8; kst0 = a.ks; } else { kq0 = a.Kx + (size_t)row * 32 + (kc - 8) * 8; kst0 = 32; }
        const int p1 = tid + NT < 832 ? tid + NT : tid;
        row = p1 / 13; kc = p1 % 13; if (kc == 12) kc = 0;
        if (kc < 8) { kq1 = a.K + (size_t)row * a.ks + kc * 8; kst1 = a.ks; } else { kq1 = a.Kx + (size_t)row * 32 + (kc - 8) * 8; kst1 = 32; }
        int d = tid / 9, c = tid % 9; if (c == 8) c = 0;
        vq0 = a.Vt + (size_t)d * T + c * 8;
        const int p2 = tid + NT < 576 ? tid + NT : tid;
        d = p2 / 9; c = p2 % 9; if (c == 8) c = 0;
        vq1 = a.Vt + (size_t)d * T + c * 8;
    }
    const unsigned k1dst = wid < 5 ? (unsigned)(8192 + wid * 1024) : 0xffffffffu, v1dst = wid < 1 ? (unsigned)(KSLOT + 8192 + wid * 1024) : 0xffffffffu;
    auto issue = [&](int kt) {
        const int ktc = kt < a.nkt ? kt : a.nkt - 1;
        const size_t tok0 = (size_t)(a.kt0 + 64 * ktc);
        const unsigned sb = (unsigned)((kt % NST) * SLOT), dump = (unsigned)(DUMP + wid * 1024);
        __builtin_amdgcn_global_load_lds((const unsigned*)(kq0 + tok0 * kst0), (LAS unsigned*)(lds + sb + wid * 1024), 16, 0, 0);
        __builtin_amdgcn_global_load_lds((const unsigned*)(kq1 + tok0 * kst1), (LAS unsigned*)(lds + (k1dst != 0xffffffffu ? sb + k1dst : dump)), 16, 0, 0);
        __builtin_amdgcn_global_load_lds((const unsigned*)(vq0 + tok0), (LAS unsigned*)(lds + sb + KSLOT + wid * 1024), 16, 0, 0);
        __builtin_amdgcn_global_load_lds((const unsigned*)(vq1 + tok0), (LAS unsigned*)(lds + (v1dst != 0xffffffffu ? sb + v1dst : dump)), 16, 0, 0);
    };
#pragma unroll
    for (int s = 0; s < 6; ++s) asm volatile("" :: "v"(qA[s]), "v"(qB[s]));
    asm volatile("s_waitcnt vmcnt(0)" ::: "memory");
    __syncthreads();
    issue(0); issue(1); issue(2); issue(3);
    asm volatile("s_waitcnt vmcnt(12)" ::: "memory");
    __builtin_amdgcn_s_barrier();
    asm volatile("" ::: "memory");
    const int koff = ql * KROWB + 16 * h, voff = KSLOT + ql * VROWB + 8 * h;
    int cb = 0;
    for (int kt = 0; kt < a.nkt; ++kt) {
        issue(kt + 4);
        const LAS char* kb = lds + cb * SLOT + koff;
        const LAS char* vb = lds + cb * SLOT + voff;
        f16v xA0, xA1, xB0, xB1;
#pragma unroll
        for (int e = 0; e < 16; ++e) { xA0[e] = 0.f; xA1[e] = 0.f; xB0[e] = 0.f; xB1[e] = 0.f; }
        h8 k0 = *(const LAS h8*)kb, k1 = *(const LAS h8*)(kb + 32 * KROWB);
#pragma unroll
        for (int s = 0; s < 6; ++s) {
            h8 n0 = k0, n1 = k1;
            if (s < 5) { n0 = *(const LAS h8*)(kb + 32 * (s + 1)); n1 = *(const LAS h8*)(kb + 32 * KROWB + 32 * (s + 1)); }
            xA0 = MFMA32(k0, qA[s], xA0); xB0 = MFMA32(k0, qB[s], xB0);
            xA1 = MFMA32(k1, qA[s], xA1); xB1 = MFMA32(k1, qB[s], xB1);
            k0 = n0; k1 = n1;
        }
        float alA, alB;
        {
            float mx = xA0[0];
#pragma unroll
            for (int e = 1; e < 16; ++e) mx = fmaxf(mx, xA0[e]);
#pragma unroll
            for (int e = 0; e < 16; ++e) mx = fmaxf(mx, xA1[e]);
            mx = fmaxf(mx, __shfl_xor(mx, 32));
            const float mn = fmaxf(mA, mx); alA = __builtin_amdgcn_exp2f(mA - mn); mA = mn;
            float ps = 0.f;
#pragma unroll
            for (int e = 0; e < 16; ++e) { const float p0 = __builtin_amdgcn_exp2f(xA0[e] - mn); xA0[e] = p0; const float p1 = __builtin_amdgcn_exp2f(xA1[e] - mn); xA1[e] = p1; ps += p0 + p1; }
            lA = lA * alA + ps;
#pragma unroll
            for (int e = 0; e < 16; ++e) { oA0[e] *= alA; oA1[e] *= alA; }
        }
        {
            float mx = xB0[0];
#pragma unroll
            for (int e = 1; e < 16; ++e) mx = fmaxf(mx, xB0[e]);
#pragma unroll
            for (int e = 0; e < 16; ++e) mx = fmaxf(mx, xB1[e]);
            mx = fmaxf(mx, __shfl_xor(mx, 32));
            const float mn = fmaxf(mB, mx); alB = __builtin_amdgcn_exp2f(mB - mn); mB = mn;
            float ps = 0.f;
#pragma unroll
            for (int e = 0; e < 16; ++e) { const float p0 = __builtin_amdgcn_exp2f(xB0[e] - mn); xB0[e] = p0; const float p1 = __builtin_amdgcn_exp2f(xB1[e] - mn); xB1[e] = p1; ps += p0 + p1; }
            lB = lB * alB + ps;
#pragma unroll
            for (int e = 0; e < 16; ++e) { oB0[e] *= alB; oB1[e] *= alB; }
        }
#pragma unroll
        for (int i = 0; i < 2; ++i)
#pragma unroll
            for (int sp = 0; sp < 2; ++sp) {
                h8 pA, pB;
#pragma unroll
                for (int j = 0; j < 8; ++j) { pA[j] = (hf)(i == 0 ? xA0[8 * sp + j] : xA1[8 * sp + j]); pB[j] = (hf)(i == 0 ? xB0[8 * sp + j] : xB1[8 * sp + j]); }
#pragma unroll
                for (int dt = 0; dt < 2; ++dt) {
                    const LAS char* vp = vb + dt * 32 * VROWB + 64 * i + 32 * sp;
                    const h4 v0 = *(const LAS h4*)vp, v1 = *(const LAS h4*)(vp + 16);
                    h8 vf; vf[0] = v0[0]; vf[1] = v0[1]; vf[2] = v0[2]; vf[3] = v0[3]; vf[4] = v1[0]; vf[5] = v1[1]; vf[6] = v1[2]; vf[7] = v1[3];
                    if (dt == 0) { oA0 = MFMA32(vf, pA, oA0); oB0 = MFMA32(vf, pB, oB0); } else { oA1 = MFMA32(vf, pA, oA1); oB1 = MFMA32(vf, pB, oB1); }
                }
            }
        asm volatile("s_waitcnt vmcnt(12)" ::: "memory");
        __builtin_amdgcn_s_barrier();
        asm volatile("" ::: "memory");
        cb = cb == NST - 1 ? 0 : cb + 1;
    }
    asm volatile("s_waitcnt vmcnt(0)" ::: "memory");
    lA += __shfl_xor(lA, 32); lB += __shfl_xor(lB, 32);
    const float ia = 1.f / lA, ib = 1.f / lB;
    hf* opA = a.O + (size_t)(a.t0 + rowA) * 1024; hf* opB = opA + (size_t)32 * 1024;
#pragma unroll
    for (int g = 0; g < 4; ++g) {
        h4 v;
        v[0] = (hf)(oA0[4 * g] * ia); v[1] = (hf)(oA0[4 * g + 1] * ia); v[2] = (hf)(oA0[4 * g + 2] * ia); v[3] = (hf)(oA0[4 * g + 3] * ia); *(h4*)(opA + 8 * g + 4 * h) = v;
        v[0] = (hf)(oA1[4 * g] * ia); v[1] = (hf)(oA1[4 * g + 1] * ia); v[2] = (hf)(oA1[4 * g + 2] * ia); v[3] = (hf)(oA1[4 * g + 3] * ia); *(h4*)(opA + 32 + 8 * g + 4 * h) = v;
        v[0] = (hf)(oB0[4 * g] * ib); v[1] = (hf)(oB0[4 * g + 1] * ib); v[2] = (hf)(oB0[4 * g + 2] * ib); v[3] = (hf)(oB0[4 * g + 3] * ib); *(h4*)(opB + 8 * g + 4 * h) = v;
        v[0] = (hf)(oB1[4 * g] * ib); v[1] = (hf)(oB1[4 * g + 1] * ib); v[2] = (hf)(oB1[4 * g + 2] * ib); v[3] = (hf)(oB1[4 * g + 3] * ib); *(h4*)(opB + 32 + 8 * g + 4 * h) = v;
    }
}

__device__ void phase_attn0(const Params& p, char* smem) {
    char* ws = p.ws;
    const int tid = tid_opaque();
    for (int it = blockIdx.x; it < 768 + 1536; it += gridDim.x) {
        AttnArgs a{};
        a.O = (hf*)(ws + OFF_AO);
        if (it < 768) {
            int head, s0, L, t0;
            if (it < 512) { const int u = (it & 7) + 8 * (it >> 7), qb = (it >> 3) & 15; const int sq = u >> 3; head = u & 7; s0 = sq * 8192; L = 8192; t0 = s0 + qb * 512; }
            else { const int j = it - 512; head = j & 7; s0 = TP; L = 16384; t0 = s0 + (j >> 3) * 512; }
            a.Q = (const hf*)p.out + head * 96; a.qs = 768;
            a.K = (const hf*)(ws + OFF_KN) + head * 64; a.ks = 512;
            a.Kx = (const hf*)(ws + OFF_KR);
            a.Vt = (const hf*)(ws + OFF_VMT) + (size_t)head * 64 * T;
            a.O += 512 + head * 64;
            a.t0 = t0; a.kt0 = s0; a.nkt = L / 64;
            mla_item64(a, smem);
        } else {
            const int i2 = it - 768, head = i2 & 7, qblk = i2 >> 3, t0 = qblk * 256;
            int s0, L; seq_of(t0, s0, L);
            const int rows = L / 64, R0 = (t0 - s0) / 64;
            int rs0 = R0 - 4; rs0 = rs0 < 0 ? 0 : (rs0 > rows - 8 ? rows - 8 : rs0);
            int rs1 = R0 + 3 - 4; rs1 = rs1 < 0 ? 0 : (rs1 > rows - 8 ? rows - 8 : rs1);
            __syncthreads();
            float* biasL = (float*)(smem + 24576);
            for (int i = tid; i < 465; i += NT) biasL[i] = p.in[3][head * 465 + i] * LOG2E;
            a.Q = (const hf*)(ws + OFF_QA) + head * 64; a.qs = 512;
            a.K = (const hf*)(ws + OFF_KA) + head * 64; a.ks = 512;
            a.Vt = (const hf*)(ws + OFF_VAT) + (size_t)head * 64 * T;
            a.O += head * 64;
            a.t0 = t0; a.kt0 = s0 + 64 * rs0; a.nkt = rs1 + 8 - rs0;
            a.R0 = R0; a.rows = rows; a.kr0 = rs0;
            attn_item<64, AT_NA>(a, smem);
        }
    }
}

DI void swa_item2(const AttnArgs& a, const hf* QB, hf* OB, float sinkB, char* smem) {
    constexpr int KST = 72, VST = 68;
    hf* Ks = (hf*)smem;
    hf* Vs = Ks + 64 * KST;
    const int tid = tid_opaque(), lane = tid & 63, wave = tid >> 6, ql = lane & 31, h = lane >> 5;
    const int qrow = 32 * wave + ql;
    h8 qa[4], qb[4];
    {
        const hf* pa = a.Q + (size_t)(a.t0 + qrow) * a.qs + 8 * h; const hf* pb = QB + (size_t)(a.t0 + qrow) * a.qs + 8 * h;
#pragma unroll
        for (int s = 0; s < 4; ++s) { qa[s] = *(const h8*)(pa + 16 * s); qb[s] = *(const h8*)(pb + 16 * s); }
    }
    float mA = a.sink, mB = sinkB, lA = (h == 0) ? 1.f : 0.f, lB = lA;
    f16v oA0, oA1, oB0, oB1;
#pragma unroll
    for (int e = 0; e < 16; ++e) { oA0[e] = 0.f; oA1[e] = 0.f; oB0[e] = 0.f; oB1[e] = 0.f; }
    const int pq = a.qpos0 + qrow, pqw = a.qpos0 + 32 * wave;
    const int krow = tid >> 3, kkc = tid & 7;
    const hf* kbase = a.K + (size_t)(a.kt0 + krow) * a.ks + kkc * 8;
    const hf* vbase = a.Vt + (size_t)krow * T + a.kt0 + kkc * 8;
    h8 rk = *(const h8*)kbase, rv = *(const h8*)vbase;
    for (int kt = 0; kt < a.nkt; ++kt) {
        __syncthreads();
        *(h8*)(Ks + krow * KST + kkc * 8) = rk;
        {
            h4 lo, hi; lo[0] = rv[0]; lo[1] = rv[1]; lo[2] = rv[2]; lo[3] = rv[3]; hi[0] = rv[4]; hi[1] = rv[5]; hi[2] = rv[6]; hi[3] = rv[7];
            *(h4*)(Vs + krow * VST + kkc * 8) = lo; *(h4*)(Vs + krow * VST + kkc * 8 + 4) = hi;
        }
        __syncthreads();
        if (kt + 1 < a.nkt) { rk = *(const h8*)(kbase + (size_t)(64 * (kt + 1)) * a.ks); rv = *(const h8*)(vbase + 64 * (kt + 1)); }
        const int pk0 = a.kpos0 + 64 * kt;
        if ((pk0 <= pqw + 31 + 128) && (pk0 + 63 >= pqw - 128)) {
            f16v xA0, xA1, xB0, xB1;
#pragma unroll
            for (int e = 0; e < 16; ++e) { xA0[e] = 0.f; xA1[e] = 0.f; xB0[e] = 0.f; xB1[e] = 0.f; }
            const hf* kp = Ks + ql * KST + 8 * h;
#pragma unroll
            for (int s = 0; s < 4; ++s) {
                const h8 k0 = *(const h8*)(kp + 16 * s), k1 = *(const h8*)(kp + 32 * KST + 16 * s);
                xA0 = MFMA32(k0, qa[s], xA0); xB0 = MFMA32(k0, qb[s], xB0);
                xA1 = MFMA32(k1, qa[s], xA1); xB1 = MFMA32(k1, qb[s], xB1);
            }
            if (!((pk0 >= pqw + 31 - 128) && (pk0 + 63 <= pqw + 128))) {
                const int base = pk0 + 4 * h - pq + 128;
#pragma unroll
                for (int e = 0; e < 16; ++e) {
                    const unsigned t0 = (unsigned)(base + (e & 3) + 8 * (e >> 2)), t1 = t0 + 32u;
                    if (t0 > 256u) { xA0[e] = NEG_BIG; xB0[e] = NEG_BIG; }
                    if (t1 > 256u) { xA1[e] = NEG_BIG; xB1[e] = NEG_BIG; }
                }
            }
            float mxa = xA0[0], mxb = xB0[0];
#pragma unroll
            for (int e = 1; e < 16; ++e) { mxa = fmaxf(mxa, xA0[e]); mxb = fmaxf(mxb, xB0[e]); }
#pragma unroll
            for (int e = 0; e < 16; ++e) { mxa = fmaxf(mxa, xA1[e]); mxb = fmaxf(mxb, xB1[e]); }
            const float pa_ = __shfl_xor(mxa, 32), pb_ = __shfl_xor(mxb, 32);
            const float mna = fmaxf(mA, fmaxf(mxa, pa_)), mnb = fmaxf(mB, fmaxf(mxb, pb_));
            const float alA = __builtin_amdgcn_exp2f(mA - mna), alB = __builtin_amdgcn_exp2f(mB - mnb); mA = mna; mB = mnb;
            float psa = 0.f, psb = 0.f;
#pragma unroll
            for (int e = 0; e < 16; ++e) {
                const float p0 = __builtin_amdgcn_exp2f(xA0[e] - mna), q0 = __builtin_amdgcn_exp2f(xB0[e] - mnb), p1 = __builtin_amdgcn_exp2f(xA1[e] - mna), q1 = __builtin_amdgcn_exp2f(xB1[e] - mnb);
                xA0[e] = p0; xB0[e] = q0; xA1[e] = p1; xB1[e] = q1; psa += p0 + p1; psb += q0 + q1;
            }
            lA = lA * alA + psa; lB = lB * alB + psb;
#pragma unroll
            for (int e = 0; e < 16; ++e) { oA0[e] *= alA; oB0[e] *= alB; oA1[e] *= alA; oB1[e] *= alB; }
#pragma unroll
            for (int i = 0; i < 2; ++i)
#pragma unroll
                for (int sp = 0; sp < 2; ++sp) {
                    h8 pA, pB;
#pragma unroll
                    for (int j = 0; j < 8; ++j) { pA[j] = (hf)(i == 0 ? xA0[8 * sp + j] : xA1[8 * sp + j]); pB[j] = (hf)(i == 0 ? xB0[8 * sp + j] : xB1[8 * sp + j]); }
#pragma unroll
                    for (int dt = 0; dt < 2; ++dt) {
                        const hf* vp = Vs + (32 * dt + ql) * VST + 32 * i + 16 * sp + 4 * h;
                        const h4 v0 = *(const h4*)vp, v1 = *(const h4*)(vp + 8);
                        h8 vf; vf[0] = v0[0]; vf[1] = v0[1]; vf[2] = v0[2]; vf[3] = v0[3]; vf[4] = v1[0]; vf[5] = v1[1]; vf[6] = v1[2]; vf[7] = v1[3];
                        if (dt == 0) { oA0 = MFMA32(vf, pA, oA0); oB0 = MFMA32(vf, pB, oB0); } else { oA1 = MFMA32(vf, pA, oA1); oB1 = MFMA32(vf, pB, oB1); }
                    }
                }
        }
    }
    lA += __shfl_xor(lA, 32); lB += __shfl_xor(lB, 32);
    const float ia = 1.f / lA, ib = 1.f / lB;
    hf* opA = a.O + (size_t)(a.t0 + qrow) * 1024; hf* opB = OB + (size_t)(a.t0 + qrow) * 1024;
#pragma unroll
    for (int g = 0; g < 4; ++g) {
        h4 v;
        v[0] = (hf)(oA0[4 * g] * ia); v[1] = (hf)(oA0[4 * g + 1] * ia); v[2] = (hf)(oA0[4 * g + 2] * ia); v[3] = (hf)(oA0[4 * g + 3] * ia); *(h4*)(opA + 8 * g + 4 * h) = v;
        v[0] = (hf)(oA1[4 * g] * ia); v[1] = (hf)(oA1[4 * g + 1] * ia); v[2] = (hf)(oA1[4 * g + 2] * ia); v[3] = (hf)(oA1[4 * g + 3] * ia); *(h4*)(opA + 32 + 8 * g + 4 * h) = v;
        v[0] = (hf)(oB0[4 * g] * ib); v[1] = (hf)(oB0[4 * g + 1] * ib); v[2] = (hf)(oB0[4 * g + 2] * ib); v[3] = (hf)(oB0[4 * g + 3] * ib); *(h4*)(opB + 8 * g + 4 * h) = v;
        v[0] = (hf)(oB1[4 * g] * ib); v[1] = (hf)(oB1[4 * g + 1] * ib); v[2] = (hf)(oB1[4 * g + 2] * ib); v[3] = (hf)(oB1[4 * g + 3] * ib); *(h4*)(opB + 32 + 8 * g + 4 * h) = v;
    }
}

__device__ void phase_attn1(const Params& p, char* smem) {
    char* ws = p.ws;
    for (int it = blockIdx.x; it < 192 * 8; it += gridDim.x) {
        const int pr = it & 7, hq = 2 * pr, qblk = it >> 3, t0 = qblk * 256, hkv = hq >> 2;
        int s0, L; seq_of(t0, s0, L);
        const int qpos0 = t0 - s0;
        const int ks = qpos0 - 128 < 0 ? 0 : qpos0 - 128, ke = qpos0 + 384 > L ? L : qpos0 + 384;
        AttnArgs a{};
        a.Q = (const hf*)(ws + OFF_Q1) + hq * 64; a.qs = 1024;
        a.K = (const hf*)(ws + OFF_K1) + hkv * 64; a.ks = 256;
        a.Vt = (const hf*)(ws + OFF_V1T) + (size_t)hkv * 64 * T;
        a.O = (hf*)(ws + OFF_AO) + hq * 64;
        a.t0 = t0; a.kt0 = s0 + ks; a.nkt = (ke - ks) / 64;
        a.qpos0 = qpos0; a.kpos0 = ks; a.sink = p.in[18][hq] * LOG2E;
        swa_item2(a, a.Q + 64, a.O + 64, p.in[18][hq + 1] * LOG2E, smem);
    }
}

__device__ void phase_ln(const Params& p, const float* g, const float* b, bool last) {
    const int lane = tid_opaque() & 63;
    const int gw = (blockIdx.x * NT + tid_opaque()) >> 6, nw = gridDim.x * (NT / 64);
    hf* Xh = (hf*)(p.ws + OFF_XH);
    f4 gg[4], bb[4];
#pragma unroll
    for (int i = 0; i < 2; ++i) { gg[2 * i] = *(const f4*)(g + i * 512 + lane * 8); gg[2 * i + 1] = *(const f4*)(g + i * 512 + lane * 8 + 4); bb[2 * i] = *(const f4*)(b + i * 512 + lane * 8); bb[2 * i + 1] = *(const f4*)(b + i * 512 + lane * 8 + 4); }
    for (int row = gw; row < T; row += nw) {
        hf* y = Xh + (size_t)row * DM;
        f4 v[4];
#pragma unroll
        for (int i = 0; i < 2; ++i) {
            const h8 hv = *(const h8*)(y + i * 512 + lane * 8);
            v[2 * i] = (f4){(float)hv[0], (float)hv[1], (float)hv[2], (float)hv[3]}; v[2 * i + 1] = (f4){(float)hv[4], (float)hv[5], (float)hv[6], (float)hv[7]};
        }
        float s = 0.f;
#pragma unroll
        for (int i = 0; i < 4; ++i) s += v[i][0] + v[i][1] + v[i][2] + v[i][3];
        const float mu = wave_sum(s) * (1.f / 1024.f);
        float q = 0.f;
#pragma unroll
        for (int i = 0; i < 4; ++i) { v[i] = v[i] - mu; q += v[i][0] * v[i][0] + v[i][1] * v[i][1] + v[i][2] * v[i][2] + v[i][3] * v[i][3]; }
        const float rstd = rsqrtf(wave_sum(q) * (1.f / 1024.f) + EPS);
#pragma unroll
        for (int i = 0; i < 2; ++i) {
            const f4 o0 = v[2 * i] * rstd * gg[2 * i] + bb[2 * i], o1 = v[2 * i + 1] * rstd * gg[2 * i + 1] + bb[2 * i + 1];
            if (last) { float* op = p.out + (size_t)row * DM + i * 512 + lane * 8; *(f4*)op = o0; *(f4*)(op + 4) = o1; }
            else *(h8*)(y + i * 512 + lane * 8) = cvt8(o0, o1, 1.f);
        }
    }
}


#define XB_TMO      128
#define XB_XCNT(j)  (256  + 64 * (j))
#define XB_XSUB(j)  (1280 + 64 * (j))
#define XB_XGEN(j)  (2304 + 64 * (j))
#define XB_TOP      3328
#define XB_TOPGEN   3392
#define XCD_BAR_WORDS 3456
#define XB_SPIN_CAP (1u << 18)
DI unsigned xb_ld(unsigned* p)              { return __hip_atomic_load(p, __ATOMIC_RELAXED, __HIP_MEMORY_SCOPE_AGENT); }
DI unsigned xb_add(unsigned* p, unsigned v) { return __hip_atomic_fetch_add(p, v, __ATOMIC_RELAXED, __HIP_MEMORY_SCOPE_AGENT); }
DI unsigned xb_xcc_id() { return (unsigned)__builtin_amdgcn_s_getreg((3 << 11) | 20) & 0xFu; }
#define XB_SPIN(cond, bar) do { unsigned _sp = 0; while (cond) { __builtin_amdgcn_s_sleep(1); \
    if ((++_sp & 255u) == 0u) { if (xb_ld(&(bar)[XB_TMO])) break; if (_sp > XB_SPIN_CAP) { atomicAdd(&(bar)[XB_TMO], 1u); break; } } } } while (0)
struct XcdBarrier { unsigned* bar; unsigned x; volatile LAS unsigned* st; };
DI XcdBarrier xcd_barrier_post(unsigned* bar, volatile LAS unsigned* st) {
    XcdBarrier b; b.bar = bar; b.x = xb_xcc_id(); b.st = st;
    if (threadIdx.x == 0) (void)xb_add(&bar[XB_XCNT(b.x)], 1u);
    return b;
}
DI void xcd_barrier_complete(unsigned* bar, unsigned x, unsigned& nloc, unsigned& nx) {
    const unsigned G = gridDim.x * gridDim.y * gridDim.z;
    unsigned sum, cnt, mine, sp = 0u;
    for (;;) {
        sum = 0u; cnt = 0u; mine = 0u;
#pragma unroll
        for (unsigned j = 0; j < 16; ++j) { const unsigned c = xb_ld(&bar[XB_XCNT(j)]); sum += c; cnt += (c > 0u) ? 1u : 0u; mine = (j == x) ? c : mine; }
        if (sum == G) break;
        __builtin_amdgcn_s_sleep(1);
        if ((++sp & 255u) == 0u) { if (xb_ld(&bar[XB_TMO])) break; if (sp > XB_SPIN_CAP) { atomicAdd(&bar[XB_TMO], 1u); break; } }
    }
    nloc = mine > 0u ? mine : 1u; nx = cnt > 0u ? cnt : 1u;
}
DI void xcd_barrier(const XcdBarrier& b) {
    asm volatile("s_waitcnt vmcnt(0)" ::: "memory");
    __syncthreads();
    if (threadIdx.x == 0) {
        unsigned* bar = b.bar;
        __builtin_amdgcn_s_waitcnt(0);
        unsigned nloc = b.st[0], nx = b.st[1];
        if (nloc == 0u) { xcd_barrier_complete(bar, b.x, nloc, nx); b.st[0] = nloc; b.st[1] = nx; }
        const unsigned old = xb_add(&bar[XB_XSUB(b.x)], 1u);
        const unsigned gen = old / nloc;
        if (old + 1u == (gen + 1u) * nloc) {
            __builtin_amdgcn_fence(__ATOMIC_RELEASE, "agent");
            asm volatile("s_waitcnt vmcnt(0)" ::: "memory");
            const unsigned og = xb_add(&bar[XB_TOP], 1u);
            const unsigned tg = og / nx;
            if (og + 1u == (tg + 1u) * nx) xb_add(&bar[XB_TOPGEN], 1u);
            else XB_SPIN(xb_ld(&bar[XB_TOPGEN]) == tg, bar);
            __builtin_amdgcn_fence(__ATOMIC_ACQUIRE, "agent");
            xb_add(&bar[XB_XGEN(b.x)], 1u);
            asm volatile("s_waitcnt vmcnt(0)" ::: "memory");
        } else {
            XB_SPIN(xb_ld(&bar[XB_XGEN(b.x)]) == gen, bar);
            __builtin_amdgcn_fence(__ATOMIC_ACQUIRE, "agent");
            asm volatile("s_waitcnt vmcnt(0)" ::: "memory");
        }
    }
    __syncthreads();
}

constexpr int NPHASE = 16;
template <int PH> DI void run_phase(const Params& p, char* smem) {
    char* ws = p.ws;
    if (PH == 0) phase_prep(p, smem);
    else if (PH == 1) phase_gemm<G_IN0>(p, smem, (const hf*)(ws + OFF_XH), 1024, (const hf*)(ws + OFF_WIN0), 9, nullptr, nullptr);
    else if (PH == 2) phase_gemm<G_UP>(p, smem, (const hf*)(ws + OFF_QL), 384, (const hf*)(ws + OFF_WQUP), 3, nullptr, nullptr);
    else if (PH == 3) phase_attn0(p, smem);
    else if (PH == 4) phase_gemm<G_RES>(p, smem, (const hf*)(ws + OFF_AO), 1024, (const hf*)(ws + OFF_WOUT0), 4, nullptr, nullptr);
    else if (PH == 5) phase_ln(p, p.in[9], p.in[10], false);
    else if (PH == 6) phase_gemm<G_FFN>(p, smem, (const hf*)(ws + OFF_XH), 1024, (const hf*)(ws + OFF_WUP0), 22, p.in[12], p.in[13]);
    else if (PH == 7) phase_gemm<G_RES>(p, smem, (const hf*)(ws + OFF_U), 2816, (const hf*)(ws + OFF_WDN0), 4, nullptr, nullptr);
    else if (PH == 8) phase_ln(p, p.in[15], p.in[16], false);
    else if (PH == 9) phase_gemm<G_IN1>(p, smem, (const hf*)(ws + OFF_XH), 1024, (const hf*)(ws + OFF_WIN1), 6, nullptr, nullptr);
    else if (PH == 10) phase_attn1(p, smem);
    else if (PH == 11) phase_gemm<G_RES>(p, smem, (const hf*)(ws + OFF_AO), 1024, (const hf*)(ws + OFF_WOUT1), 4, nullptr, nullptr);
    else if (PH == 12) phase_ln(p, p.in[20], p.in[21], false);
    else if (PH == 13) phase_gemm<G_FFN>(p, smem, (const hf*)(ws + OFF_XH), 1024, (const hf*)(ws + OFF_WUP1), 22, p.in[23], p.in[24]);
    else if (PH == 14) phase_gemm<G_RES>(p, smem, (const hf*)(ws + OFF_U), 2816, (const hf*)(ws + OFF_WDN1), 4, nullptr, nullptr);
    else if (PH == 15) phase_ln(p, p.in[26], p.in[27], true);
}

template <int LO, int HI> struct PhaseLoop {
    static DI void run(const Params& p, char* smem, const XcdBarrier& xb) {
        for (int r = 0; r < ((PROBE_MASK >> LO) & 1) + 1; ++r) run_phase<LO>(p, smem);
        if (LO + 1 < HI) {
            if (LO == 0) cg::this_grid().sync(); else xcd_barrier(xb);
            for (int r = 0; r < PROBE_SYNCS; ++r) xcd_barrier(xb);
            PhaseLoop<LO + 1, HI>::run(p, smem, xb);
        }
    }
};
template <int HI> struct PhaseLoop<HI, HI> { static DI void run(const Params&, char*, const XcdBarrier&) {} };

__global__ void __launch_bounds__(NT) mega_kernel(Params p) {
    extern __shared__ __attribute__((aligned(16))) char smem[];
    volatile LAS unsigned* st = (volatile LAS unsigned*)(LAS char*)(smem + LDS_BYTES);
    if (threadIdx.x == 0) { st[0] = 0u; st[1] = 0u; }
    __syncthreads();
    const XcdBarrier xb = xcd_barrier_post((unsigned*)(p.ws + OFF_BAR), st);
    PhaseLoop<0, NPHASE>::run(p, smem, xb);
}
extern "C" void kernel_launch(void* const* d_in, const int* in_sizes, int n_in, void* d_out, int out_size, void* d_ws, size_t ws_size, hipStream_t stream) {
    static int grid = 0;
    if (grid == 0) {
        if (n_in != 28 || out_size != T * DM || ws_size < WS_END) { fprintf(stderr, "kernel_launch: unexpected shapes (n_in %d out %d ws %zu need %zu)\n", n_in, out_size, ws_size, (size_t)WS_END); grid = -1; return; }
        int dev = 0, cus = 0, per_cu = 0;
        (void)hipGetDevice(&dev);
        (void)hipDeviceGetAttribute(&cus, hipDeviceAttributeMultiprocessorCount, dev);
        if (hipFuncSetAttribute((const void*)mega_kernel, hipFuncAttributeMaxDynamicSharedMemorySize, LDS_TOTAL) != hipSuccess) fprintf(stderr, "kernel_launch: hipFuncSetAttribute failed\n");
        if (hipOccupancyMaxActiveBlocksPerMultiprocessor(&per_cu, (const void*)mega_kernel, NT, LDS_TOTAL) != hipSuccess || per_cu < 1) { fprintf(stderr, "kernel_launch: occupancy query failed (%d)\n", per_cu); per_cu = 1; }
        grid = cus;
    }
    if (grid < 0) return;
    Params p{};
    for (int i = 0; i < 28; ++i) p.in[i] = (const float*)d_in[i];
    p.out = (float*)d_out; p.ws = (char*)d_ws;
#if MEGA
    if (hipMemsetAsync((char*)d_ws + OFF_BAR, 0, XCD_BAR_WORDS * 4, stream) != hipSuccess) { fprintf(stderr, "kernel_launch: hipMemsetAsync of the barrier words failed\n"); return; }
    void* args[] = {&p};
    hipError_t e = hipLaunchCooperativeKernel((const void*)mega_kernel, dim3(grid), dim3(NT), args, LDS_TOTAL, stream);
    if (e != hipSuccess) fprintf(stderr, "cooperative launch failed: %s (grid %d)\n", hipGetErrorString(e), grid);
#endif
}
```

```cpp
#include <hip/hip_runtime.h>
#include <hip/hip_cooperative_groups.h>
#include <cstdio>
namespace cg = cooperative_groups;

#ifndef PROBE_MASK
#define PROBE_MASK 0x0
#endif
#ifndef PROBE_SYNCS
#define PROBE_SYNCS 0
#endif
#ifndef MEGA
#define MEGA 1
#endif

typedef _Float16 hf;
typedef _Float16 h8 __attribute__((ext_vector_type(8)));
typedef _Float16 h4 __attribute__((ext_vector_type(4)));
typedef float f4 __attribute__((ext_vector_type(4)));
typedef float f16v __attribute__((ext_vector_type(16)));
#define MFMA32(a, b, c) __builtin_amdgcn_mfma_f32_32x32x16_f16((a), (b), (c), 0, 0, 0)
#define MFMA16(a, b, c) __builtin_amdgcn_mfma_f32_16x16x32_f16((a), (b), (c), 0, 0, 0)
#define DI __device__ __forceinline__
#define LAS __attribute__((address_space(3)))

constexpr int NT = 512;
constexpr int T = 49152;
constexpr int TP = 32768;
constexpr int DM = 1024;
constexpr int DFF = 2816;
constexpr float LOG2E = 1.4426950408889634f;
constexpr float ALPHA = 1.4142135623730951f;
constexpr float EPS = 1e-5f;
constexpr float NEG_BIG = -1e30f;

constexpr size_t SZ_WIN0 = (size_t)2304 * 1024 * 2, SZ_WQUP = (size_t)768 * 384 * 2, SZ_WKVUP = (size_t)1024 * 256 * 2,
                 SZ_WOUT = (size_t)1024 * 1024 * 2, SZ_WUP = (size_t)5632 * 1024 * 2, SZ_WDN = (size_t)1024 * 2816 * 2,
                 SZ_WIN1 = (size_t)1536 * 1024 * 2;
constexpr size_t OFF_WIN0 = 0, OFF_WQUP = OFF_WIN0 + SZ_WIN0, OFF_WKVUP = OFF_WQUP + SZ_WQUP, OFF_WOUT0 = OFF_WKVUP + SZ_WKVUP,
                 OFF_WUP0 = OFF_WOUT0 + SZ_WOUT, OFF_WDN0 = OFF_WUP0 + SZ_WUP, OFF_WIN1 = OFF_WDN0 + SZ_WDN, OFF_WOUT1 = OFF_WIN1 + SZ_WIN1,
                 OFF_WUP1 = OFF_WOUT1 + SZ_WOUT, OFF_WDN1 = OFF_WUP1 + SZ_WUP, OFF_ROPEM = OFF_WDN1 + SZ_WDN;
constexpr size_t SZ_ROPEM = (size_t)16384 * 16 * 4 * 2, SZ_ROPEG = (size_t)16384 * 8 * 4 * 2;
constexpr size_t OFF_ROPEG = OFF_ROPEM + SZ_ROPEM, OFF_SS = OFF_ROPEG + SZ_ROPEG, SZ_SS = (size_t)T * 8 * 4;
constexpr size_t OFF_R1 = OFF_SS + SZ_SS, SZ_R1 = (size_t)T * 1024 * 2;
constexpr size_t OFF_R2 = OFF_R1 + SZ_R1, SZ_R2 = (size_t)T * 1024 * 2;
constexpr size_t OFF_R3 = OFF_R2 + SZ_R2, SZ_R3 = (size_t)T * 2816 * 2;
constexpr size_t OFF_BAR = OFF_R3 + SZ_R3;
constexpr size_t WS_END = OFF_BAR + 16384;
constexpr size_t OFF_XH = OFF_R1, OFF_QM = OFF_R1;
constexpr size_t OFF_AO = OFF_R2, OFF_QL = OFF_R2, OFF_KVL = OFF_R2 + (size_t)T * 384 * 2;
constexpr size_t OFF_U = OFF_R3;
constexpr size_t OFF_QA = OFF_R3, OFF_KA = OFF_QA + (size_t)T * 512 * 2, OFF_VAT = OFF_KA + (size_t)T * 512 * 2, OFF_KN = OFF_VAT + (size_t)T * 512 * 2,
                 OFF_VMT = OFF_KN + (size_t)T * 512 * 2, OFF_KR = OFF_VMT + (size_t)T * 512 * 2;
constexpr size_t OFF_Q1 = OFF_R3, OFF_K1 = OFF_Q1 + (size_t)T * 1024 * 2, OFF_V1T = OFF_K1 + (size_t)T * 256 * 2;
static_assert(OFF_KR + (size_t)T * 32 * 2 <= WS_END, "L0 attention buffers overflow R3");
static_assert(OFF_V1T + (size_t)T * 256 * 2 <= WS_END, "L1 attention buffers overflow R3");

constexpr int CST = 132;
constexpr int LDS_BYTES = 256 * CST * 4;
constexpr int SWA_TILE = 64 * 72 * 2 + 64 * 68 * 2;
constexpr int LDS_ST = 8 * SWA_TILE;
constexpr int LDS_TOTAL = LDS_ST + 16;

static_assert(LDS_ST >= LDS_BYTES, "barrier words must sit behind every phase's LDS image");
struct Params {
    const float* in[28];
    float* out;
    char* ws;
};

DI void seq_of(int t, int& s0, int& L) { if (t < TP) { s0 = t & ~8191; L = 8192; } else { s0 = TP; L = 16384; } }
DI const float* xrow(const Params& p, int t) { return t < TP ? p.in[0] + (size_t)t * DM : p.in[1] + (size_t)(t - TP) * DM; }
DI h8 cvt8(f4 a, f4 b, float s) { h8 v; v[0] = (hf)(a[0] * s); v[1] = (hf)(a[1] * s); v[2] = (hf)(a[2] * s); v[3] = (hf)(a[3] * s); v[4] = (hf)(b[0] * s); v[5] = (hf)(b[1] * s); v[6] = (hf)(b[2] * s); v[7] = (hf)(b[3] * s); return v; }
DI int tid_opaque() { int t = threadIdx.x; asm volatile("" : "+v"(t)); return t; }
DI float wave_sum(float v) { v += __shfl_xor(v, 32); v += __shfl_xor(v, 16); v += __shfl_xor(v, 8); v += __shfl_xor(v, 4); v += __shfl_xor(v, 2); v += __shfl_xor(v, 1); return v; }

DI void prep_weight(const float* __restrict__ src, const float* __restrict__ g, hf* __restrict__ dst, int K, int Nsrc, int Npad, int mode, char* smem) {
    hf* tl = (hf*)smem;
    const int tid = tid_opaque(), nn = tid & 63, kq = tid >> 6, on = tid >> 3, oc = tid & 7;
    const int ntn = Npad >> 6, ntk = K >> 6;
    for (int tile = blockIdx.x; tile < ntn * ntk; tile += gridDim.x) {
        const int tn = tile % ntn, tk = tile / ntn, n0 = tn * 64, k0 = tk * 64;
        int c0 = n0;
        if (mode == 1) { const int t = n0 >> 7; c0 = (n0 & 64) ? (DFF + t * 64) : (t * 64); }
        const int col = c0 + nn;
        __syncthreads();
#pragma unroll
        for (int r = 0; r < 8; ++r) {
            const int kk = kq + 8 * r;
            float x = 0.f;
            if (col < Nsrc) { x = src[(size_t)(k0 + kk) * Nsrc + col]; if (g) x *= g[k0 + kk]; }
            tl[nn * 72 + kk] = (hf)x;
        }
        __syncthreads();
        *(h8*)(dst + (size_t)(n0 + on) * K + k0 + oc * 8) = *(const h8*)(tl + on * 72 + oc * 8);
    }
}

__device__ void phase_prep(const Params& p, char* smem) {
    const long gtid = (long)blockIdx.x * NT + tid_opaque(), gs = (long)gridDim.x * NT;
    char* ws = p.ws;
    prep_weight(p.in[2], nullptr, (hf*)(ws + OFF_WIN0), 1024, 2208, 2304, 0, smem);
    prep_weight(p.in[5], p.in[4], (hf*)(ws + OFF_WQUP), 384, 768, 768, 0, smem);
    prep_weight(p.in[7], p.in[6], (hf*)(ws + OFF_WKVUP), 256, 1024, 1024, 0, smem);
    prep_weight(p.in[8], nullptr, (hf*)(ws + OFF_WOUT0), 1024, 1024, 1024, 0, smem);
    prep_weight(p.in[11], nullptr, (hf*)(ws + OFF_WUP0), 1024, 5632, 5632, 1, smem);
    prep_weight(p.in[14], nullptr, (hf*)(ws + OFF_WDN0), 2816, 1024, 1024, 0, smem);
    prep_weight(p.in[17], nullptr, (hf*)(ws + OFF_WIN1), 1024, 1536, 1536, 0, smem);
    prep_weight(p.in[19], nullptr, (hf*)(ws + OFF_WOUT1), 1024, 1024, 1024, 0, smem);
    prep_weight(p.in[22], nullptr, (hf*)(ws + OFF_WUP1), 1024, 5632, 5632, 1, smem);
    prep_weight(p.in[25], nullptr, (hf*)(ws + OFF_WDN1), 2816, 1024, 1024, 0, smem);
    hf* xh = (hf*)(ws + OFF_XH);
    for (long idx = gtid; idx < (long)T * 128; idx += gs) {
        const int t = (int)(idx >> 7), c = (int)(idx & 127) * 8;
        const float* xr = xrow(p, t) + c;
        const f4 a = *(const f4*)xr, b = *(const f4*)(xr + 4);
        *(h8*)(xh + (size_t)t * DM + c) = cvt8(a, b, 1.f);
    }
    float* rm = (float*)(ws + OFF_ROPEM); float* rg = (float*)(ws + OFF_ROPEG);
    for (long idx = gtid; idx < 16384L * 24; idx += gs) {
        const int pos = (int)(idx / 24), i = (int)(idx % 24);
        double inv;
        if (i < 16) inv = exp2(-(double)i / 16.0 * 13.287712379549449);
        else inv = exp2(-(double)(i - 16) / 8.0 * 18.931568569324174);
        const float angf = (float)pos * (float)inv;
        const double ang = (double)angf;
        const float c = (float)cos(ang), s = (float)sin(ang);
        if (i < 16) { rm[(size_t)pos * 32 + i] = c; rm[(size_t)pos * 32 + 16 + i] = s; }
        else { rg[(size_t)pos * 16 + (i - 16)] = c; rg[(size_t)pos * 16 + 8 + (i - 16)] = s; }
    }
}

constexpr int HTB = 128 * 64 * 2;
DI int lds_byte(int r, int c) { const int st = (r >> 4) * 2 + (c >> 5), rr = r & 15, cc = c & 31, ob = rr * 64 + cc * 2; return st * 1024 + (ob ^ (((ob >> 9) & 1) << 5)); }
DI void stage_rc(int b, int& R, int& C) { const int st = b / 1024, sb = b % 1024, swz = sb ^ (((sb >> 9) & 1) << 5); R = (st >> 1) * 16 + swz / 64; C = (st & 1) * 32 + (swz % 64) / 2; }

DI void tile_coords(int L, int nM, int nN, int& pm, int& pn) {
    const int nwg = nM * nN;
    int wgid = L; { const int q = nwg / 8, r = nwg % 8, xcd = wgid % 8, off = wgid / 8; wgid = (xcd < r ? xcd * (q + 1) : r * (q + 1) + (xcd - r) * q) + off; }
    const int nig = 8 * nN, gid = wgid / nig, fm = gid * 8, gsz = (nM - fm) < 8 ? (nM - fm) : 8;
    pm = fm + ((wgid % nig) % gsz); pn = (wgid % nig) / gsz;
}

DI void gemm256(const hf* __restrict__ A, int lda, int arow0, const hf* __restrict__ Bt, int K, int bcol, LAS char* lds, f4 (&acc)[2][2][4][2]) {
    const int tid = tid_opaque(), wid = __builtin_amdgcn_readfirstlane(tid >> 6), lane = tid & 63, wr = wid >> 2, wc = wid & 3, fr = lane & 15, fq = lane >> 4;
    const int nt = K >> 6;
    unsigned offA[2], offB[2];
#pragma unroll
    for (int i = 0; i < 2; ++i) {
        int R, C; stage_rc(tid * 16 + i * 8192, R, C);
        offA[i] = (unsigned)(R * lda + C) * 2u;
        offB[i] = (unsigned)(R * K + C) * 2u;
    }
    const char* Ab = (const char*)(A + (long)arow0 * lda);
    const char* Bb = (const char*)(Bt + (long)bcol * K);
    const size_t hA = (size_t)128 * lda * 2, hB = (size_t)128 * K * 2;
    const unsigned ldsw = (unsigned)wid * 1024u;
    const int aoff = lds_byte(wr * 64 + fr, fq * 8), boff = lds_byte(wc * 32 + fr, fq * 8);
#define SA(b, h) (((b) * 2 + (h)) * HTB)
#define SB(b, h) ((4 + (b) * 2 + (h)) * HTB)
#define STAGE_A(b, h, kt) do { _Pragma("unroll") for (int _i = 0; _i < 2; ++_i) \
        __builtin_amdgcn_global_load_lds((const unsigned*)(Ab + (h) * hA + (size_t)(kt) * 128 + offA[_i]), (LAS unsigned*)(lds + SA(b, h) + ldsw + _i * 8192), 16, 0, 0); } while (0)
#define STAGE_B(b, h, kt) do { _Pragma("unroll") for (int _i = 0; _i < 2; ++_i) \
        __builtin_amdgcn_global_load_lds((const unsigned*)(Bb + (h) * hB + (size_t)(kt) * 128 + offB[_i]), (LAS unsigned*)(lds + SB(b, h) + ldsw + _i * 8192), 16, 0, 0); } while (0)
#define LDA(dst, b, h) do { _Pragma("unroll") for (int m = 0; m < 4; ++m) _Pragma("unroll") for (int k = 0; k < 2; ++k) dst[m][k] = *(const LAS h8*)(lds + SA(b, h) + aoff + m * 2048 + k * 1024); } while (0)
#define LDB(dst, b, h) do { _Pragma("unroll") for (int n = 0; n < 2; ++n) _Pragma("unroll") for (int k = 0; k < 2; ++k) dst[n][k] = *(const LAS h8*)(lds + SB(b, h) + boff + n * 2048 + k * 1024); } while (0)
#define MMA(ai, bj, At_, Bt_) do { __builtin_amdgcn_s_setprio(1); _Pragma("unroll") for (int m = 0; m < 4; ++m) _Pragma("unroll") for (int n = 0; n < 2; ++n) _Pragma("unroll") for (int k = 0; k < 2; ++k) \
        acc[ai][bj][m][n] = MFMA16(At_[m][k], Bt_[n][k], acc[ai][bj][m][n]); __builtin_amdgcn_s_setprio(0); } while (0)
#define WAIT_V(n) asm volatile("s_waitcnt vmcnt(" #n ")" ::: "memory")
#define WAIT_L(n) asm volatile("s_waitcnt lgkmcnt(" #n ")" ::: "memory")
#define BAR __builtin_amdgcn_s_barrier()
#define SCHED __builtin_amdgcn_sched_barrier(0)
#pragma unroll
    for (int a_ = 0; a_ < 2; ++a_)
#pragma unroll
        for (int b_ = 0; b_ < 2; ++b_)
#pragma unroll
            for (int m = 0; m < 4; ++m)
#pragma unroll
                for (int n = 0; n < 2; ++n) acc[a_][b_][m][n] = (f4){0.f, 0.f, 0.f, 0.f};
    h8 At[4][2], B0[2][2], B1[2][2];
    WAIT_V(0);
    __syncthreads();
    STAGE_B(0, 0, 0); STAGE_A(0, 0, 0);
    STAGE_B(0, 1, 0); STAGE_A(0, 1, 0);
    if (wr == 1) BAR;
    WAIT_V(4); BAR;
    STAGE_B(1, 0, 1); STAGE_A(1, 0, 1); STAGE_B(1, 1, 1);
    WAIT_V(6); BAR;
    for (int t = 0; t < nt - 2; t += 2) {
        LDB(B0, 0, 0); SCHED; LDA(At, 0, 0); STAGE_A(1, 1, t + 1);
        WAIT_L(8); BAR; WAIT_L(0); MMA(0, 0, At, B0); BAR; SCHED;
        LDB(B1, 0, 1); STAGE_B(0, 0, t + 2);
        BAR; WAIT_L(0); MMA(0, 1, At, B1); BAR;
        LDA(At, 0, 1); STAGE_A(0, 0, t + 2);
        BAR; WAIT_L(0); MMA(1, 0, At, B0); BAR; SCHED;
        STAGE_B(0, 1, t + 2);
        WAIT_V(6); BAR; MMA(1, 1, At, B1); BAR;
        LDB(B0, 1, 0); SCHED; LDA(At, 1, 0); STAGE_A(0, 1, t + 2);
        WAIT_L(8); BAR; WAIT_L(0); MMA(0, 0, At, B0); BAR; SCHED;
        LDB(B1, 1, 1); STAGE_B(1, 0, t + 3);
        BAR; WAIT_L(0); MMA(0, 1, At, B1); BAR;
        LDA(At, 1, 1); STAGE_A(1, 0, t + 3);
        BAR; WAIT_L(0); MMA(1, 0, At, B0); BAR; SCHED;
        STAGE_B(1, 1, t + 3);
        WAIT_V(6); BAR; MMA(1, 1, At, B1); BAR;
    }
    { LDB(B0, 0, 0); LDA(At, 0, 0); STAGE_A(1, 1, nt - 1);
      BAR; WAIT_L(0); MMA(0, 0, At, B0); BAR;
      LDB(B1, 0, 1); BAR; WAIT_L(0); MMA(0, 1, At, B1); BAR;
      LDA(At, 0, 1); WAIT_V(4); BAR; WAIT_L(0); MMA(1, 0, At, B0); MMA(1, 1, At, B1); BAR; }
    { LDB(B0, 1, 0); LDA(At, 1, 0); WAIT_V(2); BAR; WAIT_L(0); MMA(0, 0, At, B0); BAR;
      LDB(B1, 1, 1); WAIT_V(0); BAR; WAIT_L(0); MMA(0, 1, At, B1); BAR;
      LDA(At, 1, 1); BAR; WAIT_L(0); MMA(1, 0, At, B0); MMA(1, 1, At, B1); BAR; }
    if (wr == 0) BAR;
#undef SA
#undef SB
#undef STAGE_A
#undef STAGE_B
#undef LDA
#undef LDB
#undef MMA
}

template <int BJ> DI void stage_half(const f4 (&acc)[2][2][4][2], float* C) {
    __syncthreads();
    const int tid = tid_opaque(), wid = tid >> 6, lane = tid & 63, wr = wid >> 2, wc = wid & 3, fr = lane & 15, fq = lane >> 4;
#pragma unroll
    for (int ai = 0; ai < 2; ++ai)
#pragma unroll
        for (int m = 0; m < 4; ++m)
#pragma unroll
            for (int n = 0; n < 2; ++n)
#pragma unroll
                for (int j = 0; j < 4; ++j) C[(ai * 128 + wr * 64 + m * 16 + fq * 4 + j) * CST + wc * 32 + n * 16 + fr] = acc[ai][BJ][m][n][j];
    __syncthreads();
}

DI void ld8(const float* C, int r, int c, f4& a, f4& b) { a = *(const f4*)(C + r * CST + c); b = *(const f4*)(C + r * CST + c + 4); }

template <int NCOLS, bool RSCALE>
DI void store_transposed(const float* C, int c0, hf* dst  , int tok0) {
    const int tid = tid_opaque();
    const int col = tid % NCOLS, rc0 = tid / NCOLS;
    constexpr int STEP = NT / NCOLS;
#pragma unroll
    for (int rc = rc0; rc < 32; rc += STEP) {
        h8 v;
#pragma unroll
        for (int j = 0; j < 8; ++j) { float x = C[(8 * rc + j) * CST + c0 + col]; if (RSCALE) x *= C[(8 * rc + j) * CST + 128]; v[j] = (hf)x; }
        *(h8*)(dst + (size_t)col * T + tok0 + 8 * rc) = v;
    }
}

DI void epi_in0(const Params& p, const float* C, int m0, int tn) {
    char* ws = p.ws;
    hf* Qa = (hf*)(ws + OFF_QA); hf* Ka = (hf*)(ws + OFF_KA); hf* VaT = (hf*)(ws + OFF_VAT);
    hf* QL = (hf*)(ws + OFF_QL); hf* KVL = (hf*)(ws + OFF_KVL); hf* Kr = (hf*)(ws + OFF_KR);
    float* SS = (float*)(ws + OFF_SS); const float* rm = (const float*)(ws + OFF_ROPEM);
    const int tid = tid_opaque(), cc = tid & 15, rb = tid >> 4;
    if (tn >= 8 && tn < 12) {
        store_transposed<128, false>(C, 0, VaT + (size_t)(tn - 8) * 128 * T, m0);
    } else if (tn == 17) {
        if (cc < 2) {
            int s0, L; seq_of(m0, s0, L);
#pragma unroll
            for (int i = 0; i < 8; ++i) {
                const int r = rb + 32 * i, t = m0 + r, pos = t - s0;
                f4 a0, a1, b0, b1; ld8(C, r, 8 * cc, a0, a1); ld8(C, r, 16 + 8 * cc, b0, b1);
                const float* cs = rm + (size_t)pos * 32 + 8 * cc;
                h8 o1, o2;
#pragma unroll
                for (int j = 0; j < 8; ++j) {
                    const float x1 = j < 4 ? a0[j & 3] : a1[j & 3], x2 = j < 4 ? b0[j & 3] : b1[j & 3];
                    const float c = cs[j], s = cs[16 + j];
                    o1[j] = (hf)(x1 * c - x2 * s); o2[j] = (hf)(x2 * c + x1 * s);
                }
                *(h8*)(Kr + (size_t)t * 32 + 8 * cc) = o1; *(h8*)(Kr + (size_t)t * 32 + 16 + 8 * cc) = o2;
            }
        }
    } else {
        hf* dst; int ld, cbase, ssidx = -1; float scale = 1.f;
        if (tn < 4) { dst = Qa; ld = 512; cbase = tn * 128; scale = 0.125f * LOG2E; }
        else if (tn < 8) { dst = Ka; ld = 512; cbase = (tn - 4) * 128; }
        else if (tn < 15) { dst = QL; ld = 384; cbase = (tn - 12) * 128; ssidx = tn - 12; }
        else { dst = KVL; ld = 256; cbase = (tn - 15) * 128; ssidx = 3 + (tn - 15); }
#pragma unroll
        for (int i = 0; i < 8; ++i) {
            const int r = rb + 32 * i, t = m0 + r;
            f4 a, b; ld8(C, r, 8 * cc, a, b);
            *(h8*)(dst + (size_t)t * ld + cbase + 8 * cc) = cvt8(a, b, scale);
            if (ssidx >= 0) {
                float ss = a[0] * a[0] + a[1] * a[1] + a[2] * a[2] + a[3] * a[3] + b[0] * b[0] + b[1] * b[1] + b[2] * b[2] + b[3] * b[3];
                ss += __shfl_xor(ss, 1); ss += __shfl_xor(ss, 2); ss += __shfl_xor(ss, 4); ss += __shfl_xor(ss, 8);
                if (cc == 0) SS[(size_t)t * 8 + ssidx] = ss;
            }
        }
    }
}

DI void epi_qup(const Params& p, float* C, int m0, int tn) {
    char* ws = p.ws;
    hf* Qm = (hf*)p.out;
    const float* SS = (const float*)(ws + OFF_SS); const float* rm = (const float*)(ws + OFF_ROPEM);
    const int tid = tid_opaque();
    const float QSC = 0.10206207261596575f * LOG2E;
    if (tid < 256) { const float* s = SS + (size_t)(m0 + tid) * 8; C[tid * CST + 128] = rsqrtf((s[0] + s[1] + s[2]) * (1.f / 384.f) + EPS); }
    __syncthreads();
    const int cc = tid & 15, rb = tid >> 4;
    const int n = tn * 128 + 8 * cc, hd = n / 96, w = n - hd * 96;
    int s0, L; seq_of(m0, s0, L);
#pragma unroll
    for (int i = 0; i < 8; ++i) {
        const int r = rb + 32 * i, t = m0 + r, pos = t - s0;
        const float rq = C[r * CST + 128] * QSC;
        f4 a, b; ld8(C, r, 8 * cc, a, b);
        if (w >= 64) {
            const int iw = w - 64;
            f4 pa, pb;
            if (iw < 16) ld8(C, r, 8 * cc + 16, pa, pb); else ld8(C, r, 8 * cc - 16, pa, pb);
            const float* cs = rm + (size_t)pos * 32 + (iw & 15);
            const float sg = iw < 16 ? -1.f : 1.f;
#pragma unroll
            for (int j = 0; j < 4; ++j) {
                a[j] = a[j] * cs[j] + sg * pa[j] * cs[16 + j];
                b[j] = b[j] * cs[4 + j] + sg * pb[j] * cs[20 + j];
            }
        }
        *(h8*)(Qm + (size_t)t * 768 + n) = cvt8(a, b, rq);
    }
}
DI void epi_kvup(const Params& p, float* C, int m0, int tn  ) {
    char* ws = p.ws;
    hf* Kn = (hf*)(ws + OFF_KN); hf* VmT = (hf*)(ws + OFF_VMT);
    const float* SS = (const float*)(ws + OFF_SS);
    const int tid = tid_opaque();
    if (tid < 256) { const float* s = SS + (size_t)(m0 + tid) * 8; C[tid * CST + 128] = rsqrtf((s[3] + s[4]) * (1.f / 256.f) + EPS); }
    __syncthreads();
    const int cc = tid & 7, rb = tid >> 3;
#pragma unroll
    for (int i = 0; i < 4; ++i) {
        const int r = rb + 64 * i, t = m0 + r;
        f4 a, b; ld8(C, r, 8 * cc, a, b);
        *(h8*)(Kn + (size_t)t * 512 + tn * 64 + 8 * cc) = cvt8(a, b, C[r * CST + 128]);
    }
    store_transposed<64, true>(C, 64, VmT + (size_t)tn * 64 * T, m0);
}

DI void epi_res(const Params& p, const float* C, int m0, int tn, bool res_from_input) {
    const int tid = tid_opaque(), cc = tid & 15, rb = tid >> 4;
    hf* Xh = (hf*)(p.ws + OFF_XH);
#pragma unroll
    for (int i = 0; i < 8; ++i) {
        const int r = rb + 32 * i, t = m0 + r, n = tn * 128 + 8 * cc;
        f4 a, b; ld8(C, r, 8 * cc, a, b);
        hf* yp = Xh + (size_t)t * DM + n;
        f4 r0, r1;
        if (res_from_input) { const float* rp = xrow(p, t) + n; r0 = *(const f4*)rp; r1 = *(const f4*)(rp + 4); }
        else { const h8 rv = *(const h8*)yp; r0 = (f4){(float)rv[0], (float)rv[1], (float)rv[2], (float)rv[3]}; r1 = (f4){(float)rv[4], (float)rv[5], (float)rv[6], (float)rv[7]}; }
        *(h8*)yp = cvt8(r0 * ALPHA + a, r1 * ALPHA + b, 1.f);
    }
}

DI float gelu_exact(float v) {
    const float t = __builtin_amdgcn_rcpf(fmaf(fabsf(v), 0.2316418882f, 1.0f));
    float q = fmaf(t, 0.5307027145f, -0.7265760135f); q = fmaf(q, t, 0.7107068705f); q = fmaf(q, t, -0.142248368f); q = fmaf(q, t, 0.127414796f); q *= t;
    const float e = __builtin_amdgcn_exp2f(v * v * -0.72134752044f);
    const float m = v * (q * e);
    return v < 0.f ? m : v - m;
}
DI void epi_ffn(const Params& p, const float* C, int s0, int L, int pos0, int tn, const float* cw, const float* cb) {
    hf* U = (hf*)(p.ws + OFF_U);
    const int tid = tid_opaque(), cc = tid & 7, rb = tid >> 3;
#pragma unroll 1
    for (int hh = 0; hh < 2; ++hh) {
        const int lc = 8 * cc + 4 * hh, gc = tn * 64 + lc;
        const f4 wg0 = *(const f4*)(cw + gc), wg1 = *(const f4*)(cw + 5632 + gc), wg2 = *(const f4*)(cw + 2 * 5632 + gc), bg = *(const f4*)(cb + gc);
        const f4 wv0 = *(const f4*)(cw + DFF + gc), wv1 = *(const f4*)(cw + 5632 + DFF + gc), wv2 = *(const f4*)(cw + 2 * 5632 + DFF + gc), bv = *(const f4*)(cb + DFF + gc);
#pragma unroll 1
        for (int i = 0; i < 4; ++i) {
            const int lr = rb + 64 * i, pos = pos0 + lr;
            if (lr >= 1 && lr <= 254 && pos < L) {
                const f4 zero = {0.f, 0.f, 0.f, 0.f};
                const bool hm = pos - 1 >= 0, hp = pos + 1 < L;
                const f4 g0 = hm ? *(const f4*)(C + (lr - 1) * CST + lc) : zero, g1 = *(const f4*)(C + lr * CST + lc), g2 = hp ? *(const f4*)(C + (lr + 1) * CST + lc) : zero;
                const f4 v0 = hm ? *(const f4*)(C + (lr - 1) * CST + 64 + lc) : zero, v1 = *(const f4*)(C + lr * CST + 64 + lc), v2 = hp ? *(const f4*)(C + (lr + 1) * CST + 64 + lc) : zero;
                const f4 gt = wg0 * g0 + wg1 * g1 + wg2 * g2 + bg;
                const f4 vl = wv0 * v0 + wv1 * v1 + wv2 * v2 + bv;
                h4 o;
#pragma unroll
                for (int j = 0; j < 4; ++j) o[j] = (hf)(gelu_exact(gt[j]) * vl[j]);
                *(h4*)(U + (size_t)(s0 + pos) * DFF + gc) = o;
            }
        }
    }
}

DI void epi_in1(const Params& p, const float* C, int m0, int tn) {
    char* ws = p.ws;
    hf* Q1 = (hf*)(ws + OFF_Q1); hf* K1 = (hf*)(ws + OFF_K1); hf* V1t = (hf*)(ws + OFF_V1T);
    const float* rg = (const float*)(ws + OFF_ROPEG);
    const int tid = tid_opaque(), cc = tid & 15, rb = tid >> 4;
    if (tn >= 10) { store_transposed<128, false>(C, 0, V1t + (size_t)(tn - 10) * 128 * T, m0); return; }
    int s0, L; seq_of(m0, s0, L);
    const int cw8 = cc & 7;
    hf* dst = tn < 8 ? Q1 : K1; const int ld = tn < 8 ? 1024 : 256, cbase = (tn < 8 ? tn : tn - 8) * 128;
    const float scale = tn < 8 ? 0.125f * LOG2E : 1.f;
#pragma unroll
    for (int i = 0; i < 8; ++i) {
        const int r = rb + 32 * i, t = m0 + r, pos = t - s0;
        f4 a, b; ld8(C, r, 8 * cc, a, b);
        if (cw8 < 2) {
            f4 pa, pb;
            if (cw8 == 0) ld8(C, r, 8 * cc + 8, pa, pb); else ld8(C, r, 8 * cc - 8, pa, pb);
            const float* cs = rg + (size_t)pos * 16;
            const float sg = cw8 == 0 ? -1.f : 1.f;
#pragma unroll
            for (int j = 0; j < 4; ++j) {
                a[j] = a[j] * cs[j] + sg * pa[j] * cs[8 + j];
                b[j] = b[j] * cs[4 + j] + sg * pb[j] * cs[12 + j];
            }
        }
        *(h8*)(dst + (size_t)t * ld + cbase + 8 * cc) = cvt8(a, b, scale);
    }
}

enum { G_IN0 = 0, G_UP = 1, G_RES_IN = 2, G_RES = 3, G_FFN = 4, G_IN1 = 5 };
template <int KIND, int HALF_> DI void run_epi(const Params& p, float* C, int m0, int pn, bool second, int s0, int L, int pos0, const float* cw, const float* cb) {
    const int tn = pn * 2 + HALF_;
    if (KIND == G_IN0) epi_in0(p, C, m0, tn);
    else if (KIND == G_UP) { if (!second) epi_qup(p, C, m0, tn); else epi_kvup(p, C, m0, tn); }
    else if (KIND == G_RES_IN) epi_res(p, C, m0, tn, true);
    else if (KIND == G_RES) epi_res(p, C, m0, tn, false);
    else if (KIND == G_FFN) epi_ffn(p, C, s0, L, pos0, tn, cw, cb);
    else epi_in1(p, C, m0, tn);
}
template <int KIND>
__device__ void phase_gemm(const Params& p, char* smem, const hf* A, int K, const hf* W, int nN, const float* cw, const float* cb) {
    LAS char* lds = (LAS char*)smem;
    float* C = (float*)smem;
    const int nM = KIND == G_FFN ? 197 : 192;
    const int ntile = KIND == G_UP ? 192 * 7 : nM * nN;
    for (int Lx = blockIdx.x; Lx < ntile; Lx += gridDim.x) {
        int pm, pn; const hf* Ax = A; const hf* Wx = W; int Kx = K; bool second = false;
        if (KIND == G_UP) {
            if (Lx < 192 * 3) tile_coords(Lx, 192, 3, pm, pn);
            else { tile_coords(Lx - 192 * 3, 192, 4, pm, pn); second = true; Ax = (const hf*)(p.ws + OFF_KVL); Wx = (const hf*)(p.ws + OFF_WKVUP); Kx = 256; }
        } else tile_coords(Lx, nM, nN, pm, pn);
        int arow0 = pm * 256, s0 = 0, L = 0, pos0 = 0;
        if (KIND == G_FFN) {
            int ti;
            if (pm < 132) { s0 = (pm / 33) * 8192; L = 8192; ti = pm % 33; } else { s0 = TP; L = 16384; ti = pm - 132; }
            pos0 = 254 * ti - 1; arow0 = s0 + pos0;
        }
        f4 acc[2][2][4][2];
        gemm256(Ax, Kx, arow0, Wx, Kx, pn * 256, lds, acc);
        const int m0 = pm * 256;
        stage_half<0>(acc, C);
        run_epi<KIND, 0>(p, C, m0, pn, second, s0, L, pos0, cw, cb);
        stage_half<1>(acc, C);
        run_epi<KIND, 1>(p, C, m0, pn, second, s0, L, pos0, cw, cb);
    }
}

enum { AT_MLA = 0, AT_NA = 1, AT_SWA = 2 };
struct AttnArgs {
    const hf* Q; int qs;
    const hf* K; int ks;
    const hf* Kx;
    const hf* Vt;
    hf* O;
    int t0;
    int kt0;
    int nkt;
    int R0, rows, kr0;
    int qpos0, kpos0; float sink;
};

template <int DQK, int MODE>
DI void attn_item(const AttnArgs& a, char* smem) {
    constexpr int KST = DQK + 8, VST = 68, KCH = 64 * DQK / 8;
    constexpr int NKC = (KCH + NT - 1) / NT;
    hf* Ks = (hf*)smem;
    hf* Vs = Ks + 64 * KST;
    const float* biasL = (const float*)(smem + 24576);
    const int tid = tid_opaque(), lane = tid & 63, wave = tid >> 6, ql = lane & 31, h = lane >> 5;
    const int qrow = 32 * wave + ql;
    h8 qf[DQK / 16];
    {
        const hf* qp = a.Q + (size_t)(a.t0 + qrow) * a.qs + 8 * h;
#pragma unroll
        for (int s = 0; s < DQK / 16; ++s) qf[s] = *(const h8*)(qp + 16 * s);
    }
    float m = NEG_BIG, l = 0.f;
    if (MODE == AT_SWA) { m = a.sink; l = (h == 0) ? 1.f : 0.f; }
    f16v o[2];
#pragma unroll
    for (int e = 0; e < 16; ++e) { o[0][e] = 0.f; o[1][e] = 0.f; }
    int qr = 0, qc = 0, rsq = 0, csq = 0;
    if (MODE == AT_NA) {
        qr = a.R0 + (qrow >> 6); qc = qrow & 63;
        rsq = qr - 4; rsq = rsq < 0 ? 0 : (rsq > a.rows - 8 ? a.rows - 8 : rsq);
        csq = qc - 8; csq = csq < 0 ? 0 : (csq > 48 ? 48 : csq);
    }
    const int pq = a.qpos0 + qrow;
    const int pqw = a.qpos0 + 32 * wave;
    h8 rk[NKC], rv;
    auto load_tile = [&](int kt) {
        const int tok0 = a.kt0 + 64 * kt;
#pragma unroll
        for (int i = 0; i < NKC; ++i) {
            const int c = tid + NT * i, row = c / (DQK / 8), kc = c % (DQK / 8);
            if (c < KCH) {
                if (MODE == AT_MLA && kc >= 8) rk[i] = *(const h8*)(a.Kx + (size_t)(tok0 + row) * 32 + (kc - 8) * 8);
                else rk[i] = *(const h8*)(a.K + (size_t)(tok0 + row) * a.ks + kc * 8);
            }
        }
        { const int d = tid >> 3, kc = tid & 7; rv = *(const h8*)(a.Vt + (size_t)d * T + tok0 + kc * 8); }
    };
    load_tile(0);
    for (int kt = 0; kt < a.nkt; ++kt) {
        __syncthreads();
#pragma unroll
        for (int i = 0; i < NKC; ++i) {
            const int c = tid + NT * i, row = c / (DQK / 8), kc = c % (DQK / 8);
            if (c < KCH) *(h8*)(Ks + row * KST + kc * 8) = rk[i];
        }
        {
            const int d = tid >> 3, kc = tid & 7;
            h4 lo, hi; lo[0] = rv[0]; lo[1] = rv[1]; lo[2] = rv[2]; lo[3] = rv[3]; hi[0] = rv[4]; hi[1] = rv[5]; hi[2] = rv[6]; hi[3] = rv[7];
            *(h4*)(Vs + d * VST + kc * 8) = lo; *(h4*)(Vs + d * VST + kc * 8 + 4) = hi;
        }
        __syncthreads();
        if (kt + 1 < a.nkt) load_tile(kt + 1);
        bool active = true;
        if (MODE == AT_NA) { const int kr = a.kr0 + kt; active = (kr >= rsq) && (kr < rsq + 8); }
        if (MODE == AT_SWA) { const int pk0 = a.kpos0 + 64 * kt; active = (pk0 <= pqw + 31 + 128) && (pk0 + 63 >= pqw - 128); }
        if (active) {
            f16v x[2];
#pragma unroll
            for (int i = 0; i < 2; ++i) {
#pragma unroll
                for (int e = 0; e < 16; ++e) x[i][e] = 0.f;
                const hf* kp = Ks + (32 * i + ql) * KST + 8 * h;
#pragma unroll
                for (int s = 0; s < DQK / 16; ++s) { const h8 kf = *(const h8*)(kp + 16 * s); x[i] = MFMA32(kf, qf[s], x[i]); }
            }
            if (MODE == AT_NA) {
                const int kr = a.kr0 + kt;
                const int brow = (kr - qr + 7) * 31;
#pragma unroll
                for (int i = 0; i < 2; ++i)
#pragma unroll
                    for (int e = 0; e < 16; ++e) {
                        const int kcol = 32 * i + (e & 3) + 8 * (e >> 2) + 4 * h;
                        const bool v = (kcol >= csq) && (kcol < csq + 16);
                        const int bi = v ? (brow + kcol - qc + 15) : 0;
                        const float bb = biasL[bi];
                        x[i][e] = v ? (x[i][e] + bb) : NEG_BIG;
                    }
            } else if (MODE == AT_SWA) {
                const int pk0 = a.kpos0 + 64 * kt;
#pragma unroll
                for (int i = 0; i < 2; ++i)
#pragma unroll
                    for (int e = 0; e < 16; ++e) {
                        const int pk = pk0 + 32 * i + (e & 3) + 8 * (e >> 2) + 4 * h;
                        const int dd = pq - pk;
                        const bool v = (dd <= 128) && (dd >= -128);
                        x[i][e] = v ? x[i][e] : NEG_BIG;
                    }
            }
            float mx = x[0][0];
#pragma unroll
            for (int e = 1; e < 16; ++e) mx = fmaxf(mx, x[0][e]);
#pragma unroll
            for (int e = 0; e < 16; ++e) mx = fmaxf(mx, x[1][e]);
            mx = fmaxf(mx, __shfl_xor(mx, 32));
            const float mnew = fmaxf(m, mx);
            const float alpha = __builtin_amdgcn_exp2f(m - mnew);
            m = mnew;
            float ps = 0.f;
#pragma unroll
            for (int i = 0; i < 2; ++i)
#pragma unroll
                for (int e = 0; e < 16; ++e) { const float pv = __builtin_amdgcn_exp2f(x[i][e] - mnew); x[i][e] = pv; ps += pv; }
            l = l * alpha + ps;
#pragma unroll
            for (int e = 0; e < 16; ++e) { o[0][e] *= alpha; o[1][e] *= alpha; }
#pragma unroll
            for (int i = 0; i < 2; ++i)
#pragma unroll
                for (int sp = 0; sp < 2; ++sp) {
                    h8 pf;
#pragma unroll
                    for (int j = 0; j < 8; ++j) pf[j] = (hf)x[i][8 * sp + j];
#pragma unroll
                    for (int dt = 0; dt < 2; ++dt) {
                        const hf* vp = Vs + (32 * dt + ql) * VST + 32 * i + 16 * sp + 4 * h;
                        const h4 v0 = *(const h4*)vp, v1 = *(const h4*)(vp + 8);
                        h8 vf; vf[0] = v0[0]; vf[1] = v0[1]; vf[2] = v0[2]; vf[3] = v0[3]; vf[4] = v1[0]; vf[5] = v1[1]; vf[6] = v1[2]; vf[7] = v1[3];
                        o[dt] = MFMA32(vf, pf, o[dt]);
                    }
                }
        }
    }
    l += __shfl_xor(l, 32);
    const float inv = 1.f / l;
    hf* op = a.O + (size_t)(a.t0 + qrow) * 1024;
#pragma unroll
    for (int dt = 0; dt < 2; ++dt)
#pragma unroll
        for (int g = 0; g < 4; ++g) {
            h4 v; v[0] = (hf)(o[dt][4 * g] * inv); v[1] = (hf)(o[dt][4 * g + 1] * inv); v[2] = (hf)(o[dt][4 * g + 2] * inv); v[3] = (hf)(o[dt][4 * g + 3] * inv);
            *(h4*)(op + 32 * dt + 8 * g + 4 * h) = v;
        }
}


#define SBAR __builtin_amdgcn_sched_barrier(0)
DI void mla_item(const AttnArgs& a, char* smem) {
    constexpr int KROWB = 208, VROWB = 144;
    constexpr int KSLOT = 64 * KROWB, VSLOT = 64 * VROWB, SLOT = KSLOT + VSLOT, NST = 5, DUMP = NST * SLOT;
    LAS char* lds = (LAS char*)smem;
    const int tid = tid_opaque(), lane = tid & 63, wid = __builtin_amdgcn_readfirstlane(tid >> 6), ql = lane & 31, h = lane >> 5;
    const int qrow = 32 * wid + ql;
    h8 qf[6];
    {
        const hf* qp = a.Q + (size_t)(a.t0 + qrow) * a.qs + 8 * h;
#pragma unroll
        for (int s = 0; s < 6; ++s) qf[s] = *(const h8*)(qp + 16 * s);
    }
    float mref = 0.f, l = 0.f;
    f16v o0, o1;
#pragma unroll
    for (int e = 0; e < 16; ++e) { o0[e] = 0.f; o1[e] = 0.f; }
    const hf *kq0, *kq1, *vq0, *vq1; int kst0, kst1;
    {
        int row = tid / 13, kc = tid % 13; if (kc == 12) kc = 0;
        if (kc < 8) { kq0 = a.K + (size_t)row * a.ks + kc * 8; kst0 = a.ks; } else { kq0 = a.Kx + (size_t)row * 32 + (kc - 8) * 8; kst0 = 32; }
        const int p1 = tid + NT < 832 ? tid + NT : tid;
        row = p1 / 13; kc = p1 % 13; if (kc == 12) kc = 0;
        if (kc < 8) { kq1 = a.K + (size_t)row * a.ks + kc * 8; kst1 = a.ks; } else { kq1 = a.Kx + (size_t)row * 32 + (kc - 8) * 8; kst1 = 32; }
        int d = tid / 9, c = tid % 9; if (c == 8) c = 0;
        vq0 = a.Vt + (size_t)d * T + c * 8;
        const int p2 = tid + NT < 576 ? tid + NT : tid;
        d = p2 / 9; c = p2 % 9; if (c == 8) c = 0;
        vq1 = a.Vt + (size_t)d * T + c * 8;
    }
    const unsigned k1dst = wid < 5 ? (unsigned)(8192 + wid * 1024) : 0xffffffffu, v1dst = wid < 1 ? (unsigned)(KSLOT + 8192 + wid * 1024) : 0xffffffffu;
    auto issue = [&](int kt) {
        const int ktc = kt < a.nkt ? kt : a.nkt - 1;
        const size_t tok0 = (size_t)(a.kt0 + 64 * ktc);
        const unsigned sb = (unsigned)((kt % NST) * SLOT), dump = (unsigned)(DUMP + wid * 1024);
        __builtin_amdgcn_global_load_lds((const unsigned*)(kq0 + tok0 * kst0), (LAS unsigned*)(lds + sb + wid * 1024), 16, 0, 0);
        __builtin_amdgcn_global_load_lds((const unsigned*)(kq1 + tok0 * kst1), (LAS unsigned*)(lds + (k1dst != 0xffffffffu ? sb + k1dst : dump)), 16, 0, 0);
        __builtin_amdgcn_global_load_lds((const unsigned*)(vq0 + tok0), (LAS unsigned*)(lds + sb + KSLOT + wid * 1024), 16, 0, 0);
        __builtin_amdgcn_global_load_lds((const unsigned*)(vq1 + tok0), (LAS unsigned*)(lds + (v1dst != 0xffffffffu ? sb + v1dst : dump)), 16, 0, 0);
    };
    asm volatile("s_waitcnt vmcnt(0)" ::: "memory");
    __syncthreads();
    issue(0); issue(1); issue(2); issue(3);
    asm volatile("s_waitcnt vmcnt(8)" ::: "memory");
    __builtin_amdgcn_s_barrier();
    asm volatile("" ::: "memory");
    const int koff = ql * KROWB + 16 * h, voff = KSLOT + ql * VROWB + 8 * h;
#define KFR(slot, i, s) (*(const LAS h8*)(lds + (slot) * SLOT + koff + (i) * 32 * KROWB + 32 * (s)))
#define VLD(dst, slot, dt, i, sp) { const LAS char* vp_ = lds + (slot) * SLOT + voff + (dt) * 32 * VROWB + 64 * (i) + 32 * (sp); const h4 v0_ = *(const LAS h4*)vp_, v1_ = *(const LAS h4*)(vp_ + 16); \
        dst[0] = v0_[0]; dst[1] = v0_[1]; dst[2] = v0_[2]; dst[3] = v0_[3]; dst[4] = v1_[0]; dst[5] = v1_[1]; dst[6] = v1_[2]; dst[7] = v1_[3]; }
#define EX2(x, e, P, j) { const float p0_ = __builtin_amdgcn_exp2f(x[e]); const float p1_ = __builtin_amdgcn_exp2f(x[(e) + 1]); psA += p0_; psB += p1_; P[j] = (hf)p0_; P[(j) + 1] = (hf)p1_; }
    f16v xc0, xc1, xn0, xn1;
    {
#pragma unroll
        for (int e = 0; e < 16; ++e) { xc0[e] = 0.f; xc1[e] = 0.f; }
#pragma unroll
        for (int s = 0; s < 6; ++s) { const h8 kf = KFR(0, 0, s); xc0 = MFMA32(kf, qf[s], xc0); }
#pragma unroll
        for (int s = 0; s < 6; ++s) { const h8 kf = KFR(0, 1, s); xc1 = MFMA32(kf, qf[s], xc1); }
    }
    float tmax;
    {
        float mx = xc0[0];
#pragma unroll
        for (int e = 1; e < 16; ++e) mx = fmaxf(mx, xc0[e]);
#pragma unroll
        for (int e = 0; e < 16; ++e) mx = fmaxf(mx, xc1[e]);
        mx = fmaxf(mx, __shfl_xor(mx, 32));
        mref = mx;
#pragma unroll
        for (int e = 0; e < 16; ++e) { xc0[e] -= mx; xc1[e] -= mx; }
        tmax = 0.f;
    }
    int cb = 0;
    for (int kt = 0; kt + 1 < a.nkt; ++kt) {
        if (__any(tmax > 8.f)) {
            const float delta = tmax > 8.f ? tmax : 0.f;
            mref += delta;
            const float alpha = __builtin_amdgcn_exp2f(-delta);
            l *= alpha;
#pragma unroll
            for (int e = 0; e < 16; ++e) { xc0[e] -= delta; xc1[e] -= delta; o0[e] *= alpha; o1[e] *= alpha; }
        }
        const int nb = cb == NST - 1 ? 0 : cb + 1;
        issue(kt + 4);
        h8 kA0 = KFR(nb, 0, 0), kA1 = KFR(nb, 0, 1), kA2 = KFR(nb, 0, 2), kB0 = KFR(nb, 0, 3), kB1 = KFR(nb, 0, 4), kB2 = KFR(nb, 0, 5);
        const float ini = -mref;
#pragma unroll
        for (int e = 0; e < 16; ++e) { xn0[e] = ini; xn1[e] = ini; }
        float psA = 0.f, psB = 0.f;
        h8 P00, P01, P10, P11, vA0, vA1, vB0, vB1;
        SBAR;
        xn0 = MFMA32(kA0, qf[0], xn0); SBAR; EX2(xc0, 0, P00, 0); SBAR;
        xn0 = MFMA32(kA1, qf[1], xn0); SBAR; EX2(xc0, 2, P00, 2); SBAR;
        xn0 = MFMA32(kA2, qf[2], xn0); SBAR; kA0 = KFR(nb, 1, 0); kA1 = KFR(nb, 1, 1); kA2 = KFR(nb, 1, 2); EX2(xc0, 4, P00, 4); SBAR;
        xn0 = MFMA32(kB0, qf[3], xn0); SBAR; EX2(xc0, 6, P00, 6); SBAR;
        xn0 = MFMA32(kB1, qf[4], xn0); SBAR; EX2(xc0, 8, P01, 0); SBAR;
        xn0 = MFMA32(kB2, qf[5], xn0); SBAR; kB0 = KFR(nb, 1, 3); kB1 = KFR(nb, 1, 4); kB2 = KFR(nb, 1, 5); EX2(xc0, 10, P01, 2); SBAR;
        xn1 = MFMA32(kA0, qf[0], xn1); SBAR; EX2(xc0, 12, P01, 4); SBAR;
        xn1 = MFMA32(kA1, qf[1], xn1); SBAR; EX2(xc0, 14, P01, 6); SBAR;
        xn1 = MFMA32(kA2, qf[2], xn1); SBAR; VLD(vA0, cb, 0, 0, 0); VLD(vA1, cb, 1, 0, 0); EX2(xc1, 0, P10, 0); SBAR;
        xn1 = MFMA32(kB0, qf[3], xn1); SBAR; EX2(xc1, 2, P10, 2); SBAR;
        xn1 = MFMA32(kB1, qf[4], xn1); SBAR; VLD(vB0, cb, 0, 0, 1); VLD(vB1, cb, 1, 0, 1); EX2(xc1, 4, P10, 4); SBAR;
        xn1 = MFMA32(kB2, qf[5], xn1); SBAR; EX2(xc1, 6, P10, 6); SBAR;
        o0 = MFMA32(vA0, P00, o0); SBAR; EX2(xc1, 8, P11, 0); SBAR;
        o1 = MFMA32(vA1, P00, o1); SBAR; VLD(vA0, cb, 0, 1, 0); VLD(vA1, cb, 1, 1, 0); EX2(xc1, 10, P11, 2); SBAR;
        o0 = MFMA32(vB0, P01, o0); SBAR; EX2(xc1, 12, P11, 4); SBAR;
        o1 = MFMA32(vB1, P01, o1); SBAR; VLD(vB0, cb, 0, 1, 1); VLD(vB1, cb, 1, 1, 1); EX2(xc1, 14, P11, 6); SBAR;
        float mx;
        o0 = MFMA32(vA0, P10, o0); SBAR; mx = fmaxf(fmaxf(xn0[0], xn0[1]), xn0[2]); mx = fmaxf(fmaxf(mx, xn0[3]), xn0[4]); mx = fmaxf(fmaxf(mx, xn0[5]), xn0[6]); mx = fmaxf(fmaxf(mx, xn0[7]), xn0[8]); SBAR;
        o1 = MFMA32(vA1, P10, o1); SBAR; mx = fmaxf(fmaxf(mx, xn0[9]), xn0[10]); mx = fmaxf(fmaxf(mx, xn0[11]), xn0[12]); mx = fmaxf(fmaxf(mx, xn0[13]), xn0[14]); mx = fmaxf(fmaxf(mx, xn0[15]), xn1[0]); SBAR;
        o0 = MFMA32(vB0, P11, o0); SBAR; mx = fmaxf(fmaxf(mx, xn1[1]), xn1[2]); mx = fmaxf(fmaxf(mx, xn1[3]), xn1[4]); mx = fmaxf(fmaxf(mx, xn1[5]), xn1[6]); mx = fmaxf(fmaxf(mx, xn1[7]), xn1[8]); SBAR;
        o1 = MFMA32(vB1, P11, o1); SBAR; mx = fmaxf(fmaxf(mx, xn1[9]), xn1[10]); mx = fmaxf(fmaxf(mx, xn1[11]), xn1[12]); mx = fmaxf(fmaxf(mx, xn1[13]), xn1[14]); mx = fmaxf(mx, xn1[15]); SBAR;
        tmax = fmaxf(mx, __shfl_xor(mx, 32));
        l += psA + psB;
        asm volatile("s_waitcnt vmcnt(8)" ::: "memory");
        __builtin_amdgcn_s_barrier();
        asm volatile("" ::: "memory");
        xc0 = xn0; xc1 = xn1; cb = nb;
    }
    {
        if (__any(tmax > 8.f)) {
            const float delta = tmax > 8.f ? tmax : 0.f;
            mref += delta;
            const float alpha = __builtin_amdgcn_exp2f(-delta);
            l *= alpha;
#pragma unroll
            for (int e = 0; e < 16; ++e) { xc0[e] -= delta; xc1[e] -= delta; o0[e] *= alpha; o1[e] *= alpha; }
        }
        float psA = 0.f, psB = 0.f;
        h8 P00, P01, P10, P11, vA0, vA1;
        EX2(xc0, 0, P00, 0); EX2(xc0, 2, P00, 2); EX2(xc0, 4, P00, 4); EX2(xc0, 6, P00, 6);
        EX2(xc0, 8, P01, 0); EX2(xc0, 10, P01, 2); EX2(xc0, 12, P01, 4); EX2(xc0, 14, P01, 6);
        EX2(xc1, 0, P10, 0); EX2(xc1, 2, P10, 2); EX2(xc1, 4, P10, 4); EX2(xc1, 6, P10, 6);
        EX2(xc1, 8, P11, 0); EX2(xc1, 10, P11, 2); EX2(xc1, 12, P11, 4); EX2(xc1, 14, P11, 6);
        l += psA + psB;
        VLD(vA0, cb, 0, 0, 0); VLD(vA1, cb, 1, 0, 0); o0 = MFMA32(vA0, P00, o0); o1 = MFMA32(vA1, P00, o1);
        VLD(vA0, cb, 0, 0, 1); VLD(vA1, cb, 1, 0, 1); o0 = MFMA32(vA0, P01, o0); o1 = MFMA32(vA1, P01, o1);
        VLD(vA0, cb, 0, 1, 0); VLD(vA1, cb, 1, 1, 0); o0 = MFMA32(vA0, P10, o0); o1 = MFMA32(vA1, P10, o1);
        VLD(vA0, cb, 0, 1, 1); VLD(vA1, cb, 1, 1, 1); o0 = MFMA32(vA0, P11, o0); o1 = MFMA32(vA1, P11, o1);
    }
#undef KFR
#undef VLD
#undef EX2
    asm volatile("s_waitcnt vmcnt(0)" ::: "memory");
    l += __shfl_xor(l, 32);
    const float inv = 1.f / l;
    hf* op = a.O + (size_t)(a.t0 + qrow) * 1024;
#pragma unroll
    for (int g = 0; g < 4; ++g) {
        h4 v; v[0] = (hf)(o0[4 * g] * inv); v[1] = (hf)(o0[4 * g + 1] * inv); v[2] = (hf)(o0[4 * g + 2] * inv); v[3] = (hf)(o0[4 * g + 3] * inv);
        *(h4*)(op + 8 * g + 4 * h) = v;
        h4 w; w[0] = (hf)(o1[4 * g] * inv); w[1] = (hf)(o1[4 * g + 1] * inv); w[2] = (hf)(o1[4 * g + 2] * inv); w[3] = (hf)(o1[4 * g + 3] * inv);
        *(h4*)(op + 32 + 8 * g + 4 * h) = w;
    }
}

DI void mla_item64(const AttnArgs& a, char* smem) {
    constexpr int KROWB = 208, VROWB = 144;
    constexpr int KSLOT = 64 * KROWB, VSLOT = 64 * VROWB, SLOT = KSLOT + VSLOT, NST = 5, DUMP = NST * SLOT;
    LAS char* lds = (LAS char*)smem;
    const int tid = tid_opaque(), lane = tid & 63, wid = __builtin_amdgcn_readfirstlane(tid >> 6), ql = lane & 31, h = lane >> 5;
    const int rowA = 64 * wid + ql, rowB = rowA + 32;
    h8 qA[6], qB[6];
    {
        const hf* qp = a.Q + (size_t)(a.t0 + rowA) * a.qs + 8 * h;
#pragma unroll
        for (int s = 0; s < 6; ++s) { qA[s] = *(const h8*)(qp + 16 * s); qB[s] = *(const h8*)(qp + (size_t)32 * a.qs + 16 * s); }
    }
    float mA = NEG_BIG, lA = 0.f, mB = NEG_BIG, lB = 0.f;
    f16v oA0, oA1, oB0, oB1;
#pragma unroll
    for (int e = 0; e < 16; ++e) { oA0[e] = 0.f; oA1[e] = 0.f; oB0[e] = 0.f; oB1[e] = 0.f; }
    const hf *kq0, *kq1, *vq0, *vq1; int kst0, kst1;
    {
        int row = tid / 13, kc = tid % 13; if (kc == 12) kc = 0;
        if (kc < 8) { kq0 = a.K + (size_t)row * a.ks + kc * 8; kst0 = a.ks; } else { kq0 = a.Kx + (size_t)row * 32 + (kc - 8) * 8; kst0 = 32; }
        const int p1 = tid + NT < 832 ? tid + NT : tid;
        row = p1 / 13; kc = p1 % 13; if (kc == 12) kc = 0;
        if (kc < 8) { kq1 = a.K + (size_t)row * a.ks + kc * 8; kst1 = a.ks; } else { kq1 = a.Kx + (size_t)row * 32 + (kc - 8) * 8; kst1 = 32; }
        int d = tid / 9, c = tid % 9; if (c == 8) c = 0;
        vq0 = a.Vt + (size_t)d * T + c * 8;
        const int p2 = tid + NT < 576 ? tid + NT : tid;
        d = p2 / 9; c = p2 % 9; if (c == 8) c = 0;
        vq1 = a.Vt + (size_t)d * T + c * 8;
    }
    const unsigned k1dst = wid < 5 ? (unsigned)(8192 + wid * 1024) : 0xffffffffu, v1dst = wid < 1 ? (unsigned)(KSLOT + 8192 + wid * 1024) : 0xffffffffu;
    auto issue = [&](int kt) {
        const int ktc = kt < a.nkt ? kt : a.nkt - 1;
        const size_t tok0 = (size_t)(a.kt0 + 64 * ktc);
        const unsigned sb = (unsigned)((kt % NST) * SLOT), dump = (unsigned)(DUMP + wid * 1024);
        __builtin_amdgcn_global_load_lds((const unsigned*)(kq0 + tok0 * kst0), (LAS unsigned*)(lds + sb + wid * 1024), 16, 0, 0);
        __builtin_amdgcn_global_load_lds((const unsigned*)(kq1 + tok0 * kst1), (LAS unsigned*)(lds + (k1dst != 0xffffffffu ? sb + k1dst : dump)), 16, 0, 0);
        __builtin_amdgcn_global_load_lds((const unsigned*)(vq0 + tok0), (LAS unsigned*)(lds + sb + KSLOT + wid * 1024), 16, 0, 0);
        __builtin_amdgcn_global_load_lds((const unsigned*)(vq1 + tok0), (LAS unsigned*)(lds + (v1dst != 0xffffffffu ? sb + v1dst : dump)), 16, 0, 0);
    };
#pragma unroll
    for (int s = 0; s < 6; ++s) asm volatile("" :: "v"(qA[s]), "v"(qB[s]));
    asm volatile("s_waitcnt vmcnt(0)" ::: "memory");
    __syncthreads();
    issue(0); issue(1); issue(2); issue(3);
    asm volatile("s_waitcnt vmcnt(12)" ::: "memory");
    __builtin_amdgcn_s_barrier();
    asm volatile("" ::: "memory");
    const int koff = ql * KROWB + 16 * h, voff = KSLOT + ql * VROWB + 8 * h;
    int cb = 0;
    for (int kt = 0; kt < a.nkt; ++kt) {
        issue(kt + 4);
        const LAS char* kb = lds + cb * SLOT + koff;
        const LAS char* vb = lds + cb * SLOT + voff;
        f16v xA0, xA1, xB0, xB1;
#pragma unroll
        for (int e = 0; e < 16; ++e) { xA0[e] = 0.f; xA1[e] = 0.f; xB0[e] = 0.f; xB1[e] = 0.f; }
        h8 k0 = *(const LAS h8*)kb, k1 = *(const LAS h8*)(kb + 32 * KROWB);
#pragma unroll
        for (int s = 0; s < 6; ++s) {
            h8 n0 = k0, n1 = k1;
            if (s < 5) { n0 = *(const LAS h8*)(kb + 32 * (s + 1)); n1 = *(const LAS h8*)(kb + 32 * KROWB + 32 * (s + 1)); }
            xA0 = MFMA32(k0, qA[s], xA0); xB0 = MFMA32(k0, qB[s], xB0);
            xA1 = MFMA32(k1, qA[s], xA1); xB1 = MFMA32(k1, qB[s], xB1);
            k0 = n0; k1 = n1;
        }
        float alA, alB;
        {
            float mx = xA0[0];
#pragma unroll
            for (int e = 1; e < 16; ++e) mx = fmaxf(mx, xA0[e]);
#pragma unroll
            for (int e = 0; e < 16; ++e) mx = fmaxf(mx, xA1[e]);
            mx = fmaxf(mx, __shfl_xor(mx, 32));
            const float mn = fmaxf(mA, mx); alA = __builtin_amdgcn_exp2f(mA - mn); mA = mn;
            float ps = 0.f;
#pragma unroll
            for (int e = 0; e < 16; ++e) { const float p0 = __builtin_amdgcn_exp2f(xA0[e] - mn); xA0[e] = p0; const float p1 = __builtin_amdgcn_exp2f(xA1[e] - mn); xA1[e] = p1; ps += p0 + p1; }
            lA = lA * alA + ps;
#pragma unroll
            for (int e = 0; e < 16; ++e) { oA0[e] *= alA; oA1[e] *= alA; }
        }
        {
            float mx = xB0[0];
#pragma unroll
            for (int e = 1; e < 16; ++e) mx = fmaxf(mx, xB0[e]);
#pragma unroll
            for (int e = 0; e < 16; ++e) mx = fmaxf(mx, xB1[e]);
            mx = fmaxf(mx, __shfl_xor(mx, 32));
            const float mn = fmaxf(mB, mx); alB = __builtin_amdgcn_exp2f(mB - mn); mB = mn;
            float ps = 0.f;
#pragma unroll
            for (int e = 0; e < 16; ++e) { const float p0 = __builtin_amdgcn_exp2f(xB0[e] - mn); xB0[e] = p0; const float p1 = __builtin_amdgcn_exp2f(xB1[e] - mn); xB1[e] = p1; ps += p0 + p1; }
            lB = lB * alB + ps;
#pragma unroll
            for (int e = 0; e < 16; ++e) { oB0[e] *= alB; oB1[e] *= alB; }
        }
#pragma unroll
        for (int i = 0; i < 2; ++i)
#pragma unroll
            for (int sp = 0; sp < 2; ++sp) {
                h8 pA, pB;
#pragma unroll
                for (int j = 0; j < 8; ++j) { pA[j] = (hf)(i == 0 ? xA0[8 * sp + j] : xA1[8 * sp + j]); pB[j] = (hf)(i == 0 ? xB0[8 * sp + j] : xB1[8 * sp + j]); }
#pragma unroll
                for (int dt = 0; dt < 2; ++dt) {
                    const LAS char* vp = vb + dt * 32 * VROWB + 64 * i + 32 * sp;
                    const h4 v0 = *(const LAS h4*)vp, v1 = *(const LAS h4*)(vp + 16);
                    h8 vf; vf[0] = v0[0]; vf[1] = v0[1]; vf[2] = v0[2]; vf[3] = v0[3]; vf[4] = v1[0]; vf[5] = v1[1]; vf[6] = v1[2]; vf[7] = v1[3];
                    if (dt == 0) { oA0 = MFMA32(vf, pA, oA0); oB0 = MFMA32(vf, pB, oB0); } else { oA1 = MFMA32(vf, pA, oA1); oB1 = MFMA32(vf, pB, oB1); }
                }
            }
        asm volatile("s_waitcnt vmcnt(12)" ::: "memory");
        __builtin_amdgcn_s_barrier();
        asm volatile("" ::: "memory");
        cb = cb == NST - 1 ? 0 : cb + 1;
    }
    asm volatile("s_waitcnt vmcnt(0)" ::: "memory");
    lA += __shfl_xor(lA, 32); lB += __shfl_xor(lB, 32);
    const float ia = 1.f / lA, ib = 1.f / lB;
    hf* opA = a.O + (size_t)(a.t0 + rowA) * 1024; hf* opB = opA + (size_t)32 * 1024;
#pragma unroll
    for (int g = 0; g < 4; ++g) {
        h4 v;
        v[0] = (hf)(oA0[4 * g] * ia); v[1] = (hf)(oA0[4 * g + 1] * ia); v[2] = (hf)(oA0[4 * g + 2] * ia); v[3] = (hf)(oA0[4 * g + 3] * ia); *(h4*)(opA + 8 * g + 4 * h) = v;
        v[0] = (hf)(oA1[4 * g] * ia); v[1] = (hf)(oA1[4 * g + 1] * ia); v[2] = (hf)(oA1[4 * g + 2] * ia); v[3] = (hf)(oA1[4 * g + 3] * ia); *(h4*)(opA + 32 + 8 * g + 4 * h) = v;
        v[0] = (hf)(oB0[4 * g] * ib); v[1] = (hf)(oB0[4 * g + 1] * ib); v[2] = (hf)(oB0[4 * g + 2] * ib); v[3] = (hf)(oB0[4 * g + 3] * ib); *(h4*)(opB + 8 * g + 4 * h) = v;
        v[0] = (hf)(oB1[4 * g] * ib); v[1] = (hf)(oB1[4 * g + 1] * ib); v[2] = (hf)(oB1[4 * g + 2] * ib); v[3] = (hf)(oB1[4 * g + 3] * ib); *(h4*)(opB + 32 + 8 * g + 4 * h) = v;
    }
}

__device__ void phase_attn0(const Params& p, char* smem) {
    char* ws = p.ws;
    const int tid = tid_opaque();
    for (int it = blockIdx.x; it < 768 + 1536; it += gridDim.x) {
        AttnArgs a{};
        a.O = (hf*)(ws + OFF_AO);
        if (it < 768) {
            int head, s0, L, t0;
            if (it < 512) { const int u = (it & 7) + 8 * (it >> 7), qb = (it >> 3) & 15; const int sq = u >> 3; head = u & 7; s0 = sq * 8192; L = 8192; t0 = s0 + qb * 512; }
            else { const int j = it - 512; head = j & 7; s0 = TP; L = 16384; t0 = s0 + (j >> 3) * 512; }
            a.Q = (const hf*)p.out + head * 96; a.qs = 768;
            a.K = (const hf*)(ws + OFF_KN) + head * 64; a.ks = 512;
            a.Kx = (const hf*)(ws + OFF_KR);
            a.Vt = (const hf*)(ws + OFF_VMT) + (size_t)head * 64 * T;
            a.O += 512 + head * 64;
            a.t0 = t0; a.kt0 = s0; a.nkt = L / 64;
            mla_item64(a, smem);
        } else {
            const int i2 = it - 768, head = i2 & 7, qblk = i2 >> 3, t0 = qblk * 256;
            int s0, L; seq_of(t0, s0, L);
            const int rows = L / 64, R0 = (t0 - s0) / 64;
            int rs0 = R0 - 4; rs0 = rs0 < 0 ? 0 : (rs0 > rows - 8 ? rows - 8 : rs0);
            int rs1 = R0 + 3 - 4; rs1 = rs1 < 0 ? 0 : (rs1 > rows - 8 ? rows - 8 : rs1);
            __syncthreads();
            float* biasL = (float*)(smem + 24576);
            for (int i = tid; i < 465; i += NT) biasL[i] = p.in[3][head * 465 + i] * LOG2E;
            a.Q = (const hf*)(ws + OFF_QA) + head * 64; a.qs = 512;
            a.K = (const hf*)(ws + OFF_KA) + head * 64; a.ks = 512;
            a.Vt = (const hf*)(ws + OFF_VAT) + (size_t)head * 64 * T;
            a.O += head * 64;
            a.t0 = t0; a.kt0 = s0 + 64 * rs0; a.nkt = rs1 + 8 - rs0;
            a.R0 = R0; a.rows = rows; a.kr0 = rs0;
            attn_item<64, AT_NA>(a, smem);
        }
    }
}

DI void swa_stage(const AttnArgs& a, char* smem) {
    constexpr int KST = 72, VST = 68;
    const int tid = tid_opaque(), krow = tid >> 3, kkc = tid & 7;
    const hf* kbase = a.K + (size_t)(a.kt0 + krow) * a.ks + kkc * 8;
    const hf* vbase = a.Vt + (size_t)krow * T + a.kt0 + kkc * 8;
    h8 rk[8], rv[8];
#pragma unroll
    for (int kt = 0; kt < 8; ++kt) if (kt < a.nkt) { rk[kt] = *(const h8*)(kbase + (size_t)(64 * kt) * a.ks); rv[kt] = *(const h8*)(vbase + 64 * kt); }
    __syncthreads();
#pragma unroll
    for (int kt = 0; kt < 8; ++kt) if (kt < a.nkt) {
        hf* Ks = (hf*)(smem + kt * SWA_TILE); hf* Vs = Ks + 64 * KST;
        *(h8*)(Ks + krow * KST + kkc * 8) = rk[kt];
        h4 lo, hi; lo[0] = rv[kt][0]; lo[1] = rv[kt][1]; lo[2] = rv[kt][2]; lo[3] = rv[kt][3]; hi[0] = rv[kt][4]; hi[1] = rv[kt][5]; hi[2] = rv[kt][6]; hi[3] = rv[kt][7];
        *(h4*)(Vs + krow * VST + kkc * 8) = lo; *(h4*)(Vs + krow * VST + kkc * 8 + 4) = hi;
    }
    __syncthreads();
}
DI void swa_pair(const AttnArgs& a, const hf* QB, hf* OB, float sinkB, char* smem) {
    constexpr int KST = 72, VST = 68;
    const int tid = tid_opaque(), lane = tid & 63, wave = tid >> 6, ql = lane & 31, h = lane >> 5;
    const int qrow = 32 * wave + ql;
    h8 qa[4], qb[4];
    {
        const hf* pa = a.Q + (size_t)(a.t0 + qrow) * a.qs + 8 * h; const hf* pb = QB + (size_t)(a.t0 + qrow) * a.qs + 8 * h;
#pragma unroll
        for (int s = 0; s < 4; ++s) { qa[s] = *(const h8*)(pa + 16 * s); qb[s] = *(const h8*)(pb + 16 * s); }
    }
    float mA = a.sink, mB = sinkB, lA = (h == 0) ? 1.f : 0.f, lB = lA;
    f16v oA0, oA1, oB0, oB1;
#pragma unroll
    for (int e = 0; e < 16; ++e) { oA0[e] = 0.f; oA1[e] = 0.f; oB0[e] = 0.f; oB1[e] = 0.f; }
    const int pq = a.qpos0 + qrow, pqw = a.qpos0 + 32 * wave;
    for (int kt = 0; kt < a.nkt; ++kt) {
        const hf* Ks = (const hf*)(smem + kt * SWA_TILE);
        const hf* Vs = Ks + 64 * KST;
        const int pk0 = a.kpos0 + 64 * kt;
        if ((pk0 <= pqw + 31 + 128) && (pk0 + 63 >= pqw - 128)) {
            f16v xA0, xA1, xB0, xB1;
#pragma unroll
            for (int e = 0; e < 16; ++e) { xA0[e] = 0.f; xA1[e] = 0.f; xB0[e] = 0.f; xB1[e] = 0.f; }
            const hf* kp = Ks + ql * KST + 8 * h;
#pragma unroll
            for (int s = 0; s < 4; ++s) {
                const h8 k0 = *(const h8*)(kp + 16 * s), k1 = *(const h8*)(kp + 32 * KST + 16 * s);
                xA0 = MFMA32(k0, qa[s], xA0); xB0 = MFMA32(k0, qb[s], xB0);
                xA1 = MFMA32(k1, qa[s], xA1); xB1 = MFMA32(k1, qb[s], xB1);
            }
            if (!((pk0 >= pqw + 31 - 128) && (pk0 + 63 <= pqw + 128))) {
                const int base = pk0 + 4 * h - pq + 128;
#pragma unroll
                for (int e = 0; e < 16; ++e) {
                    const unsigned t0 = (unsigned)(base + (e & 3) + 8 * (e >> 2)), t1 = t0 + 32u;
                    if (t0 > 256u) { xA0[e] = NEG_BIG; xB0[e] = NEG_BIG; }
                    if (t1 > 256u) { xA1[e] = NEG_BIG; xB1[e] = NEG_BIG; }
                }
            }
            float mxa = xA0[0], mxb = xB0[0];
#pragma unroll
            for (int e = 1; e < 16; ++e) { mxa = fmaxf(mxa, xA0[e]); mxb = fmaxf(mxb, xB0[e]); }
#pragma unroll
            for (int e = 0; e < 16; ++e) { mxa = fmaxf(mxa, xA1[e]); mxb = fmaxf(mxb, xB1[e]); }
            const float pa_ = __shfl_xor(mxa, 32), pb_ = __shfl_xor(mxb, 32);
            const float mna = fmaxf(mA, fmaxf(mxa, pa_)), mnb = fmaxf(mB, fmaxf(mxb, pb_));
            const float alA = __builtin_amdgcn_exp2f(mA - mna), alB = __builtin_amdgcn_exp2f(mB - mnb); mA = mna; mB = mnb;
            float psa = 0.f, psb = 0.f;
#pragma unroll
            for (int e = 0; e < 16; ++e) {
                const float p0 = __builtin_amdgcn_exp2f(xA0[e] - mna), q0 = __builtin_amdgcn_exp2f(xB0[e] - mnb), p1 = __builtin_amdgcn_exp2f(xA1[e] - mna), q1 = __builtin_amdgcn_exp2f(xB1[e] - mnb);
                xA0[e] = p0; xB0[e] = q0; xA1[e] = p1; xB1[e] = q1; psa += p0 + p1; psb += q0 + q1;
            }
            lA = lA * alA + psa; lB = lB * alB + psb;
#pragma unroll
            for (int e = 0; e < 16; ++e) { oA0[e] *= alA; oB0[e] *= alB; oA1[e] *= alA; oB1[e] *= alB; }
#pragma unroll
            for (int i = 0; i < 2; ++i)
#pragma unroll
                for (int sp = 0; sp < 2; ++sp) {
                    h8 pA, pB;
#pragma unroll
                    for (int j = 0; j < 8; ++j) { pA[j] = (hf)(i == 0 ? xA0[8 * sp + j] : xA1[8 * sp + j]); pB[j] = (hf)(i == 0 ? xB0[8 * sp + j] : xB1[8 * sp + j]); }
#pragma unroll
                    for (int dt = 0; dt < 2; ++dt) {
                        const hf* vp = Vs + (32 * dt + ql) * VST + 32 * i + 16 * sp + 4 * h;
                        const h4 v0 = *(const h4*)vp, v1 = *(const h4*)(vp + 8);
                        h8 vf; vf[0] = v0[0]; vf[1] = v0[1]; vf[2] = v0[2]; vf[3] = v0[3]; vf[4] = v1[0]; vf[5] = v1[1]; vf[6] = v1[2]; vf[7] = v1[3];
                        if (dt == 0) { oA0 = MFMA32(vf, pA, oA0); oB0 = MFMA32(vf, pB, oB0); } else { oA1 = MFMA32(vf, pA, oA1); oB1 = MFMA32(vf, pB, oB1); }
                    }
                }
        }
    }
    lA += __shfl_xor(lA, 32); lB += __shfl_xor(lB, 32);
    const float ia = 1.f / lA, ib = 1.f / lB;
    hf* opA = a.O + (size_t)(a.t0 + qrow) * 1024; hf* opB = OB + (size_t)(a.t0 + qrow) * 1024;
#pragma unroll
    for (int g = 0; g < 4; ++g) {
        h4 v;
        v[0] = (hf)(oA0[4 * g] * ia); v[1] = (hf)(oA0[4 * g + 1] * ia); v[2] = (hf)(oA0[4 * g + 2] * ia); v[3] = (hf)(oA0[4 * g + 3] * ia); *(h4*)(opA + 8 * g + 4 * h) = v;
        v[0] = (hf)(oA1[4 * g] * ia); v[1] = (hf)(oA1[4 * g + 1] * ia); v[2] = (hf)(oA1[4 * g + 2] * ia); v[3] = (hf)(oA1[4 * g + 3] * ia); *(h4*)(opA + 32 + 8 * g + 4 * h) = v;
        v[0] = (hf)(oB0[4 * g] * ib); v[1] = (hf)(oB0[4 * g + 1] * ib); v[2] = (hf)(oB0[4 * g + 2] * ib); v[3] = (hf)(oB0[4 * g + 3] * ib); *(h4*)(opB + 8 * g + 4 * h) = v;
        v[0] = (hf)(oB1[4 * g] * ib); v[1] = (hf)(oB1[4 * g + 1] * ib); v[2] = (hf)(oB1[4 * g + 2] * ib); v[3] = (hf)(oB1[4 * g + 3] * ib); *(h4*)(opB + 32 + 8 * g + 4 * h) = v;
    }
}

__device__ void phase_attn1(const Params& p, char* smem) {
    char* ws = p.ws;
    for (int it = blockIdx.x; it < 192 * 4; it += gridDim.x) {
        const int hkv = it & 3, qblk = it >> 2, t0 = qblk * 256;
        int s0, L; seq_of(t0, s0, L);
        const int qpos0 = t0 - s0;
        const int ks = qpos0 - 128 < 0 ? 0 : qpos0 - 128, ke = qpos0 + 384 > L ? L : qpos0 + 384;
        AttnArgs a{};
        a.qs = 1024;
        a.K = (const hf*)(ws + OFF_K1) + hkv * 64; a.ks = 256;
        a.Vt = (const hf*)(ws + OFF_V1T) + (size_t)hkv * 64 * T;
        a.t0 = t0; a.kt0 = s0 + ks; a.nkt = (ke - ks) / 64;
        a.qpos0 = qpos0; a.kpos0 = ks;
        swa_stage(a, smem);
#pragma unroll 1
        for (int pr = 0; pr < 2; ++pr) {
            const int hq = 4 * hkv + 2 * pr;
            a.Q = (const hf*)(ws + OFF_Q1) + hq * 64; a.O = (hf*)(ws + OFF_AO) + hq * 64; a.sink = p.in[18][hq] * LOG2E;
            swa_pair(a, a.Q + 64, a.O + 64, p.in[18][hq + 1] * LOG2E, smem);
        }
    }
}

__device__ void phase_ln(const Params& p, const float* g, const float* b, bool last) {
    const int lane = tid_opaque() & 63;
    const int gw = (blockIdx.x * NT + tid_opaque()) >> 6, nw = gridDim.x * (NT / 64);
    hf* Xh = (hf*)(p.ws + OFF_XH);
    f4 gg[4], bb[4];
#pragma unroll
    for (int i = 0; i < 2; ++i) { gg[2 * i] = *(const f4*)(g + i * 512 + lane * 8); gg[2 * i + 1] = *(const f4*)(g + i * 512 + lane * 8 + 4); bb[2 * i] = *(const f4*)(b + i * 512 + lane * 8); bb[2 * i + 1] = *(const f4*)(b + i * 512 + lane * 8 + 4); }
    for (int row = gw; row < T; row += nw) {
        hf* y = Xh + (size_t)row * DM;
        f4 v[4];
#pragma unroll
        for (int i = 0; i < 2; ++i) {
            const h8 hv = *(const h8*)(y + i * 512 + lane * 8);
            v[2 * i] = (f4){(float)hv[0], (float)hv[1], (float)hv[2], (float)hv[3]}; v[2 * i + 1] = (f4){(float)hv[4], (float)hv[5], (float)hv[6], (float)hv[7]};
        }
        float s = 0.f;
#pragma unroll
        for (int i = 0; i < 4; ++i) s += v[i][0] + v[i][1] + v[i][2] + v[i][3];
        const float mu = wave_sum(s) * (1.f / 1024.f);
        float q = 0.f;
#pragma unroll
        for (int i = 0; i < 4; ++i) { v[i] = v[i] - mu; q += v[i][0] * v[i][0] + v[i][1] * v[i][1] + v[i][2] * v[i][2] + v[i][3] * v[i][3]; }
        const float rstd = rsqrtf(wave_sum(q) * (1.f / 1024.f) + EPS);
#pragma unroll
        for (int i = 0; i < 2; ++i) {
            const f4 o0 = v[2 * i] * rstd * gg[2 * i] + bb[2 * i], o1 = v[2 * i + 1] * rstd * gg[2 * i + 1] + bb[2 * i + 1];
            if (last) { float* op = p.out + (size_t)row * DM + i * 512 + lane * 8; *(f4*)op = o0; *(f4*)(op + 4) = o1; }
            else *(h8*)(y + i * 512 + lane * 8) = cvt8(o0, o1, 1.f);
        }
    }
}


#define XB_TMO      128
#define XB_XCNT(j)  (256  + 64 * (j))
#define XB_XSUB(j)  (1280 + 64 * (j))
#define XB_XGEN(j)  (2304 + 64 * (j))
#define XB_TOP      3328
#define XB_TOPGEN   3392
#define XCD_BAR_WORDS 3456
#define XB_SPIN_CAP (1u << 18)
DI unsigned xb_ld(unsigned* p)              { return __hip_atomic_load(p, __ATOMIC_RELAXED, __HIP_MEMORY_SCOPE_AGENT); }
DI unsigned xb_add(unsigned* p, unsigned v) { return __hip_atomic_fetch_add(p, v, __ATOMIC_RELAXED, __HIP_MEMORY_SCOPE_AGENT); }
DI unsigned xb_xcc_id() { return (unsigned)__builtin_amdgcn_s_getreg((3 << 11) | 20) & 0xFu; }
#define XB_SPIN(cond, bar) do { unsigned _sp = 0; while (cond) { __builtin_amdgcn_s_sleep(1); \
    if ((++_sp & 255u) == 0u) { if (xb_ld(&(bar)[XB_TMO])) break; if (_sp > XB_SPIN_CAP) { atomicAdd(&(bar)[XB_TMO], 1u); break; } } } } while (0)
struct XcdBarrier { unsigned* bar; unsigned x; volatile LAS unsigned* st; };
DI XcdBarrier xcd_barrier_post(unsigned* bar, volatile LAS unsigned* st) {
    XcdBarrier b; b.bar = bar; b.x = xb_xcc_id(); b.st = st;
    if (threadIdx.x == 0) (void)xb_add(&bar[XB_XCNT(b.x)], 1u);
    return b;
}
DI void xcd_barrier_complete(unsigned* bar, unsigned x, unsigned& nloc, unsigned& nx) {
    const unsigned G = gridDim.x * gridDim.y * gridDim.z;
    unsigned sum, cnt, mine, sp = 0u;
    for (;;) {
        sum = 0u; cnt = 0u; mine = 0u;
#pragma unroll
        for (unsigned j = 0; j < 16; ++j) { const unsigned c = xb_ld(&bar[XB_XCNT(j)]); sum += c; cnt += (c > 0u) ? 1u : 0u; mine = (j == x) ? c : mine; }
        if (sum == G) break;
        __builtin_amdgcn_s_sleep(1);
        if ((++sp & 255u) == 0u) { if (xb_ld(&bar[XB_TMO])) break; if (sp > XB_SPIN_CAP) { atomicAdd(&bar[XB_TMO], 1u); break; } }
    }
    nloc = mine > 0u ? mine : 1u; nx = cnt > 0u ? cnt : 1u;
}
DI void xcd_barrier(const XcdBarrier& b) {
    asm volatile("s_waitcnt vmcnt(0)" ::: "memory");
    __syncthreads();
    if (threadIdx.x == 0) {
        unsigned* bar = b.bar;
        __builtin_amdgcn_s_waitcnt(0);
        unsigned nloc = b.st[0], nx = b.st[1];
        if (nloc == 0u) { xcd_barrier_complete(bar, b.x, nloc, nx); b.st[0] = nloc; b.st[1] = nx; }
        const unsigned old = xb_add(&bar[XB_XSUB(b.x)], 1u);
        const unsigned gen = old / nloc;
        if (old + 1u == (gen + 1u) * nloc) {
            __builtin_amdgcn_fence(__ATOMIC_RELEASE, "agent");
            asm volatile("s_waitcnt vmcnt(0)" ::: "memory");
            const unsigned og = xb_add(&bar[XB_TOP], 1u);
            const unsigned tg = og / nx;
            if (og + 1u == (tg + 1u) * nx) xb_add(&bar[XB_TOPGEN], 1u);
            else XB_SPIN(xb_ld(&bar[XB_TOPGEN]) == tg, bar);
            __builtin_amdgcn_fence(__ATOMIC_ACQUIRE, "agent");
            xb_add(&bar[XB_XGEN(b.x)], 1u);
            asm volatile("s_waitcnt vmcnt(0)" ::: "memory");
        } else {
            XB_SPIN(xb_ld(&bar[XB_XGEN(b.x)]) == gen, bar);
            __builtin_amdgcn_fence(__ATOMIC_ACQUIRE, "agent");
            asm volatile("s_waitcnt vmcnt(0)" ::: "memory");
        }
    }
    __syncthreads();
}

constexpr int NPHASE = 16;
template <int PH> DI void run_phase(const Params& p, char* smem) {
    char* ws = p.ws;
    if (PH == 0) phase_prep(p, smem);
    else if (PH == 1) phase_gemm<G_IN0>(p, smem, (const hf*)(ws + OFF_XH), 1024, (const hf*)(ws + OFF_WIN0), 9, nullptr, nullptr);
    else if (PH == 2) phase_gemm<G_UP>(p, smem, (const hf*)(ws + OFF_QL), 384, (const hf*)(ws + OFF_WQUP), 3, nullptr, nullptr);
    else if (PH == 3) phase_attn0(p, smem);
    else if (PH == 4) phase_gemm<G_RES>(p, smem, (const hf*)(ws + OFF_AO), 1024, (const hf*)(ws + OFF_WOUT0), 4, nullptr, nullptr);
    else if (PH == 5) phase_ln(p, p.in[9], p.in[10], false);
    else if (PH == 6) phase_gemm<G_FFN>(p, smem, (const hf*)(ws + OFF_XH), 1024, (const hf*)(ws + OFF_WUP0), 22, p.in[12], p.in[13]);
    else if (PH == 7) phase_gemm<G_RES>(p, smem, (const hf*)(ws + OFF_U), 2816, (const hf*)(ws + OFF_WDN0), 4, nullptr, nullptr);
    else if (PH == 8) phase_ln(p, p.in[15], p.in[16], false);
    else if (PH == 9) phase_gemm<G_IN1>(p, smem, (const hf*)(ws + OFF_XH), 1024, (const hf*)(ws + OFF_WIN1), 6, nullptr, nullptr);
    else if (PH == 10) phase_attn1(p, smem);
    else if (PH == 11) phase_gemm<G_RES>(p, smem, (const hf*)(ws + OFF_AO), 1024, (const hf*)(ws + OFF_WOUT1), 4, nullptr, nullptr);
    else if (PH == 12) phase_ln(p, p.in[20], p.in[21], false);
    else if (PH == 13) phase_gemm<G_FFN>(p, smem, (const hf*)(ws + OFF_XH), 1024, (const hf*)(ws + OFF_WUP1), 22, p.in[23], p.in[24]);
    else if (PH == 14) phase_gemm<G_RES>(p, smem, (const hf*)(ws + OFF_U), 2816, (const hf*)(ws + OFF_WDN1), 4, nullptr, nullptr);
    else if (PH == 15) phase_ln(p, p.in[26], p.in[27], true);
}

template <int LO, int HI> struct PhaseLoop {
    static DI void run(const Params& p, char* smem, const XcdBarrier& xb) {
        for (int r = 0; r < ((PROBE_MASK >> LO) & 1) + 1; ++r) run_phase<LO>(p, smem);
        if (LO + 1 < HI) {
            if (LO == 0) cg::this_grid().sync(); else xcd_barrier(xb);
            for (int r = 0; r < PROBE_SYNCS; ++r) xcd_barrier(xb);
            PhaseLoop<LO + 1, HI>::run(p, smem, xb);
        }
    }
};
template <int HI> struct PhaseLoop<HI, HI> { static DI void run(const Params&, char*, const XcdBarrier&) {} };

__global__ void __launch_bounds__(NT) mega_kernel(Params p) {
    extern __shared__ __attribute__((aligned(16))) char smem[];
    volatile LAS unsigned* st = (volatile LAS unsigned*)(LAS char*)(smem + LDS_ST);
    if (threadIdx.x == 0) { st[0] = 0u; st[1] = 0u; }
    __syncthreads();
    const XcdBarrier xb = xcd_barrier_post((unsigned*)(p.ws + OFF_BAR), st);
    PhaseLoop<0, NPHASE>::run(p, smem, xb);
}
extern "C" void kernel_launch(void* const* d_in, const int* in_sizes, int n_in, void* d_out, int out_size, void* d_ws, size_t ws_size, hipStream_t stream) {
    static int grid = 0;
    if (grid == 0) {
        if (n_in != 28 || out_size != T * DM || ws_size < WS_END) { fprintf(stderr, "kernel_launch: unexpected shapes (n_in %d out %d ws %zu need %zu)\n", n_in, out_size, ws_size, (size_t)WS_END); grid = -1; return; }
        int dev = 0, cus = 0, per_cu = 0;
        (void)hipGetDevice(&dev);
        (void)hipDeviceGetAttribute(&cus, hipDeviceAttributeMultiprocessorCount, dev);
        if (hipFuncSetAttribute((const void*)mega_kernel, hipFuncAttributeMaxDynamicSharedMemorySize, LDS_TOTAL) != hipSuccess) fprintf(stderr, "kernel_launch: hipFuncSetAttribute failed\n");
        if (hipOccupancyMaxActiveBlocksPerMultiprocessor(&per_cu, (const void*)mega_kernel, NT, LDS_TOTAL) != hipSuccess || per_cu < 1) { fprintf(stderr, "kernel_launch: occupancy query failed (%d)\n", per_cu); per_cu = 1; }
        grid = cus;
    }
    if (grid < 0) return;
    Params p{};
    for (int i = 0; i < 28; ++i) p.in[i] = (const float*)d_in[i];
    p.out = (float*)d_out; p.ws = (char*)d_ws;
#if MEGA
    if (hipMemsetAsync((char*)d_ws + OFF_BAR, 0, XCD_BAR_WORDS * 4, stream) != hipSuccess) { fprintf(stderr, "kernel_launch: hipMemsetAsync of the barrier words failed\n"); return; }
    void* args[] = {&p};
    hipError_t e = hipLaunchCooperativeKernel((const void*)mega_kernel, dim3(grid), dim3(NT), args, LDS_TOTAL, stream);
    if (e != hipSuccess) fprintf(stderr, "cooperative launch failed: %s (grid %d)\n", hipGetErrorString(e), grid);
#endif
}
```

```cpp
#include <hip/hip_runtime.h>
#include <hip/hip_cooperative_groups.h>
#include <cstdio>
namespace cg = cooperative_groups;

#ifndef PROBE_MASK
#define PROBE_MASK 0x0
#endif
#ifndef PROBE_SYNCS
#define PROBE_SYNCS 0
#endif
#ifndef MEGA
#define MEGA 1
#endif

typedef _Float16 hf;
typedef _Float16 h8 __attribute__((ext_vector_type(8)));
typedef _Float16 h4 __attribute__((ext_vector_type(4)));
typedef float f4 __attribute__((ext_vector_type(4)));
typedef float f16v __attribute__((ext_vector_type(16)));
#define MFMA32(a, b, c) __builtin_amdgcn_mfma_f32_32x32x16_f16((a), (b), (c), 0, 0, 0)
#define MFMA16(a, b, c) __builtin_amdgcn_mfma_f32_16x16x32_f16((a), (b), (c), 0, 0, 0)
#define DI __device__ __forceinline__
#define LAS __attribute__((address_space(3)))

constexpr int NT = 512;
constexpr int T = 49152;
constexpr int TP = 32768;
constexpr int DM = 1024;
constexpr int DFF = 2816;
constexpr float LOG2E = 1.4426950408889634f;
constexpr float ALPHA = 1.4142135623730951f;
constexpr float EPS = 1e-5f;
constexpr float NEG_BIG = -1e30f;

constexpr size_t SZ_WIN0 = (size_t)2304 * 1024 * 2, SZ_WQUP = (size_t)768 * 384 * 2, SZ_WKVUP = (size_t)1024 * 256 * 2,
                 SZ_WOUT = (size_t)1024 * 1024 * 2, SZ_WUP = (size_t)5632 * 1024 * 2, SZ_WDN = (size_t)1024 * 2816 * 2,
                 SZ_WIN1 = (size_t)1536 * 1024 * 2;
constexpr size_t OFF_WIN0 = 0, OFF_WQUP = OFF_WIN0 + SZ_WIN0, OFF_WKVUP = OFF_WQUP + SZ_WQUP, OFF_WOUT0 = OFF_WKVUP + SZ_WKVUP,
                 OFF_WUP0 = OFF_WOUT0 + SZ_WOUT, OFF_WDN0 = OFF_WUP0 + SZ_WUP, OFF_WIN1 = OFF_WDN0 + SZ_WDN, OFF_WOUT1 = OFF_WIN1 + SZ_WIN1,
                 OFF_WUP1 = OFF_WOUT1 + SZ_WOUT, OFF_WDN1 = OFF_WUP1 + SZ_WUP, OFF_ROPEM = OFF_WDN1 + SZ_WDN;
constexpr size_t SZ_ROPEM = (size_t)16384 * 16 * 4 * 2, SZ_ROPEG = (size_t)16384 * 8 * 4 * 2;
constexpr size_t OFF_ROPEG = OFF_ROPEM + SZ_ROPEM, OFF_SS = OFF_ROPEG + SZ_ROPEG, SZ_SS = (size_t)T * 8 * 4;
constexpr size_t OFF_R1 = OFF_SS + SZ_SS, SZ_R1 = (size_t)T * 1024 * 2;
constexpr size_t OFF_R2 = OFF_R1 + SZ_R1, SZ_R2 = (size_t)T * 1024 * 2;
constexpr size_t OFF_R3 = OFF_R2 + SZ_R2, SZ_R3 = (size_t)T * 2816 * 2;
constexpr size_t OFF_BAR = OFF_R3 + SZ_R3;
constexpr size_t WS_END = OFF_BAR + 16384;
constexpr size_t OFF_XH = OFF_R1, OFF_QM = OFF_R1;
constexpr size_t OFF_AO = OFF_R2, OFF_QL = OFF_R2, OFF_KVL = OFF_R2 + (size_t)T * 384 * 2;
constexpr size_t OFF_U = OFF_R3;
constexpr size_t OFF_QA = OFF_R3, OFF_KA = OFF_QA + (size_t)T * 512 * 2, OFF_VAT = OFF_KA + (size_t)T * 512 * 2, OFF_KN = OFF_VAT + (size_t)T * 512 * 2,
                 OFF_VMT = OFF_KN + (size_t)T * 512 * 2, OFF_KR = OFF_VMT + (size_t)T * 512 * 2;
constexpr size_t OFF_Q1 = OFF_R3, OFF_K1 = OFF_Q1 + (size_t)T * 1024 * 2, OFF_V1T = OFF_K1 + (size_t)T * 256 * 2;
static_assert(OFF_KR + (size_t)T * 32 * 2 <= WS_END, "L0 attention buffers overflow R3");
static_assert(OFF_V1T + (size_t)T * 256 * 2 <= WS_END, "L1 attention buffers overflow R3");

constexpr int CST = 132;
constexpr int LDS_BYTES = 256 * CST * 4;
constexpr int SWA_TILE = 64 * 72 * 2 + 64 * 68 * 2;
constexpr int LDS_ST = 8 * SWA_TILE;
constexpr int LDS_NAB = LDS_ST + 16;
constexpr int LDS_TOTAL = LDS_NAB + 1872;

static_assert(LDS_ST >= LDS_BYTES, "barrier words must sit behind every phase's LDS image");
struct Params {
    const float* in[28];
    float* out;
    char* ws;
};

DI void seq_of(int t, int& s0, int& L) { if (t < TP) { s0 = t & ~8191; L = 8192; } else { s0 = TP; L = 16384; } }
DI const float* xrow(const Params& p, int t) { return t < TP ? p.in[0] + (size_t)t * DM : p.in[1] + (size_t)(t - TP) * DM; }
DI h8 cvt8(f4 a, f4 b, float s) { h8 v; v[0] = (hf)(a[0] * s); v[1] = (hf)(a[1] * s); v[2] = (hf)(a[2] * s); v[3] = (hf)(a[3] * s); v[4] = (hf)(b[0] * s); v[5] = (hf)(b[1] * s); v[6] = (hf)(b[2] * s); v[7] = (hf)(b[3] * s); return v; }
DI int tid_opaque() { int t = threadIdx.x; asm volatile("" : "+v"(t)); return t; }
DI float wave_sum(float v) { v += __shfl_xor(v, 32); v += __shfl_xor(v, 16); v += __shfl_xor(v, 8); v += __shfl_xor(v, 4); v += __shfl_xor(v, 2); v += __shfl_xor(v, 1); return v; }

DI void prep_weight(const float* __restrict__ src, const float* __restrict__ g, hf* __restrict__ dst, int K, int Nsrc, int Npad, int mode, char* smem) {
    hf* tl = (hf*)smem;
    const int tid = tid_opaque(), nn = tid & 63, kq = tid >> 6, on = tid >> 3, oc = tid & 7;
    const int ntn = Npad >> 6, ntk = K >> 6;
    for (int tile = blockIdx.x; tile < ntn * ntk; tile += gridDim.x) {
        const int tn = tile % ntn, tk = tile / ntn, n0 = tn * 64, k0 = tk * 64;
        int c0 = n0;
        if (mode == 1) { const int t = n0 >> 7; c0 = (n0 & 64) ? (DFF + t * 64) : (t * 64); }
        const int col = c0 + nn;
        __syncthreads();
#pragma unroll
        for (int r = 0; r < 8; ++r) {
            const int kk = kq + 8 * r;
            float x = 0.f;
            if (col < Nsrc) { x = src[(size_t)(k0 + kk) * Nsrc + col]; if (g) x *= g[k0 + kk]; }
            tl[nn * 72 + kk] = (hf)x;
        }
        __syncthreads();
        *(h8*)(dst + (size_t)(n0 + on) * K + k0 + oc * 8) = *(const h8*)(tl + on * 72 + oc * 8);
    }
}

__device__ void phase_prep(const Params& p, char* smem) {
    const long gtid = (long)blockIdx.x * NT + tid_opaque(), gs = (long)gridDim.x * NT;
    char* ws = p.ws;
    prep_weight(p.in[2], nullptr, (hf*)(ws + OFF_WIN0), 1024, 2208, 2304, 0, smem);
    prep_weight(p.in[5], p.in[4], (hf*)(ws + OFF_WQUP), 384, 768, 768, 0, smem);
    prep_weight(p.in[7], p.in[6], (hf*)(ws + OFF_WKVUP), 256, 1024, 1024, 0, smem);
    prep_weight(p.in[8], nullptr, (hf*)(ws + OFF_WOUT0), 1024, 1024, 1024, 0, smem);
    prep_weight(p.in[11], nullptr, (hf*)(ws + OFF_WUP0), 1024, 5632, 5632, 1, smem);
    prep_weight(p.in[14], nullptr, (hf*)(ws + OFF_WDN0), 2816, 1024, 1024, 0, smem);
    prep_weight(p.in[17], nullptr, (hf*)(ws + OFF_WIN1), 1024, 1536, 1536, 0, smem);
    prep_weight(p.in[19], nullptr, (hf*)(ws + OFF_WOUT1), 1024, 1024, 1024, 0, smem);
    prep_weight(p.in[22], nullptr, (hf*)(ws + OFF_WUP1), 1024, 5632, 5632, 1, smem);
    prep_weight(p.in[25], nullptr, (hf*)(ws + OFF_WDN1), 2816, 1024, 1024, 0, smem);
    hf* xh = (hf*)(ws + OFF_XH);
    for (long idx = gtid; idx < (long)T * 128; idx += gs) {
        const int t = (int)(idx >> 7), c = (int)(idx & 127) * 8;
        const float* xr = xrow(p, t) + c;
        const f4 a = *(const f4*)xr, b = *(const f4*)(xr + 4);
        *(h8*)(xh + (size_t)t * DM + c) = cvt8(a, b, 1.f);
    }
    float* rm = (float*)(ws + OFF_ROPEM); float* rg = (float*)(ws + OFF_ROPEG);
    for (long idx = gtid; idx < 16384L * 24; idx += gs) {
        const int pos = (int)(idx / 24), i = (int)(idx % 24);
        double inv;
        if (i < 16) inv = exp2(-(double)i / 16.0 * 13.287712379549449);
        else inv = exp2(-(double)(i - 16) / 8.0 * 18.931568569324174);
        const float angf = (float)pos * (float)inv;
        const double ang = (double)angf;
        const float c = (float)cos(ang), s = (float)sin(ang);
        if (i < 16) { rm[(size_t)pos * 32 + i] = c; rm[(size_t)pos * 32 + 16 + i] = s; }
        else { rg[(size_t)pos * 16 + (i - 16)] = c; rg[(size_t)pos * 16 + 8 + (i - 16)] = s; }
    }
}

constexpr int HTB = 128 * 64 * 2;
DI int lds_byte(int r, int c) { const int st = (r >> 4) * 2 + (c >> 5), rr = r & 15, cc = c & 31, ob = rr * 64 + cc * 2; return st * 1024 + (ob ^ (((ob >> 9) & 1) << 5)); }
DI void stage_rc(int b, int& R, int& C) { const int st = b / 1024, sb = b % 1024, swz = sb ^ (((sb >> 9) & 1) << 5); R = (st >> 1) * 16 + swz / 64; C = (st & 1) * 32 + (swz % 64) / 2; }

DI void tile_coords(int L, int nM, int nN, int& pm, int& pn) {
    const int nwg = nM * nN;
    int wgid = L; { const int q = nwg / 8, r = nwg % 8, xcd = wgid % 8, off = wgid / 8; wgid = (xcd < r ? xcd * (q + 1) : r * (q + 1) + (xcd - r) * q) + off; }
    const int nig = 8 * nN, gid = wgid / nig, fm = gid * 8, gsz = (nM - fm) < 8 ? (nM - fm) : 8;
    pm = fm + ((wgid % nig) % gsz); pn = (wgid % nig) / gsz;
}

DI void gemm256(const hf* __restrict__ A, int lda, int arow0, const hf* __restrict__ Bt, int K, int bcol, LAS char* lds, f4 (&acc)[2][2][4][2]) {
    const int tid = tid_opaque(), wid = __builtin_amdgcn_readfirstlane(tid >> 6), lane = tid & 63, wr = wid >> 2, wc = wid & 3, fr = lane & 15, fq = lane >> 4;
    const int nt = K >> 6;
    unsigned offA[2], offB[2];
#pragma unroll
    for (int i = 0; i < 2; ++i) {
        int R, C; stage_rc(tid * 16 + i * 8192, R, C);
        offA[i] = (unsigned)(R * lda + C) * 2u;
        offB[i] = (unsigned)(R * K + C) * 2u;
    }
    const char* Ab = (const char*)(A + (long)arow0 * lda);
    const char* Bb = (const char*)(Bt + (long)bcol * K);
    const size_t hA = (size_t)128 * lda * 2, hB = (size_t)128 * K * 2;
    const unsigned ldsw = (unsigned)wid * 1024u;
    const int aoff = lds_byte(wr * 64 + fr, fq * 8), boff = lds_byte(wc * 32 + fr, fq * 8);
#define SA(b, h) (((b) * 2 + (h)) * HTB)
#define SB(b, h) ((4 + (b) * 2 + (h)) * HTB)
#define STAGE_A(b, h, kt) do { _Pragma("unroll") for (int _i = 0; _i < 2; ++_i) \
        __builtin_amdgcn_global_load_lds((const unsigned*)(Ab + (h) * hA + (size_t)(kt) * 128 + offA[_i]), (LAS unsigned*)(lds + SA(b, h) + ldsw + _i * 8192), 16, 0, 0); } while (0)
#define STAGE_B(b, h, kt) do { _Pragma("unroll") for (int _i = 0; _i < 2; ++_i) \
        __builtin_amdgcn_global_load_lds((const unsigned*)(Bb + (h) * hB + (size_t)(kt) * 128 + offB[_i]), (LAS unsigned*)(lds + SB(b, h) + ldsw + _i * 8192), 16, 0, 0); } while (0)
#define LDA(dst, b, h) do { _Pragma("unroll") for (int m = 0; m < 4; ++m) _Pragma("unroll") for (int k = 0; k < 2; ++k) dst[m][k] = *(const LAS h8*)(lds + SA(b, h) + aoff + m * 2048 + k * 1024); } while (0)
#define LDB(dst, b, h) do { _Pragma("unroll") for (int n = 0; n < 2; ++n) _Pragma("unroll") for (int k = 0; k < 2; ++k) dst[n][k] = *(const LAS h8*)(lds + SB(b, h) + boff + n * 2048 + k * 1024); } while (0)
#define MMA(ai, bj, At_, Bt_) do { __builtin_amdgcn_s_setprio(1); _Pragma("unroll") for (int m = 0; m < 4; ++m) _Pragma("unroll") for (int n = 0; n < 2; ++n) _Pragma("unroll") for (int k = 0; k < 2; ++k) \
        acc[ai][bj][m][n] = MFMA16(At_[m][k], Bt_[n][k], acc[ai][bj][m][n]); __builtin_amdgcn_s_setprio(0); } while (0)
#define WAIT_V(n) asm volatile("s_waitcnt vmcnt(" #n ")" ::: "memory")
#define WAIT_L(n) asm volatile("s_waitcnt lgkmcnt(" #n ")" ::: "memory")
#define BAR __builtin_amdgcn_s_barrier()
#define SCHED __builtin_amdgcn_sched_barrier(0)
#pragma unroll
    for (int a_ = 0; a_ < 2; ++a_)
#pragma unroll
        for (int b_ = 0; b_ < 2; ++b_)
#pragma unroll
            for (int m = 0; m < 4; ++m)
#pragma unroll
                for (int n = 0; n < 2; ++n) acc[a_][b_][m][n] = (f4){0.f, 0.f, 0.f, 0.f};
    h8 At[4][2], B0[2][2], B1[2][2];
    WAIT_V(0);
    __syncthreads();
    STAGE_B(0, 0, 0); STAGE_A(0, 0, 0);
    STAGE_B(0, 1, 0); STAGE_A(0, 1, 0);
    if (wr == 1) BAR;
    WAIT_V(4); BAR;
    STAGE_B(1, 0, 1); STAGE_A(1, 0, 1); STAGE_B(1, 1, 1);
    WAIT_V(6); BAR;
    for (int t = 0; t < nt - 2; t += 2) {
        LDB(B0, 0, 0); SCHED; LDA(At, 0, 0); STAGE_A(1, 1, t + 1);
        WAIT_L(8); BAR; WAIT_L(0); MMA(0, 0, At, B0); BAR; SCHED;
        LDB(B1, 0, 1); STAGE_B(0, 0, t + 2);
        BAR; WAIT_L(0); MMA(0, 1, At, B1); BAR;
        LDA(At, 0, 1); STAGE_A(0, 0, t + 2);
        BAR; WAIT_L(0); MMA(1, 0, At, B0); BAR; SCHED;
        STAGE_B(0, 1, t + 2);
        WAIT_V(6); BAR; MMA(1, 1, At, B1); BAR;
        LDB(B0, 1, 0); SCHED; LDA(At, 1, 0); STAGE_A(0, 1, t + 2);
        WAIT_L(8); BAR; WAIT_L(0); MMA(0, 0, At, B0); BAR; SCHED;
        LDB(B1, 1, 1); STAGE_B(1, 0, t + 3);
        BAR; WAIT_L(0); MMA(0, 1, At, B1); BAR;
        LDA(At, 1, 1); STAGE_A(1, 0, t + 3);
        BAR; WAIT_L(0); MMA(1, 0, At, B0); BAR; SCHED;
        STAGE_B(1, 1, t + 3);
        WAIT_V(6); BAR; MMA(1, 1, At, B1); BAR;
    }
    { LDB(B0, 0, 0); LDA(At, 0, 0); STAGE_A(1, 1, nt - 1);
      BAR; WAIT_L(0); MMA(0, 0, At, B0); BAR;
      LDB(B1, 0, 1); BAR; WAIT_L(0); MMA(0, 1, At, B1); BAR;
      LDA(At, 0, 1); WAIT_V(4); BAR; WAIT_L(0); MMA(1, 0, At, B0); MMA(1, 1, At, B1); BAR; }
    { LDB(B0, 1, 0); LDA(At, 1, 0); WAIT_V(2); BAR; WAIT_L(0); MMA(0, 0, At, B0); BAR;
      LDB(B1, 1, 1); WAIT_V(0); BAR; WAIT_L(0); MMA(0, 1, At, B1); BAR;
      LDA(At, 1, 1); BAR; WAIT_L(0); MMA(1, 0, At, B0); MMA(1, 1, At, B1); BAR; }
    if (wr == 0) BAR;
#undef SA
#undef SB
#undef STAGE_A
#undef STAGE_B
#undef LDA
#undef LDB
#undef MMA
}

template <int BJ> DI void stage_half(const f4 (&acc)[2][2][4][2], float* C) {
    __syncthreads();
    const int tid = tid_opaque(), wid = tid >> 6, lane = tid & 63, wr = wid >> 2, wc = wid & 3, fr = lane & 15, fq = lane >> 4;
#pragma unroll
    for (int ai = 0; ai < 2; ++ai)
#pragma unroll
        for (int m = 0; m < 4; ++m)
#pragma unroll
            for (int n = 0; n < 2; ++n)
#pragma unroll
                for (int j = 0; j < 4; ++j) C[(ai * 128 + wr * 64 + m * 16 + fq * 4 + j) * CST + wc * 32 + n * 16 + fr] = acc[ai][BJ][m][n][j];
    __syncthreads();
}

DI void ld8(const float* C, int r, int c, f4& a, f4& b) { a = *(const f4*)(C + r * CST + c); b = *(const f4*)(C + r * CST + c + 4); }

template <int NCOLS, bool RSCALE>
DI void store_transposed(const float* C, int c0, hf* dst  , int tok0) {
    const int tid = tid_opaque();
    const int col = tid % NCOLS, rc0 = tid / NCOLS;
    constexpr int STEP = NT / NCOLS;
#pragma unroll
    for (int rc = rc0; rc < 32; rc += STEP) {
        h8 v;
#pragma unroll
        for (int j = 0; j < 8; ++j) { float x = C[(8 * rc + j) * CST + c0 + col]; if (RSCALE) x *= C[(8 * rc + j) * CST + 128]; v[j] = (hf)x; }
        *(h8*)(dst + (size_t)col * T + tok0 + 8 * rc) = v;
    }
}

DI void epi_in0(const Params& p, const float* C, int m0, int tn) {
    char* ws = p.ws;
    hf* Qa = (hf*)(ws + OFF_QA); hf* Ka = (hf*)(ws + OFF_KA); hf* VaT = (hf*)(ws + OFF_VAT);
    hf* QL = (hf*)(ws + OFF_QL); hf* KVL = (hf*)(ws + OFF_KVL); hf* Kr = (hf*)(ws + OFF_KR);
    float* SS = (float*)(ws + OFF_SS); const float* rm = (const float*)(ws + OFF_ROPEM);
    const int tid = tid_opaque(), cc = tid & 15, rb = tid >> 4;
    if (tn >= 8 && tn < 12) {
        store_transposed<128, false>(C, 0, VaT + (size_t)(tn - 8) * 128 * T, m0);
    } else if (tn == 17) {
        if (cc < 2) {
            int s0, L; seq_of(m0, s0, L);
#pragma unroll
            for (int i = 0; i < 8; ++i) {
                const int r = rb + 32 * i, t = m0 + r, pos = t - s0;
                f4 a0, a1, b0, b1; ld8(C, r, 8 * cc, a0, a1); ld8(C, r, 16 + 8 * cc, b0, b1);
                const float* cs = rm + (size_t)pos * 32 + 8 * cc;
                h8 o1, o2;
#pragma unroll
                for (int j = 0; j < 8; ++j) {
                    const float x1 = j < 4 ? a0[j & 3] : a1[j & 3], x2 = j < 4 ? b0[j & 3] : b1[j & 3];
                    const float c = cs[j], s = cs[16 + j];
                    o1[j] = (hf)(x1 * c - x2 * s); o2[j] = (hf)(x2 * c + x1 * s);
                }
                *(h8*)(Kr + (size_t)t * 32 + 8 * cc) = o1; *(h8*)(Kr + (size_t)t * 32 + 16 + 8 * cc) = o2;
            }
        }
    } else {
        hf* dst; int ld, cbase, ssidx = -1; float scale = 1.f;
        if (tn < 4) { dst = Qa; ld = 512; cbase = tn * 128; scale = 0.125f * LOG2E; }
        else if (tn < 8) { dst = Ka; ld = 512; cbase = (tn - 4) * 128; }
        else if (tn < 15) { dst = QL; ld = 384; cbase = (tn - 12) * 128; ssidx = tn - 12; }
        else { dst = KVL; ld = 256; cbase = (tn - 15) * 128; ssidx = 3 + (tn - 15); }
#pragma unroll
        for (int i = 0; i < 8; ++i) {
            const int r = rb + 32 * i, t = m0 + r;
            f4 a, b; ld8(C, r, 8 * cc, a, b);
            *(h8*)(dst + (size_t)t * ld + cbase + 8 * cc) = cvt8(a, b, scale);
            if (ssidx >= 0) {
                float ss = a[0] * a[0] + a[1] * a[1] + a[2] * a[2] + a[3] * a[3] + b[0] * b[0] + b[1] * b[1] + b[2] * b[2] + b[3] * b[3];
                ss += __shfl_xor(ss, 1); ss += __shfl_xor(ss, 2); ss += __shfl_xor(ss, 4); ss += __shfl_xor(ss, 8);
                if (cc == 0) SS[(size_t)t * 8 + ssidx] = ss;
            }
        }
    }
}

DI void epi_qup(const Params& p, float* C, int m0, int tn) {
    char* ws = p.ws;
    hf* Qm = (hf*)p.out;
    const float* SS = (const float*)(ws + OFF_SS); const float* rm = (const float*)(ws + OFF_ROPEM);
    const int tid = tid_opaque();
    const float QSC = 0.10206207261596575f * LOG2E;
    if (tid < 256) { const float* s = SS + (size_t)(m0 + tid) * 8; C[tid * CST + 128] = rsqrtf((s[0] + s[1] + s[2]) * (1.f / 384.f) + EPS); }
    __syncthreads();
    const int cc = tid & 15, rb = tid >> 4;
    const int n = tn * 128 + 8 * cc, hd = n / 96, w = n - hd * 96;
    int s0, L; seq_of(m0, s0, L);
#pragma unroll
    for (int i = 0; i < 8; ++i) {
        const int r = rb + 32 * i, t = m0 + r, pos = t - s0;
        const float rq = C[r * CST + 128] * QSC;
        f4 a, b; ld8(C, r, 8 * cc, a, b);
        if (w >= 64) {
            const int iw = w - 64;
            f4 pa, pb;
            if (iw < 16) ld8(C, r, 8 * cc + 16, pa, pb); else ld8(C, r, 8 * cc - 16, pa, pb);
            const float* cs = rm + (size_t)pos * 32 + (iw & 15);
            const float sg = iw < 16 ? -1.f : 1.f;
#pragma unroll
            for (int j = 0; j < 4; ++j) {
                a[j] = a[j] * cs[j] + sg * pa[j] * cs[16 + j];
                b[j] = b[j] * cs[4 + j] + sg * pb[j] * cs[20 + j];
            }
        }
        *(h8*)(Qm + (size_t)t * 768 + n) = cvt8(a, b, rq);
    }
}
DI void epi_kvup(const Params& p, float* C, int m0, int tn  ) {
    char* ws = p.ws;
    hf* Kn = (hf*)(ws + OFF_KN); hf* VmT = (hf*)(ws + OFF_VMT);
    const float* SS = (const float*)(ws + OFF_SS);
    const int tid = tid_opaque();
    if (tid < 256) { const float* s = SS + (size_t)(m0 + tid) * 8; C[tid * CST + 128] = rsqrtf((s[3] + s[4]) * (1.f / 256.f) + EPS); }
    __syncthreads();
    const int cc = tid & 7, rb = tid >> 3;
#pragma unroll
    for (int i = 0; i < 4; ++i) {
        const int r = rb + 64 * i, t = m0 + r;
        f4 a, b; ld8(C, r, 8 * cc, a, b);
        *(h8*)(Kn + (size_t)t * 512 + tn * 64 + 8 * cc) = cvt8(a, b, C[r * CST + 128]);
    }
    store_transposed<64, true>(C, 64, VmT + (size_t)tn * 64 * T, m0);
}

DI void epi_res(const Params& p, const float* C, int m0, int tn, bool res_from_input) {
    const int tid = tid_opaque(), cc = tid & 15, rb = tid >> 4;
    hf* Xh = (hf*)(p.ws + OFF_XH);
#pragma unroll
    for (int i = 0; i < 8; ++i) {
        const int r = rb + 32 * i, t = m0 + r, n = tn * 128 + 8 * cc;
        f4 a, b; ld8(C, r, 8 * cc, a, b);
        hf* yp = Xh + (size_t)t * DM + n;
        f4 r0, r1;
        if (res_from_input) { const float* rp = xrow(p, t) + n; r0 = *(const f4*)rp; r1 = *(const f4*)(rp + 4); }
        else { const h8 rv = *(const h8*)yp; r0 = (f4){(float)rv[0], (float)rv[1], (float)rv[2], (float)rv[3]}; r1 = (f4){(float)rv[4], (float)rv[5], (float)rv[6], (float)rv[7]}; }
        *(h8*)yp = cvt8(r0 * ALPHA + a, r1 * ALPHA + b, 1.f);
    }
}

DI float gelu_exact(float v) {
    const float t = __builtin_amdgcn_rcpf(fmaf(fabsf(v), 0.2316418882f, 1.0f));
    float q = fmaf(t, 0.5307027145f, -0.7265760135f); q = fmaf(q, t, 0.7107068705f); q = fmaf(q, t, -0.142248368f); q = fmaf(q, t, 0.127414796f); q *= t;
    const float e = __builtin_amdgcn_exp2f(v * v * -0.72134752044f);
    const float m = v * (q * e);
    return v < 0.f ? m : v - m;
}
DI void epi_ffn(const Params& p, const float* C, int s0, int L, int pos0, int tn, const float* cw, const float* cb) {
    hf* U = (hf*)(p.ws + OFF_U);
    const int tid = tid_opaque(), cc = tid & 7, rb = tid >> 3;
#pragma unroll 1
    for (int hh = 0; hh < 2; ++hh) {
        const int lc = 8 * cc + 4 * hh, gc = tn * 64 + lc;
        const f4 wg0 = *(const f4*)(cw + gc), wg1 = *(const f4*)(cw + 5632 + gc), wg2 = *(const f4*)(cw + 2 * 5632 + gc), bg = *(const f4*)(cb + gc);
        const f4 wv0 = *(const f4*)(cw + DFF + gc), wv1 = *(const f4*)(cw + 5632 + DFF + gc), wv2 = *(const f4*)(cw + 2 * 5632 + DFF + gc), bv = *(const f4*)(cb + DFF + gc);
#pragma unroll 1
        for (int i = 0; i < 4; ++i) {
            const int lr = rb + 64 * i, pos = pos0 + lr;
            if (lr >= 1 && lr <= 254 && pos < L) {
                const f4 zero = {0.f, 0.f, 0.f, 0.f};
                const bool hm = pos - 1 >= 0, hp = pos + 1 < L;
                const f4 g0 = hm ? *(const f4*)(C + (lr - 1) * CST + lc) : zero, g1 = *(const f4*)(C + lr * CST + lc), g2 = hp ? *(const f4*)(C + (lr + 1) * CST + lc) : zero;
                const f4 v0 = hm ? *(const f4*)(C + (lr - 1) * CST + 64 + lc) : zero, v1 = *(const f4*)(C + lr * CST + 64 + lc), v2 = hp ? *(const f4*)(C + (lr + 1) * CST + 64 + lc) : zero;
                const f4 gt = wg0 * g0 + wg1 * g1 + wg2 * g2 + bg;
                const f4 vl = wv0 * v0 + wv1 * v1 + wv2 * v2 + bv;
                h4 o;
#pragma unroll
                for (int j = 0; j < 4; ++j) o[j] = (hf)(gelu_exact(gt[j]) * vl[j]);
                *(h4*)(U + (size_t)(s0 + pos) * DFF + gc) = o;
            }
        }
    }
}

DI void epi_in1(const Params& p, const float* C, int m0, int tn) {
    char* ws = p.ws;
    hf* Q1 = (hf*)(ws + OFF_Q1); hf* K1 = (hf*)(ws + OFF_K1); hf* V1t = (hf*)(ws + OFF_V1T);
    const float* rg = (const float*)(ws + OFF_ROPEG);
    const int tid = tid_opaque(), cc = tid & 15, rb = tid >> 4;
    if (tn >= 10) { store_transposed<128, false>(C, 0, V1t + (size_t)(tn - 10) * 128 * T, m0); return; }
    int s0, L; seq_of(m0, s0, L);
    const int cw8 = cc & 7;
    hf* dst = tn < 8 ? Q1 : K1; const int ld = tn < 8 ? 1024 : 256, cbase = (tn < 8 ? tn : tn - 8) * 128;
    const float scale = tn < 8 ? 0.125f * LOG2E : 1.f;
#pragma unroll
    for (int i = 0; i < 8; ++i) {
        const int r = rb + 32 * i, t = m0 + r, pos = t - s0;
        f4 a, b; ld8(C, r, 8 * cc, a, b);
        if (cw8 < 2) {
            f4 pa, pb;
            if (cw8 == 0) ld8(C, r, 8 * cc + 8, pa, pb); else ld8(C, r, 8 * cc - 8, pa, pb);
            const float* cs = rg + (size_t)pos * 16;
            const float sg = cw8 == 0 ? -1.f : 1.f;
#pragma unroll
            for (int j = 0; j < 4; ++j) {
                a[j] = a[j] * cs[j] + sg * pa[j] * cs[8 + j];
                b[j] = b[j] * cs[4 + j] + sg * pb[j] * cs[12 + j];
            }
        }
        *(h8*)(dst + (size_t)t * ld + cbase + 8 * cc) = cvt8(a, b, scale);
    }
}

enum { G_IN0 = 0, G_UP = 1, G_RES_IN = 2, G_RES = 3, G_FFN = 4, G_IN1 = 5 };
template <int KIND, int HALF_> DI void run_epi(const Params& p, float* C, int m0, int pn, bool second, int s0, int L, int pos0, const float* cw, const float* cb) {
    const int tn = pn * 2 + HALF_;
    if (KIND == G_IN0) epi_in0(p, C, m0, tn);
    else if (KIND == G_UP) { if (!second) epi_qup(p, C, m0, tn); else epi_kvup(p, C, m0, tn); }
    else if (KIND == G_RES_IN) epi_res(p, C, m0, tn, true);
    else if (KIND == G_RES) epi_res(p, C, m0, tn, false);
    else if (KIND == G_FFN) epi_ffn(p, C, s0, L, pos0, tn, cw, cb);
    else epi_in1(p, C, m0, tn);
}
template <int KIND>
__device__ void phase_gemm(const Params& p, char* smem, const hf* A, int K, const hf* W, int nN, const float* cw, const float* cb) {
    LAS char* lds = (LAS char*)smem;
    float* C = (float*)smem;
    const int nM = KIND == G_FFN ? 197 : 192;
    const int ntile = KIND == G_UP ? 192 * 7 : nM * nN;
    for (int Lx = blockIdx.x; Lx < ntile; Lx += gridDim.x) {
        int pm, pn; const hf* Ax = A; const hf* Wx = W; int Kx = K; bool second = false;
        if (KIND == G_UP) {
            if (Lx < 192 * 3) tile_coords(Lx, 192, 3, pm, pn);
            else { tile_coords(Lx - 192 * 3, 192, 4, pm, pn); second = true; Ax = (const hf*)(p.ws + OFF_KVL); Wx = (const hf*)(p.ws + OFF_WKVUP); Kx = 256; }
        } else tile_coords(Lx, nM, nN, pm, pn);
        int arow0 = pm * 256, s0 = 0, L = 0, pos0 = 0;
        if (KIND == G_FFN) {
            int ti;
            if (pm < 132) { s0 = (pm / 33) * 8192; L = 8192; ti = pm % 33; } else { s0 = TP; L = 16384; ti = pm - 132; }
            pos0 = 254 * ti - 1; arow0 = s0 + pos0;
        }
        f4 acc[2][2][4][2];
        gemm256(Ax, Kx, arow0, Wx, Kx, pn * 256, lds, acc);
        const int m0 = pm * 256;
        stage_half<0>(acc, C);
        run_epi<KIND, 0>(p, C, m0, pn, second, s0, L, pos0, cw, cb);
        stage_half<1>(acc, C);
        run_epi<KIND, 1>(p, C, m0, pn, second, s0, L, pos0, cw, cb);
    }
}

enum { AT_MLA = 0, AT_NA = 1, AT_SWA = 2 };
struct AttnArgs {
    const hf* Q; int qs;
    const hf* K; int ks;
    const hf* Kx;
    const hf* Vt;
    hf* O;
    int t0;
    int kt0;
    int nkt;
    int R0, rows, kr0;
    int qpos0, kpos0; float sink;
};

template <int DQK, int MODE>
DI void attn_item(const AttnArgs& a, char* smem) {
    constexpr int KST = DQK + 8, VST = 68, KCH = 64 * DQK / 8;
    constexpr int NKC = (KCH + NT - 1) / NT;
    const float* biasL = (const float*)(smem + LDS_NAB);
    const int tid = tid_opaque(), lane = tid & 63, wave = tid >> 6, ql = lane & 31, h = lane >> 5;
    const int qrow = 32 * wave + ql;
    h8 qf[DQK / 16];
    {
        const hf* qp = a.Q + (size_t)(a.t0 + qrow) * a.qs + 8 * h;
#pragma unroll
        for (int s = 0; s < DQK / 16; ++s) qf[s] = *(const h8*)(qp + 16 * s);
    }
    float m = NEG_BIG, l = 0.f;
    if (MODE == AT_SWA) { m = a.sink; l = (h == 0) ? 1.f : 0.f; }
    f16v o[2];
#pragma unroll
    for (int e = 0; e < 16; ++e) { o[0][e] = 0.f; o[1][e] = 0.f; }
    int qr = 0, qc = 0, rsq = 0, csq = 0;
    if (MODE == AT_NA) {
        qr = a.R0 + (qrow >> 6); qc = qrow & 63;
        rsq = qr - 4; rsq = rsq < 0 ? 0 : (rsq > a.rows - 8 ? a.rows - 8 : rsq);
        csq = qc - 8; csq = csq < 0 ? 0 : (csq > 48 ? 48 : csq);
    }
    const int pq = a.qpos0 + qrow;
    const int pqw = a.qpos0 + 32 * wave;
    const int krow = tid >> 3, kkc = tid & 7;
    const hf* kbase = a.K + (size_t)(a.kt0 + krow) * a.ks + kkc * 8;
    const hf* vbase = a.Vt + (size_t)krow * T + a.kt0 + kkc * 8;
    for (int kb0 = 0; kb0 < a.nkt; kb0 += 8) {
      {
        h8 rk[8], rv[8];
#pragma unroll
        for (int j = 0; j < 8; ++j) if (kb0 + j < a.nkt) { rk[j] = *(const h8*)(kbase + (size_t)(64 * (kb0 + j)) * a.ks); rv[j] = *(const h8*)(vbase + 64 * (kb0 + j)); }
        __syncthreads();
#pragma unroll
        for (int j = 0; j < 8; ++j) if (kb0 + j < a.nkt) {
            hf* Kw = (hf*)(smem + j * SWA_TILE); hf* Vw = Kw + 64 * KST;
            *(h8*)(Kw + krow * KST + kkc * 8) = rk[j];
            h4 lo, hi; lo[0] = rv[j][0]; lo[1] = rv[j][1]; lo[2] = rv[j][2]; lo[3] = rv[j][3]; hi[0] = rv[j][4]; hi[1] = rv[j][5]; hi[2] = rv[j][6]; hi[3] = rv[j][7];
            *(h4*)(Vw + krow * VST + kkc * 8) = lo; *(h4*)(Vw + krow * VST + kkc * 8 + 4) = hi;
        }
        __syncthreads();
      }
      const int kend = kb0 + 8 < a.nkt ? kb0 + 8 : a.nkt;
      for (int kt = kb0; kt < kend; ++kt) {
        const hf* Ks = (const hf*)(smem + (kt - kb0) * SWA_TILE);
        const hf* Vs = Ks + 64 * KST;
        bool active = true;
        if (MODE == AT_NA) { const int kr = a.kr0 + kt; active = (kr >= rsq) && (kr < rsq + 8); }
        if (MODE == AT_SWA) { const int pk0 = a.kpos0 + 64 * kt; active = (pk0 <= pqw + 31 + 128) && (pk0 + 63 >= pqw - 128); }
        if (active) {
            f16v x[2];
#pragma unroll
            for (int i = 0; i < 2; ++i) {
#pragma unroll
                for (int e = 0; e < 16; ++e) x[i][e] = 0.f;
                const hf* kp = Ks + (32 * i + ql) * KST + 8 * h;
#pragma unroll
                for (int s = 0; s < DQK / 16; ++s) { const h8 kf = *(const h8*)(kp + 16 * s); x[i] = MFMA32(kf, qf[s], x[i]); }
            }
            if (MODE == AT_NA) {
                const int kr = a.kr0 + kt;
                const int brow = (kr - qr + 7) * 31;
#pragma unroll
                for (int i = 0; i < 2; ++i)
#pragma unroll
                    for (int e = 0; e < 16; ++e) {
                        const int kcol = 32 * i + (e & 3) + 8 * (e >> 2) + 4 * h;
                        const bool v = (kcol >= csq) && (kcol < csq + 16);
                        const int bi = v ? (brow + kcol - qc + 15) : 0;
                        const float bb = biasL[bi];
                        x[i][e] = v ? (x[i][e] + bb) : NEG_BIG;
                    }
            } else if (MODE == AT_SWA) {
                const int pk0 = a.kpos0 + 64 * kt;
#pragma unroll
                for (int i = 0; i < 2; ++i)
#pragma unroll
                    for (int e = 0; e < 16; ++e) {
                        const int pk = pk0 + 32 * i + (e & 3) + 8 * (e >> 2) + 4 * h;
                        const int dd = pq - pk;
                        const bool v = (dd <= 128) && (dd >= -128);
                        x[i][e] = v ? x[i][e] : NEG_BIG;
                    }
            }
            float mx = x[0][0];
#pragma unroll
            for (int e = 1; e < 16; ++e) mx = fmaxf(mx, x[0][e]);
#pragma unroll
            for (int e = 0; e < 16; ++e) mx = fmaxf(mx, x[1][e]);
            mx = fmaxf(mx, __shfl_xor(mx, 32));
            const float mnew = fmaxf(m, mx);
            const float alpha = __builtin_amdgcn_exp2f(m - mnew);
            m = mnew;
            float ps = 0.f;
#pragma unroll
            for (int i = 0; i < 2; ++i)
#pragma unroll
                for (int e = 0; e < 16; ++e) { const float pv = __builtin_amdgcn_exp2f(x[i][e] - mnew); x[i][e] = pv; ps += pv; }
            l = l * alpha + ps;
#pragma unroll
            for (int e = 0; e < 16; ++e) { o[0][e] *= alpha; o[1][e] *= alpha; }
#pragma unroll
            for (int i = 0; i < 2; ++i)
#pragma unroll
                for (int sp = 0; sp < 2; ++sp) {
                    h8 pf;
#pragma unroll
                    for (int j = 0; j < 8; ++j) pf[j] = (hf)x[i][8 * sp + j];
#pragma unroll
                    for (int dt = 0; dt < 2; ++dt) {
                        const hf* vp = Vs + (32 * dt + ql) * VST + 32 * i + 16 * sp + 4 * h;
                        const h4 v0 = *(const h4*)vp, v1 = *(const h4*)(vp + 8);
                        h8 vf; vf[0] = v0[0]; vf[1] = v0[1]; vf[2] = v0[2]; vf[3] = v0[3]; vf[4] = v1[0]; vf[5] = v1[1]; vf[6] = v1[2]; vf[7] = v1[3];
                        o[dt] = MFMA32(vf, pf, o[dt]);
                    }
                }
        }
      }
    }
    l += __shfl_xor(l, 32);
    const float inv = 1.f / l;
    hf* op = a.O + (size_t)(a.t0 + qrow) * 1024;
#pragma unroll
    for (int dt = 0; dt < 2; ++dt)
#pragma unroll
        for (int g = 0; g < 4; ++g) {
            h4 v; v[0] = (hf)(o[dt][4 * g] * inv); v[1] = (hf)(o[dt][4 * g + 1] * inv); v[2] = (hf)(o[dt][4 * g + 2] * inv); v[3] = (hf)(o[dt][4 * g + 3] * inv);
            *(h4*)(op + 32 * dt + 8 * g + 4 * h) = v;
        }
}


#define SBAR __builtin_amdgcn_sched_barrier(0)
DI void mla_item(const AttnArgs& a, char* smem) {
    constexpr int KROWB = 208, VROWB = 144;
    constexpr int KSLOT = 64 * KROWB, VSLOT = 64 * VROWB, SLOT = KSLOT + VSLOT, NST = 5, DUMP = NST * SLOT;
    LAS char* lds = (LAS char*)smem;
    const int tid = tid_opaque(), lane = tid & 63, wid = __builtin_amdgcn_readfirstlane(tid >> 6), ql = lane & 31, h = lane >> 5;
    const int qrow = 32 * wid + ql;
    h8 qf[6];
    {
        const hf* qp = a.Q + (size_t)(a.t0 + qrow) * a.qs + 8 * h;
#pragma unroll
        for (int s = 0; s < 6; ++s) qf[s] = *(const h8*)(qp + 16 * s);
    }
    float mref = 0.f, l = 0.f;
    f16v o0, o1;
#pragma unroll
    for (int e = 0; e < 16; ++e) { o0[e] = 0.f; o1[e] = 0.f; }
    const hf *kq0, *kq1, *vq0, *vq1; int kst0, kst1;
    {
        int row = tid / 13, kc = tid % 13; if (kc == 12) kc = 0;
        if (kc < 8) { kq0 = a.K + (size_t)row * a.ks + kc * 8; kst0 = a.ks; } else { kq0 = a.Kx + (size_t)row * 32 + (kc - 8) * 8; kst0 = 32; }
        const int p1 = tid + NT < 832 ? tid + NT : tid;
        row = p1 / 13; kc = p1 % 13; if (kc == 12) kc = 0;
        if (kc < 8) { kq1 = a.K + (size_t)row * a.ks + kc * 8; kst1 = a.ks; } else { kq1 = a.Kx + (size_t)row * 32 + (kc - 8) * 8; kst1 = 32; }
        int d = tid / 9, c = tid % 9; if (c == 8) c = 0;
        vq0 = a.Vt + (size_t)d * T + c * 8;
        const int p2 = tid + NT < 576 ? tid + NT : tid;
        d = p2 / 9; c = p2 % 9; if (c == 8) c = 0;
        vq1 = a.Vt + (size_t)d * T + c * 8;
    }
    const unsigned k1dst = wid < 5 ? (unsigned)(8192 + wid * 1024) : 0xffffffffu, v1dst = wid < 1 ? (unsigned)(KSLOT + 8192 + wid * 1024) : 0xffffffffu;
    auto issue = [&](int kt) {
        const int ktc = kt < a.nkt ? kt : a.nkt - 1;
        const size_t tok0 = (size_t)(a.kt0 + 64 * ktc);
        const unsigned sb = (unsigned)((kt % NST) * SLOT), dump = (unsigned)(DUMP + wid * 1024);
        __builtin_amdgcn_global_load_lds((const unsigned*)(kq0 + tok0 * kst0), (LAS unsigned*)(lds + sb + wid * 1024), 16, 0, 0);
        __builtin_amdgcn_global_load_lds((const unsigned*)(kq1 + tok0 * kst1), (LAS unsigned*)(lds + (k1dst != 0xffffffffu ? sb + k1dst : dump)), 16, 0, 0);
        __builtin_amdgcn_global_load_lds((const unsigned*)(vq0 + tok0), (LAS unsigned*)(lds + sb + KSLOT + wid * 1024), 16, 0, 0);
        __builtin_amdgcn_global_load_lds((const unsigned*)(vq1 + tok0), (LAS unsigned*)(lds + (v1dst != 0xffffffffu ? sb + v1dst : dump)), 16, 0, 0);
    };
    asm volatile("s_waitcnt vmcnt(0)" ::: "memory");
    __syncthreads();
    issue(0); issue(1); issue(2); issue(3);
    asm volatile("s_waitcnt vmcnt(8)" ::: "memory");
    __builtin_amdgcn_s_barrier();
    asm volatile("" ::: "memory");
    const int koff = ql * KROWB + 16 * h, voff = KSLOT + ql * VROWB + 8 * h;
#define KFR(slot, i, s) (*(const LAS h8*)(lds + (slot) * SLOT + koff + (i) * 32 * KROWB + 32 * (s)))
#define VLD(dst, slot, dt, i, sp) { const LAS char* vp_ = lds + (slot) * SLOT + voff + (dt) * 32 * VROWB + 64 * (i) + 32 * (sp); const h4 v0_ = *(const LAS h4*)vp_, v1_ = *(const LAS h4*)(vp_ + 16); \
        dst[0] = v0_[0]; dst[1] = v0_[1]; dst[2] = v0_[2]; dst[3] = v0_[3]; dst[4] = v1_[0]; dst[5] = v1_[1]; dst[6] = v1_[2]; dst[7] = v1_[3]; }
#define EX2(x, e, P, j) { const float p0_ = __builtin_amdgcn_exp2f(x[e]); const float p1_ = __builtin_amdgcn_exp2f(x[(e) + 1]); psA += p0_; psB += p1_; P[j] = (hf)p0_; P[(j) + 1] = (hf)p1_; }
    f16v xc0, xc1, xn0, xn1;
    {
#pragma unroll
        for (int e = 0; e < 16; ++e) { xc0[e] = 0.f; xc1[e] = 0.f; }
#pragma unroll
        for (int s = 0; s < 6; ++s) { const h8 kf = KFR(0, 0, s); xc0 = MFMA32(kf, qf[s], xc0); }
#pragma unroll
        for (int s = 0; s < 6; ++s) { const h8 kf = KFR(0, 1, s); xc1 = MFMA32(kf, qf[s], xc1); }
    }
    float tmax;
    {
        float mx = xc0[0];
#pragma unroll
        for (int e = 1; e < 16; ++e) mx = fmaxf(mx, xc0[e]);
#pragma unroll
        for (int e = 0; e < 16; ++e) mx = fmaxf(mx, xc1[e]);
        mx = fmaxf(mx, __shfl_xor(mx, 32));
        mref = mx;
#pragma unroll
        for (int e = 0; e < 16; ++e) { xc0[e] -= mx; xc1[e] -= mx; }
        tmax = 0.f;
    }
    int cb = 0;
    for (int kt = 0; kt + 1 < a.nkt; ++kt) {
        if (__any(tmax > 8.f)) {
            const float delta = tmax > 8.f ? tmax : 0.f;
            mref += delta;
            const float alpha = __builtin_amdgcn_exp2f(-delta);
            l *= alpha;
#pragma unroll
            for (int e = 0; e < 16; ++e) { xc0[e] -= delta; xc1[e] -= delta; o0[e] *= alpha; o1[e] *= alpha; }
        }
        const int nb = cb == NST - 1 ? 0 : cb + 1;
        issue(kt + 4);
        h8 kA0 = KFR(nb, 0, 0), kA1 = KFR(nb, 0, 1), kA2 = KFR(nb, 0, 2), kB0 = KFR(nb, 0, 3), kB1 = KFR(nb, 0, 4), kB2 = KFR(nb, 0, 5);
        const float ini = -mref;
#pragma unroll
        for (int e = 0; e < 16; ++e) { xn0[e] = ini; xn1[e] = ini; }
        float psA = 0.f, psB = 0.f;
        h8 P00, P01, P10, P11, vA0, vA1, vB0, vB1;
        SBAR;
        xn0 = MFMA32(kA0, qf[0], xn0); SBAR; EX2(xc0, 0, P00, 0); SBAR;
        xn0 = MFMA32(kA1, qf[1], xn0); SBAR; EX2(xc0, 2, P00, 2); SBAR;
        xn0 = MFMA32(kA2, qf[2], xn0); SBAR; kA0 = KFR(nb, 1, 0); kA1 = KFR(nb, 1, 1); kA2 = KFR(nb, 1, 2); EX2(xc0, 4, P00, 4); SBAR;
        xn0 = MFMA32(kB0, qf[3], xn0); SBAR; EX2(xc0, 6, P00, 6); SBAR;
        xn0 = MFMA32(kB1, qf[4], xn0); SBAR; EX2(xc0, 8, P01, 0); SBAR;
        xn0 = MFMA32(kB2, qf[5], xn0); SBAR; kB0 = KFR(nb, 1, 3); kB1 = KFR(nb, 1, 4); kB2 = KFR(nb, 1, 5); EX2(xc0, 10, P01, 2); SBAR;
        xn1 = MFMA32(kA0, qf[0], xn1); SBAR; EX2(xc0, 12, P01, 4); SBAR;
        xn1 = MFMA32(kA1, qf[1], xn1); SBAR; EX2(xc0, 14, P01, 6); SBAR;
        xn1 = MFMA32(kA2, qf[2], xn1); SBAR; VLD(vA0, cb, 0, 0, 0); VLD(vA1, cb, 1, 0, 0); EX2(xc1, 0, P10, 0); SBAR;
        xn1 = MFMA32(kB0, qf[3], xn1); SBAR; EX2(xc1, 2, P10, 2); SBAR;
        xn1 = MFMA32(kB1, qf[4], xn1); SBAR; VLD(vB0, cb, 0, 0, 1); VLD(vB1, cb, 1, 0, 1); EX2(xc1, 4, P10, 4); SBAR;
        xn1 = MFMA32(kB2, qf[5], xn1); SBAR; EX2(xc1, 6, P10, 6); SBAR;
        o0 = MFMA32(vA0, P00, o0); SBAR; EX2(xc1, 8, P11, 0); SBAR;
        o1 = MFMA32(vA1, P00, o1); SBAR; VLD(vA0, cb, 0, 1, 0); VLD(vA1, cb, 1, 1, 0); EX2(xc1, 10, P11, 2); SBAR;
        o0 = MFMA32(vB0, P01, o0); SBAR; EX2(xc1, 12, P11, 4); SBAR;
        o1 = MFMA32(vB1, P01, o1); SBAR; VLD(vB0, cb, 0, 1, 1); VLD(vB1, cb, 1, 1, 1); EX2(xc1, 14, P11, 6); SBAR;
        float mx;
        o0 = MFMA32(vA0, P10, o0); SBAR; mx = fmaxf(fmaxf(xn0[0], xn0[1]), xn0[2]); mx = fmaxf(fmaxf(mx, xn0[3]), xn0[4]); mx = fmaxf(fmaxf(mx, xn0[5]), xn0[6]); mx = fmaxf(fmaxf(mx, xn0[7]), xn0[8]); SBAR;
        o1 = MFMA32(vA1, P10, o1); SBAR; mx = fmaxf(fmaxf(mx, xn0[9]), xn0[10]); mx = fmaxf(fmaxf(mx, xn0[11]), xn0[12]); mx = fmaxf(fmaxf(mx, xn0[13]), xn0[14]); mx = fmaxf(fmaxf(mx, xn0[15]), xn1[0]); SBAR;
        o0 = MFMA32(vB0, P11, o0); SBAR; mx = fmaxf(fmaxf(mx, xn1[1]), xn1[2]); mx = fmaxf(fmaxf(mx, xn1[3]), xn1[4]); mx = fmaxf(fmaxf(mx, xn1[5]), xn1[6]); mx = fmaxf(fmaxf(mx, xn1[7]), xn1[8]); SBAR;
        o1 = MFMA32(vB1, P11, o1); SBAR; mx = fmaxf(fmaxf(mx, xn1[9]), xn1[10]); mx = fmaxf(fmaxf(mx, xn1[11]), xn1[12]); mx = fmaxf(fmaxf(mx, xn1[13]), xn1[14]); mx = fmaxf(mx, xn1[15]); SBAR;
        tmax = fmaxf(mx, __shfl_xor(mx, 32));
        l += psA + psB;
        asm volatile("s_waitcnt vmcnt(8)" ::: "memory");
        __builtin_amdgcn_s_barrier();
        asm volatile("" ::: "memory");
        xc0 = xn0; xc1 = xn1; cb = nb;
    }
    {
        if (__any(tmax > 8.f)) {
            const float delta = tmax > 8.f ? tmax : 0.f;
            mref += delta;
            const float alpha = __builtin_amdgcn_exp2f(-delta);
            l *= alpha;
#pragma unroll
            for (int e = 0; e < 16; ++e) { xc0[e] -= delta; xc1[e] -= delta; o0[e] *= alpha; o1[e] *= alpha; }
        }
        float psA = 0.f, psB = 0.f;
        h8 P00, P01, P10, P11, vA0, vA1;
        EX2(xc0, 0, P00, 0); EX2(xc0, 2, P00, 2); EX2(xc0, 4, P00, 4); EX2(xc0, 6, P00, 6);
        EX2(xc0, 8, P01, 0); EX2(xc0, 10, P01, 2); EX2(xc0, 12, P01, 4); EX2(xc0, 14, P01, 6);
        EX2(xc1, 0, P10, 0); EX2(xc1, 2, P10, 2); EX2(xc1, 4, P10, 4); EX2(xc1, 6, P10, 6);
        EX2(xc1, 8, P11, 0); EX2(xc1, 10, P11, 2); EX2(xc1, 12, P11, 4); EX2(xc1, 14, P11, 6);
        l += psA + psB;
        VLD(vA0, cb, 0, 0, 0); VLD(vA1, cb, 1, 0, 0); o0 = MFMA32(vA0, P00, o0); o1 = MFMA32(vA1, P00, o1);
        VLD(vA0, cb, 0, 0, 1); VLD(vA1, cb, 1, 0, 1); o0 = MFMA32(vA0, P01, o0); o1 = MFMA32(vA1, P01, o1);
        VLD(vA0, cb, 0, 1, 0); VLD(vA1, cb, 1, 1, 0); o0 = MFMA32(vA0, P10, o0); o1 = MFMA32(vA1, P10, o1);
        VLD(vA0, cb, 0, 1, 1); VLD(vA1, cb, 1, 1, 1); o0 = MFMA32(vA0, P11, o0); o1 = MFMA32(vA1, P11, o1);
    }
#undef KFR
#undef VLD
#undef EX2
    asm volatile("s_waitcnt vmcnt(0)" ::: "memory");
    l += __shfl_xor(l, 32);
    const float inv = 1.f / l;
    hf* op = a.O + (size_t)(a.t0 + qrow) * 1024;
#pragma unroll
    for (int g = 0; g < 4; ++g) {
        h4 v; v[0] = (hf)(o0[4 * g] * inv); v[1] = (hf)(o0[4 * g + 1] * inv); v[2] = (hf)(o0[4 * g + 2] * inv); v[3] = (hf)(o0[4 * g + 3] * inv);
        *(h4*)(op + 8 * g + 4 * h) = v;
        h4 w; w[0] = (hf)(o1[4 * g] * inv); w[1] = (hf)(o1[4 * g + 1] * inv); w[2] = (hf)(o1[4 * g + 2] * inv); w[3] = (hf)(o1[4 * g + 3] * inv);
        *(h4*)(op + 32 + 8 * g + 4 * h) = w;
    }
}

DI void mla_item64(const AttnArgs& a, char* smem) {
    constexpr int KROWB = 208, VROWB = 144;
    constexpr int KSLOT = 64 * KROWB, VSLOT = 64 * VROWB, SLOT = KSLOT + VSLOT, NST = 5, DUMP = NST * SLOT;
    LAS char* lds = (LAS char*)smem;
    const int tid = tid_opaque(), lane = tid & 63, wid = __builtin_amdgcn_readfirstlane(tid >> 6), ql = lane & 31, h = lane >> 5;
    const int rowA = 64 * wid + ql, rowB = rowA + 32;
    h8 qA[6], qB[6];
    {
        const hf* qp = a.Q + (size_t)(a.t0 + rowA) * a.qs + 8 * h;
#pragma unroll
        for (int s = 0; s < 6; ++s) { qA[s] = *(const h8*)(qp + 16 * s); qB[s] = *(const h8*)(qp + (size_t)32 * a.qs + 16 * s); }
    }
    float mA = NEG_BIG, lA = 0.f, mB = NEG_BIG, lB = 0.f;
    f16v oA0, oA1, oB0, oB1;
#pragma unroll
    for (int e = 0; e < 16; ++e) { oA0[e] = 0.f; oA1[e] = 0.f; oB0[e] = 0.f; oB1[e] = 0.f; }
    const hf *kq0, *kq1, *vq0, *vq1; int kst0, kst1;
    {
        int row = tid / 13, kc = tid % 13; if (kc == 12) kc = 0;
        if (kc < 8) { kq0 = a.K + (size_t)row * a.ks + kc * 8; kst0 = a.ks; } else { kq0 = a.Kx + (size_t)row * 32 + (kc - 8) * 8; kst0 = 32; }
        const int p1 = tid + NT < 832 ? tid + NT : tid;
        row = p1 / 13; kc = p1 % 13; if (kc == 12) kc = 0;
        if (kc < 8) { kq1 = a.K + (size_t)row * a.ks + kc * 8; kst1 = a.ks; } else { kq1 = a.Kx + (size_t)row * 32 + (kc - 8) * 8; kst1 = 32; }
        int d = tid / 9, c = tid % 9; if (c == 8) c = 0;
        vq0 = a.Vt + (size_t)d * T + c * 8;
        const int p2 = tid + NT < 576 ? tid + NT : tid;
        d = p2 / 9; c = p2 % 9; if (c == 8) c = 0;
        vq1 = a.Vt + (size_t)d * T + c * 8;
    }
    const unsigned k1dst = wid < 5 ? (unsigned)(8192 + wid * 1024) : 0xffffffffu, v1dst = wid < 1 ? (unsigned)(KSLOT + 8192 + wid * 1024) : 0xffffffffu;
    auto issue = [&](int kt) {
        const int ktc = kt < a.nkt ? kt : a.nkt - 1;
        const size_t tok0 = (size_t)(a.kt0 + 64 * ktc);
        const unsigned sb = (unsigned)((kt % NST) * SLOT), dump = (unsigned)(DUMP + wid * 1024);
        __builtin_amdgcn_global_load_lds((const unsigned*)(kq0 + tok0 * kst0), (LAS unsigned*)(lds + sb + wid * 1024), 16, 0, 0);
        __builtin_amdgcn_global_load_lds((const unsigned*)(kq1 + tok0 * kst1), (LAS unsigned*)(lds + (k1dst != 0xffffffffu ? sb + k1dst : dump)), 16, 0, 0);
        __builtin_amdgcn_global_load_lds((const unsigned*)(vq0 + tok0), (LAS unsigned*)(lds + sb + KSLOT + wid * 1024), 16, 0, 0);
        __builtin_amdgcn_global_load_lds((const unsigned*)(vq1 + tok0), (LAS unsigned*)(lds + (v1dst != 0xffffffffu ? sb + v1dst : dump)), 16, 0, 0);
    };
#pragma unroll
    for (int s = 0; s < 6; ++s) asm volatile("" :: "v"(qA[s]), "v"(qB[s]));
    asm volatile("s_waitcnt vmcnt(0)" ::: "memory");
    __syncthreads();
    issue(0); issue(1); issue(2); issue(3);
    asm volatile("s_waitcnt vmcnt(12)" ::: "memory");
    __builtin_amdgcn_s_barrier();
    asm volatile("" ::: "memory");
    const int koff = ql * KROWB + 16 * h, voff = KSLOT + ql * VROWB + 8 * h;
    int cb = 0;
    for (int kt = 0; kt < a.nkt; ++kt) {
        issue(kt + 4);
        const LAS char* kb = lds + cb * SLOT + koff;
        const LAS char* vb = lds + cb * SLOT + voff;
        f16v xA0, xA1, xB0, xB1;
#pragma unroll
        for (int e = 0; e < 16; ++e) { xA0[e] = 0.f; xA1[e] = 0.f; xB0[e] = 0.f; xB1[e] = 0.f; }
        h8 k0 = *(const LAS h8*)kb, k1 = *(const LAS h8*)(kb + 32 * KROWB);
#pragma unroll
        for (int s = 0; s < 6; ++s) {
            h8 n0 = k0, n1 = k1;
            if (s < 5) { n0 = *(const LAS h8*)(kb + 32 * (s + 1)); n1 = *(const LAS h8*)(kb + 32 * KROWB + 32 * (s + 1)); }
            xA0 = MFMA32(k0, qA[s], xA0); xB0 = MFMA32(k0, qB[s], xB0);
            xA1 = MFMA32(k1, qA[s], xA1); xB1 = MFMA32(k1, qB[s], xB1);
            k0 = n0; k1 = n1;
        }
        float alA, alB;
        {
            float mx = xA0[0];
#pragma unroll
            for (int e = 1; e < 16; ++e) mx = fmaxf(mx, xA0[e]);
#pragma unroll
            for (int e = 0; e < 16; ++e) mx = fmaxf(mx, xA1[e]);
            mx = fmaxf(mx, __shfl_xor(mx, 32));
            const float mn = fmaxf(mA, mx); alA = __builtin_amdgcn_exp2f(mA - mn); mA = mn;
            float ps = 0.f;
#pragma unroll
            for (int e = 0; e < 16; ++e) { const float p0 = __builtin_amdgcn_exp2f(xA0[e] - mn); xA0[e] = p0; const float p1 = __builtin_amdgcn_exp2f(xA1[e] - mn); xA1[e] = p1; ps += p0 + p1; }
            lA = lA * alA + ps;
#pragma unroll
            for (int e = 0; e < 16; ++e) { oA0[e] *= alA; oA1[e] *= alA; }
        }
        {
            float mx = xB0[0];
#pragma unroll
            for (int e = 1; e < 16; ++e) mx = fmaxf(mx, xB0[e]);
#pragma unroll
            for (int e = 0; e < 16; ++e) mx = fmaxf(mx, xB1[e]);
            mx = fmaxf(mx, __shfl_xor(mx, 32));
            const float mn = fmaxf(mB, mx); alB = __builtin_amdgcn_exp2f(mB - mn); mB = mn;
            float ps = 0.f;
#pragma unroll
            for (int e = 0; e < 16; ++e) { const float p0 = __builtin_amdgcn_exp2f(xB0[e] - mn); xB0[e] = p0; const float p1 = __builtin_amdgcn_exp2f(xB1[e] - mn); xB1[e] = p1; ps += p0 + p1; }
            lB = lB * alB + ps;
#pragma unroll
            for (int e = 0; e < 16; ++e) { oB0[e] *= alB; oB1[e] *= alB; }
        }
#pragma unroll
        for (int i = 0; i < 2; ++i)
#pragma unroll
            for (int sp = 0; sp < 2; ++sp) {
                h8 pA, pB;
#pragma unroll
                for (int j = 0; j < 8; ++j) { pA[j] = (hf)(i == 0 ? xA0[8 * sp + j] : xA1[8 * sp + j]); pB[j] = (hf)(i == 0 ? xB0[8 * sp + j] : xB1[8 * sp + j]); }
#pragma unroll
                for (int dt = 0; dt < 2; ++dt) {
                    const LAS char* vp = vb + dt * 32 * VROWB + 64 * i + 32 * sp;
                    const h4 v0 = *(const LAS h4*)vp, v1 = *(const LAS h4*)(vp + 16);
                    h8 vf; vf[0] = v0[0]; vf[1] = v0[1]; vf[2] = v0[2]; vf[3] = v0[3]; vf[4] = v1[0]; vf[5] = v1[1]; vf[6] = v1[2]; vf[7] = v1[3];
                    if (dt == 0) { oA0 = MFMA32(vf, pA, oA0); oB0 = MFMA32(vf, pB, oB0); } else { oA1 = MFMA32(vf, pA, oA1); oB1 = MFMA32(vf, pB, oB1); }
                }
            }
        asm volatile("s_waitcnt vmcnt(12)" ::: "memory");
        __builtin_amdgcn_s_barrier();
        asm volatile("" ::: "memory");
        cb = cb == NST - 1 ? 0 : cb + 1;
    }
    asm volatile("s_waitcnt vmcnt(0)" ::: "memory");
    lA += __shfl_xor(lA, 32); lB += __shfl_xor(lB, 32);
    const float ia = 1.f / lA, ib = 1.f / lB;
    hf* opA = a.O + (size_t)(a.t0 + rowA) * 1024; hf* opB = opA + (size_t)32 * 1024;
#pragma unroll
    for (int g = 0; g < 4; ++g) {
        h4 v;
        v[0] = (hf)(oA0[4 * g] * ia); v[1] = (hf)(oA0[4 * g + 1] * ia); v[2] = (hf)(oA0[4 * g + 2] * ia); v[3] = (hf)(oA0[4 * g + 3] * ia); *(h4*)(opA + 8 * g + 4 * h) = v;
        v[0] = (hf)(oA1[4 * g] * ia); v[1] = (hf)(oA1[4 * g + 1] * ia); v[2] = (hf)(oA1[4 * g + 2] * ia); v[3] = (hf)(oA1[4 * g + 3] * ia); *(h4*)(opA + 32 + 8 * g + 4 * h) = v;
        v[0] = (hf)(oB0[4 * g] * ib); v[1] = (hf)(oB0[4 * g + 1] * ib); v[2] = (hf)(oB0[4 * g + 2] * ib); v[3] = (hf)(oB0[4 * g + 3] * ib); *(h4*)(opB + 8 * g + 4 * h) = v;
        v[0] = (hf)(oB1[4 * g] * ib); v[1] = (hf)(oB1[4 * g + 1] * ib); v[2] = (hf)(oB1[4 * g + 2] * ib); v[3] = (hf)(oB1[4 * g + 3] * ib); *(h4*)(opB + 32 + 8 * g + 4 * h) = v;
    }
}

__device__ void phase_attn0(const Params& p, char* smem) {
    char* ws = p.ws;
    const int tid = tid_opaque();
    for (int it = blockIdx.x; it < 768 + 1536; it += gridDim.x) {
        AttnArgs a{};
        a.O = (hf*)(ws + OFF_AO);
        if (it < 768) {
            int head, s0, L, t0;
            if (it < 512) { const int u = (it & 7) + 8 * (it >> 7), qb = (it >> 3) & 15; const int sq = u >> 3; head = u & 7; s0 = sq * 8192; L = 8192; t0 = s0 + qb * 512; }
            else { const int j = it - 512; head = j & 7; s0 = TP; L = 16384; t0 = s0 + (j >> 3) * 512; }
            a.Q = (const hf*)p.out + head * 96; a.qs = 768;
            a.K = (const hf*)(ws + OFF_KN) + head * 64; a.ks = 512;
            a.Kx = (const hf*)(ws + OFF_KR);
            a.Vt = (const hf*)(ws + OFF_VMT) + (size_t)head * 64 * T;
            a.O += 512 + head * 64;
            a.t0 = t0; a.kt0 = s0; a.nkt = L / 64;
            mla_item64(a, smem);
        } else {
            const int i2 = it - 768, head = i2 & 7, qblk = i2 >> 3, t0 = qblk * 256;
            int s0, L; seq_of(t0, s0, L);
            const int rows = L / 64, R0 = (t0 - s0) / 64;
            int rs0 = R0 - 4; rs0 = rs0 < 0 ? 0 : (rs0 > rows - 8 ? rows - 8 : rs0);
            int rs1 = R0 + 3 - 4; rs1 = rs1 < 0 ? 0 : (rs1 > rows - 8 ? rows - 8 : rs1);
            __syncthreads();
            float* biasL = (float*)(smem + LDS_NAB);
            for (int i = tid; i < 465; i += NT) biasL[i] = p.in[3][head * 465 + i] * LOG2E;
            a.Q = (const hf*)(ws + OFF_QA) + head * 64; a.qs = 512;
            a.K = (const hf*)(ws + OFF_KA) + head * 64; a.ks = 512;
            a.Vt = (const hf*)(ws + OFF_VAT) + (size_t)head * 64 * T;
            a.O += head * 64;
            a.t0 = t0; a.kt0 = s0 + 64 * rs0; a.nkt = rs1 + 8 - rs0;
            a.R0 = R0; a.rows = rows; a.kr0 = rs0;
            attn_item<64, AT_NA>(a, smem);
        }
    }
}

DI void swa_stage(const AttnArgs& a, char* smem) {
    constexpr int KST = 72, VST = 68;
    const int tid = tid_opaque(), krow = tid >> 3, kkc = tid & 7;
    const hf* kbase = a.K + (size_t)(a.kt0 + krow) * a.ks + kkc * 8;
    const hf* vbase = a.Vt + (size_t)krow * T + a.kt0 + kkc * 8;
    h8 rk[8], rv[8];
#pragma unroll
    for (int kt = 0; kt < 8; ++kt) if (kt < a.nkt) { rk[kt] = *(const h8*)(kbase + (size_t)(64 * kt) * a.ks); rv[kt] = *(const h8*)(vbase + 64 * kt); }
    __syncthreads();
#pragma unroll
    for (int kt = 0; kt < 8; ++kt) if (kt < a.nkt) {
        hf* Ks = (hf*)(smem + kt * SWA_TILE); hf* Vs = Ks + 64 * KST;
        *(h8*)(Ks + krow * KST + kkc * 8) = rk[kt];
        h4 lo, hi; lo[0] = rv[kt][0]; lo[1] = rv[kt][1]; lo[2] = rv[kt][2]; lo[3] = rv[kt][3]; hi[0] = rv[kt][4]; hi[1] = rv[kt][5]; hi[2] = rv[kt][6]; hi[3] = rv[kt][7];
        *(h4*)(Vs + krow * VST + kkc * 8) = lo; *(h4*)(Vs + krow * VST + kkc * 8 + 4) = hi;
    }
    __syncthreads();
}
DI void swa_pair(const AttnArgs& a, const hf* QB, hf* OB, float sinkB, char* smem) {
    constexpr int KST = 72, VST = 68;
    const int tid = tid_opaque(), lane = tid & 63, wave = tid >> 6, ql = lane & 31, h = lane >> 5;
    const int qrow = 32 * wave + ql;
    h8 qa[4], qb[4];
    {
        const hf* pa = a.Q + (size_t)(a.t0 + qrow) * a.qs + 8 * h; const hf* pb = QB + (size_t)(a.t0 + qrow) * a.qs + 8 * h;
#pragma unroll
        for (int s = 0; s < 4; ++s) { qa[s] = *(const h8*)(pa + 16 * s); qb[s] = *(const h8*)(pb + 16 * s); }
    }
    float mA = a.sink, mB = sinkB, lA = (h == 0) ? 1.f : 0.f, lB = lA;
    f16v oA0, oA1, oB0, oB1;
#pragma unroll
    for (int e = 0; e < 16; ++e) { oA0[e] = 0.f; oA1[e] = 0.f; oB0[e] = 0.f; oB1[e] = 0.f; }
    const int pq = a.qpos0 + qrow, pqw = a.qpos0 + 32 * wave;
    for (int kt = 0; kt < a.nkt; ++kt) {
        const hf* Ks = (const hf*)(smem + kt * SWA_TILE);
        const hf* Vs = Ks + 64 * KST;
        const int pk0 = a.kpos0 + 64 * kt;
        if ((pk0 <= pqw + 31 + 128) && (pk0 + 63 >= pqw - 128)) {
            f16v xA0, xA1, xB0, xB1;
#pragma unroll
            for (int e = 0; e < 16; ++e) { xA0[e] = 0.f; xA1[e] = 0.f; xB0[e] = 0.f; xB1[e] = 0.f; }
            const hf* kp = Ks + ql * KST + 8 * h;
#pragma unroll
            for (int s = 0; s < 4; ++s) {
                const h8 k0 = *(const h8*)(kp + 16 * s), k1 = *(const h8*)(kp + 32 * KST + 16 * s);
                xA0 = MFMA32(k0, qa[s], xA0); xB0 = MFMA32(k0, qb[s], xB0);
                xA1 = MFMA32(k1, qa[s], xA1); xB1 = MFMA32(k1, qb[s], xB1);
            }
            if (!((pk0 >= pqw + 31 - 128) && (pk0 + 63 <= pqw + 128))) {
                const int base = pk0 + 4 * h - pq + 128;
#pragma unroll
                for (int e = 0; e < 16; ++e) {
                    const unsigned t0 = (unsigned)(base + (e & 3) + 8 * (e >> 2)), t1 = t0 + 32u;
                    if (t0 > 256u) { xA0[e] = NEG_BIG; xB0[e] = NEG_BIG; }
                    if (t1 > 256u) { xA1[e] = NEG_BIG; xB1[e] = NEG_BIG; }
                }
            }
            float mxa = xA0[0], mxb = xB0[0];
#pragma unroll
            for (int e = 1; e < 16; ++e) { mxa = fmaxf(mxa, xA0[e]); mxb = fmaxf(mxb, xB0[e]); }
#pragma unroll
            for (int e = 0; e < 16; ++e) { mxa = fmaxf(mxa, xA1[e]); mxb = fmaxf(mxb, xB1[e]); }
            const float pa_ = __shfl_xor(mxa, 32), pb_ = __shfl_xor(mxb, 32);
            const float mna = fmaxf(mA, fmaxf(mxa, pa_)), mnb = fmaxf(mB, fmaxf(mxb, pb_));
            const float alA = __builtin_amdgcn_exp2f(mA - mna), alB = __builtin_amdgcn_exp2f(mB - mnb); mA = mna; mB = mnb;
            float psa = 0.f, psb = 0.f;
#pragma unroll
            for (int e = 0; e < 16; ++e) {
                const float p0 = __builtin_amdgcn_exp2f(xA0[e] - mna), q0 = __builtin_amdgcn_exp2f(xB0[e] - mnb), p1 = __builtin_amdgcn_exp2f(xA1[e] - mna), q1 = __builtin_amdgcn_exp2f(xB1[e] - mnb);
                xA0[e] = p0; xB0[e] = q0; xA1[e] = p1; xB1[e] = q1; psa += p0 + p1; psb += q0 + q1;
            }
            lA = lA * alA + psa; lB = lB * alB + psb;
#pragma unroll
            for (int e = 0; e < 16; ++e) { oA0[e] *= alA; oB0[e] *= alB; oA1[e] *= alA; oB1[e] *= alB; }
#pragma unroll
            for (int i = 0; i < 2; ++i)
#pragma unroll
                for (int sp = 0; sp < 2; ++sp) {
                    h8 pA, pB;
#pragma unroll
                    for (int j = 0; j < 8; ++j) { pA[j] = (hf)(i == 0 ? xA0[8 * sp + j] : xA1[8 * sp + j]); pB[j] = (hf)(i == 0 ? xB0[8 * sp + j] : xB1[8 * sp + j]); }
#pragma unroll
                    for (int dt = 0; dt < 2; ++dt) {
                        const hf* vp = Vs + (32 * dt + ql) * VST + 32 * i + 16 * sp + 4 * h;
                        const h4 v0 = *(const h4*)vp, v1 = *(const h4*)(vp + 8);
                        h8 vf; vf[0] = v0[0]; vf[1] = v0[1]; vf[2] = v0[2]; vf[3] = v0[3]; vf[4] = v1[0]; vf[5] = v1[1]; vf[6] = v1[2]; vf[7] = v1[3];
                        if (dt == 0) { oA0 = MFMA32(vf, pA, oA0); oB0 = MFMA32(vf, pB, oB0); } else { oA1 = MFMA32(vf, pA, oA1); oB1 = MFMA32(vf, pB, oB1); }
                    }
                }
        }
    }
    lA += __shfl_xor(lA, 32); lB += __shfl_xor(lB, 32);
    const float ia = 1.f / lA, ib = 1.f / lB;
    hf* opA = a.O + (size_t)(a.t0 + qrow) * 1024; hf* opB = OB + (size_t)(a.t0 + qrow) * 1024;
#pragma unroll
    for (int g = 0; g < 4; ++g) {
        h4 v;
        v[0] = (hf)(oA0[4 * g] * ia); v[1] = (hf)(oA0[4 * g + 1] * ia); v[2] = (hf)(oA0[4 * g + 2] * ia); v[3] = (hf)(oA0[4 * g + 3] * ia); *(h4*)(opA + 8 * g + 4 * h) = v;
        v[0] = (hf)(oA1[4 * g] * ia); v[1] = (hf)(oA1[4 * g + 1] * ia); v[2] = (hf)(oA1[4 * g + 2] * ia); v[3] = (hf)(oA1[4 * g + 3] * ia); *(h4*)(opA + 32 + 8 * g + 4 * h) = v;
        v[0] = (hf)(oB0[4 * g] * ib); v[1] = (hf)(oB0[4 * g + 1] * ib); v[2] = (hf)(oB0[4 * g + 2] * ib); v[3] = (hf)(oB0[4 * g + 3] * ib); *(h4*)(opB + 8 * g + 4 * h) = v;
        v[0] = (hf)(oB1[4 * g] * ib); v[1] = (hf)(oB1[4 * g + 1] * ib); v[2] = (hf)(oB1[4 * g + 2] * ib); v[3] = (hf)(oB1[4 * g + 3] * ib); *(h4*)(opB + 32 + 8 * g + 4 * h) = v;
    }
}

__device__ void phase_attn1(const Params& p, char* smem) {
    char* ws = p.ws;
    for (int it = blockIdx.x; it < 192 * 4; it += gridDim.x) {
        const int hkv = it & 3, qblk = it >> 2, t0 = qblk * 256;
        int s0, L; seq_of(t0, s0, L);
        const int qpos0 = t0 - s0;
        const int ks = qpos0 - 128 < 0 ? 0 : qpos0 - 128, ke = qpos0 + 384 > L ? L : qpos0 + 384;
        AttnArgs a{};
        a.qs = 1024;
        a.K = (const hf*)(ws + OFF_K1) + hkv * 64; a.ks = 256;
        a.Vt = (const hf*)(ws + OFF_V1T) + (size_t)hkv * 64 * T;
        a.t0 = t0; a.kt0 = s0 + ks; a.nkt = (ke - ks) / 64;
        a.qpos0 = qpos0; a.kpos0 = ks;
        swa_stage(a, smem);
#pragma unroll 1
        for (int pr = 0; pr < 2; ++pr) {
            const int hq = 4 * hkv + 2 * pr;
            a.Q = (const hf*)(ws + OFF_Q1) + hq * 64; a.O = (hf*)(ws + OFF_AO) + hq * 64; a.sink = p.in[18][hq] * LOG2E;
            swa_pair(a, a.Q + 64, a.O + 64, p.in[18][hq + 1] * LOG2E, smem);
        }
    }
}

__device__ void phase_ln(const Params& p, const float* g, const float* b, bool last) {
    const int lane = tid_opaque() & 63;
    const int gw = (blockIdx.x * NT + tid_opaque()) >> 6, nw = gridDim.x * (NT / 64);
    hf* Xh = (hf*)(p.ws + OFF_XH);
    f4 gg[4], bb[4];
#pragma unroll
    for (int i = 0; i < 2; ++i) { gg[2 * i] = *(const f4*)(g + i * 512 + lane * 8); gg[2 * i + 1] = *(const f4*)(g + i * 512 + lane * 8 + 4); bb[2 * i] = *(const f4*)(b + i * 512 + lane * 8); bb[2 * i + 1] = *(const f4*)(b + i * 512 + lane * 8 + 4); }
    for (int row = gw; row < T; row += nw) {
        hf* y = Xh + (size_t)row * DM;
        f4 v[4];
#pragma unroll
        for (int i = 0; i < 2; ++i) {
            const h8 hv = *(const h8*)(y + i * 512 + lane * 8);
            v[2 * i] = (f4){(float)hv[0], (float)hv[1], (float)hv[2], (float)hv[3]}; v[2 * i + 1] = (f4){(float)hv[4], (float)hv[5], (float)hv[6], (float)hv[7]};
        }
        float s = 0.f;
#pragma unroll
        for (int i = 0; i < 4; ++i) s += v[i][0] + v[i][1] + v[i][2] + v[i][3];
        const float mu = wave_sum(s) * (1.f / 1024.f);
        float q = 0.f;
#pragma unroll
        for (int i = 0; i < 4; ++i) { v[i] = v[i] - mu; q += v[i][0] * v[i][0] + v[i][1] * v[i][1] + v[i][2] * v[i][2] + v[i][3] * v[i][3]; }
        const float rstd = rsqrtf(wave_sum(q) * (1.f / 1024.f) + EPS);
#pragma unroll
        for (int i = 0; i < 2; ++i) {
            const f4 o0 = v[2 * i] * rstd * gg[2 * i] + bb[2 * i], o1 = v[2 * i + 1] * rstd * gg[2 * i + 1] + bb[2 * i + 1];
            if (last) { float* op = p.out + (size_t)row * DM + i * 512 + lane * 8; *(f4*)op = o0; *(f4*)(op + 4) = o1; }
            else *(h8*)(y + i * 512 + lane * 8) = cvt8(o0, o1, 1.f);
        }
    }
}


#define XB_TMO      128
#define XB_XCNT(j)  (256  + 64 * (j))
#define XB_XSUB(j)  (1280 + 64 * (j))
#define XB_XGEN(j)  (2304 + 64 * (j))
#define XB_TOP      3328
#define XB_TOPGEN   3392
#define XCD_BAR_WORDS 3456
#define XB_SPIN_CAP (1u << 18)
DI unsigned xb_ld(unsigned* p)              { return __hip_atomic_load(p, __ATOMIC_RELAXED, __HIP_MEMORY_SCOPE_AGENT); }
DI unsigned xb_add(unsigned* p, unsigned v) { return __hip_atomic_fetch_add(p, v, __ATOMIC_RELAXED, __HIP_MEMORY_SCOPE_AGENT); }
DI unsigned xb_xcc_id() { return (unsigned)__builtin_amdgcn_s_getreg((3 << 11) | 20) & 0xFu; }
#define XB_SPIN(cond, bar) do { unsigned _sp = 0; while (cond) { __builtin_amdgcn_s_sleep(1); \
    if ((++_sp & 255u) == 0u) { if (xb_ld(&(bar)[XB_TMO])) break; if (_sp > XB_SPIN_CAP) { atomicAdd(&(bar)[XB_TMO], 1u); break; } } } } while (0)
struct XcdBarrier { unsigned* bar; unsigned x; volatile LAS unsigned* st; };
DI XcdBarrier xcd_barrier_post(unsigned* bar, volatile LAS unsigned* st) {
    XcdBarrier b; b.bar = bar; b.x = xb_xcc_id(); b.st = st;
    if (threadIdx.x == 0) (void)xb_add(&bar[XB_XCNT(b.x)], 1u);
    return b;
}
DI void xcd_barrier_complete(unsigned* bar, unsigned x, unsigned& nloc, unsigned& nx) {
    const unsigned G = gridDim.x * gridDim.y * gridDim.z;
    unsigned sum, cnt, mine, sp = 0u;
    for (;;) {
        sum = 0u; cnt = 0u; mine = 0u;
#pragma unroll
        for (unsigned j = 0; j < 16; ++j) { const unsigned c = xb_ld(&bar[XB_XCNT(j)]); sum += c; cnt += (c > 0u) ? 1u : 0u; mine = (j == x) ? c : mine; }
        if (sum == G) break;
        __builtin_amdgcn_s_sleep(1);
        if ((++sp & 255u) == 0u) { if (xb_ld(&bar[XB_TMO])) break; if (sp > XB_SPIN_CAP) { atomicAdd(&bar[XB_TMO], 1u); break; } }
    }
    nloc = mine > 0u ? mine : 1u; nx = cnt > 0u ? cnt : 1u;
}
DI void xcd_barrier(const XcdBarrier& b) {
    asm volatile("s_waitcnt vmcnt(0)" ::: "memory");
    __syncthreads();
    if (threadIdx.x == 0) {
        unsigned* bar = b.bar;
        __builtin_amdgcn_s_waitcnt(0);
        unsigned nloc = b.st[0], nx = b.st[1];
        if (nloc == 0u) { xcd_barrier_complete(bar, b.x, nloc, nx); b.st[0] = nloc; b.st[1] = nx; }
        const unsigned old = xb_add(&bar[XB_XSUB(b.x)], 1u);
        const unsigned gen = old / nloc;
        if (old + 1u == (gen + 1u) * nloc) {
            __builtin_amdgcn_fence(__ATOMIC_RELEASE, "agent");
            asm volatile("s_waitcnt vmcnt(0)" ::: "memory");
            const unsigned og = xb_add(&bar[XB_TOP], 1u);
            const unsigned tg = og / nx;
            if (og + 1u == (tg + 1u) * nx) xb_add(&bar[XB_TOPGEN], 1u);
            else XB_SPIN(xb_ld(&bar[XB_TOPGEN]) == tg, bar);
            __builtin_amdgcn_fence(__ATOMIC_ACQUIRE, "agent");
            xb_add(&bar[XB_XGEN(b.x)], 1u);
            asm volatile("s_waitcnt vmcnt(0)" ::: "memory");
        } else {
            XB_SPIN(xb_ld(&bar[XB_XGEN(b.x)]) == gen, bar);
            __builtin_amdgcn_fence(__ATOMIC_ACQUIRE, "agent");
            asm volatile("s_waitcnt vmcnt(0)" ::: "memory");
        }
    }
    __syncthreads();
}

constexpr int NPHASE = 16;
template <int PH> DI void run_phase(const Params& p, char* smem) {
    char* ws = p.ws;
    if (PH == 0) phase_prep(p, smem);
    else if (PH == 1) phase_gemm<G_IN0>(p, smem, (const hf*)(ws + OFF_XH), 1024, (const hf*)(ws + OFF_WIN0), 9, nullptr, nullptr);
    else if (PH == 2) phase_gemm<G_UP>(p, smem, (const hf*)(ws + OFF_QL), 384, (const hf*)(ws + OFF_WQUP), 3, nullptr, nullptr);
    else if (PH == 3) phase_attn0(p, smem);
    else if (PH == 4) phase_gemm<G_RES>(p, smem, (const hf*)(ws + OFF_AO), 1024, (const hf*)(ws + OFF_WOUT0), 4, nullptr, nullptr);
    else if (PH == 5) phase_ln(p, p.in[9], p.in[10], false);
    else if (PH == 6) phase_gemm<G_FFN>(p, smem, (const hf*)(ws + OFF_XH), 1024, (const hf*)(ws + OFF_WUP0), 22, p.in[12], p.in[13]);
    else if (PH == 7) phase_gemm<G_RES>(p, smem, (const hf*)(ws + OFF_U), 2816, (const hf*)(ws + OFF_WDN0), 4, nullptr, nullptr);
    else if (PH == 8) phase_ln(p, p.in[15], p.in[16], false);
    else if (PH == 9) phase_gemm<G_IN1>(p, smem, (const hf*)(ws + OFF_XH), 1024, (const hf*)(ws + OFF_WIN1), 6, nullptr, nullptr);
    else if (PH == 10) phase_attn1(p, smem);
    else if (PH == 11) phase_gemm<G_RES>(p, smem, (const hf*)(ws + OFF_AO), 1024, (const hf*)(ws + OFF_WOUT1), 4, nullptr, nullptr);
    else if (PH == 12) phase_ln(p, p.in[20], p.in[21], false);
    else if (PH == 13) phase_gemm<G_FFN>(p, smem, (const hf*)(ws + OFF_XH), 1024, (const hf*)(ws + OFF_WUP1), 22, p.in[23], p.in[24]);
    else if (PH == 14) phase_gemm<G_RES>(p, smem, (const hf*)(ws + OFF_U), 2816, (const hf*)(ws + OFF_WDN1), 4, nullptr, nullptr);
    else if (PH == 15) phase_ln(p, p.in[26], p.in[27], true);
}

template <int LO, int HI> struct PhaseLoop {
    static DI void run(const Params& p, char* smem, const XcdBarrier& xb) {
        for (int r = 0; r < ((PROBE_MASK >> LO) & 1) + 1; ++r) run_phase<LO>(p, smem);
        if (LO + 1 < HI) {
            if (LO == 0) cg::this_grid().sync(); else xcd_barrier(xb);
            for (int r = 0; r < PROBE_SYNCS; ++r) xcd_barrier(xb);
            PhaseLoop<LO + 1, HI>::run(p, smem, xb);
        }
    }
};
template <int HI> struct PhaseLoop<HI, HI> { static DI void run(const Params&, char*, const XcdBarrier&) {} };

__global__ void __launch_bounds__(NT) mega_kernel(Params p) {
    extern __shared__ __attribute__((aligned(16))) char smem[];
    volatile LAS unsigned* st = (volatile LAS unsigned*)(LAS char*)(smem + LDS_ST);
    if (threadIdx.x == 0) { st[0] = 0u; st[1] = 0u; }
    __syncthreads();
    const XcdBarrier xb = xcd_barrier_post((unsigned*)(p.ws + OFF_BAR), st);
    PhaseLoop<0, NPHASE>::run(p, smem, xb);
}
extern "C" void kernel_launch(void* const* d_in, const int* in_sizes, int n_in, void* d_out, int out_size, void* d_ws, size_t ws_size, hipStream_t stream) {
    static int grid = 0;
    if (grid == 0) {
        if (n_in != 28 || out_size != T * DM || ws_size < WS_END) { fprintf(stderr, "kernel_launch: unexpected shapes (n_in %d out %d ws %zu need %zu)\n", n_in, out_size, ws_size, (size_t)WS_END); grid = -1; return; }
        int dev = 0, cus = 0, per_cu = 0;
        (void)hipGetDevice(&dev);
        (void)hipDeviceGetAttribute(&cus, hipDeviceAttributeMultiprocessorCount, dev);
        if (hipFuncSetAttribute((const void*)mega_kernel, hipFuncAttributeMaxDynamicSharedMemorySize, LDS_TOTAL) != hipSuccess) fprintf(stderr, "kernel_launch: hipFuncSetAttribute failed\n");
        if (hipOccupancyMaxActiveBlocksPerMultiprocessor(&per_cu, (const void*)mega_kernel, NT, LDS_TOTAL) != hipSuccess || per_cu < 1) { fprintf(stderr, "kernel_launch: occupancy query failed (%d)\n", per_cu); per_cu = 1; }
        grid = cus;
    }
    if (grid < 0) return;
    Params p{};
    for (int i = 0; i < 28; ++i) p.in[i] = (const float*)d_in[i];
    p.out = (float*)d_out; p.ws = (char*)d_ws;
#if MEGA
    if (hipMemsetAsync((char*)d_ws + OFF_BAR, 0, XCD_BAR_WORDS * 4, stream) != hipSuccess) { fprintf(stderr, "kernel_launch: hipMemsetAsync of the barrier words failed\n"); return; }
    void* args[] = {&p};
    hipError_t e = hipLaunchCooperativeKernel((const void*)mega_kernel, dim3(grid), dim3(NT), args, LDS_TOTAL, stream);
    if (e != hipSuccess) fprintf(stderr, "cooperative launch failed: %s (grid %d)\n", hipGetErrorString(e), grid);
#endif
}
```

```cpp
#include <hip/hip_runtime.h>
#include <hip/hip_cooperative_groups.h>
#include <cstdio>
namespace cg = cooperative_groups;

#ifndef PROBE_MASK
#define PROBE_MASK 0x0
#endif
#ifndef PROBE_SYNCS
#define PROBE_SYNCS 0
#endif
#ifndef MEGA
#define MEGA 1
#endif

typedef _Float16 hf;
typedef _Float16 h8 __attribute__((ext_vector_type(8)));
typedef _Float16 h4 __attribute__((ext_vector_type(4)));
typedef float f4 __attribute__((ext_vector_type(4)));
typedef float f16v __attribute__((ext_vector_type(16)));
#define MFMA32(a, b, c) __builtin_amdgcn_mfma_f32_32x32x16_f16((a), (b), (c), 0, 0, 0)
#define MFMA16(a, b, c) __builtin_amdgcn_mfma_f32_16x16x32_f16((a), (b), (c), 0, 0, 0)
#define DI __device__ __forceinline__
#define LAS __attribute__((address_space(3)))

constexpr int NT = 512;
constexpr int T = 49152;
constexpr int TP = 32768;
constexpr int DM = 1024;
constexpr int DFF = 2816;
constexpr float LOG2E = 1.4426950408889634f;
constexpr float ALPHA = 1.4142135623730951f;
constexpr float EPS = 1e-5f;
constexpr float NEG_BIG = -1e30f;

constexpr size_t SZ_WIN0 = (size_t)2304 * 1024 * 2, SZ_WQUP = (size_t)768 * 384 * 2, SZ_WKVUP = (size_t)1024 * 256 * 2,
                 SZ_WOUT = (size_t)1024 * 1024 * 2, SZ_WUP = (size_t)5632 * 1024 * 2, SZ_WDN = (size_t)1024 * 2816 * 2,
                 SZ_WIN1 = (size_t)1536 * 1024 * 2;
constexpr size_t OFF_WIN0 = 0, OFF_WQUP = OFF_WIN0 + SZ_WIN0, OFF_WKVUP = OFF_WQUP + SZ_WQUP, OFF_WOUT0 = OFF_WKVUP + SZ_WKVUP,
                 OFF_WUP0 = OFF_WOUT0 + SZ_WOUT, OFF_WDN0 = OFF_WUP0 + SZ_WUP, OFF_WIN1 = OFF_WDN0 + SZ_WDN, OFF_WOUT1 = OFF_WIN1 + SZ_WIN1,
                 OFF_WUP1 = OFF_WOUT1 + SZ_WOUT, OFF_WDN1 = OFF_WUP1 + SZ_WUP, OFF_ROPEM = OFF_WDN1 + SZ_WDN;
constexpr size_t SZ_ROPEM = (size_t)16384 * 16 * 4 * 2, SZ_ROPEG = (size_t)16384 * 8 * 4 * 2;
constexpr size_t OFF_ROPEG = OFF_ROPEM + SZ_ROPEM, OFF_SS = OFF_ROPEG + SZ_ROPEG, SZ_SS = (size_t)T * 8 * 4;
constexpr size_t OFF_R1 = OFF_SS + SZ_SS, SZ_R1 = (size_t)T * 1024 * 2;
constexpr size_t OFF_R2 = OFF_R1 + SZ_R1, SZ_R2 = (size_t)T * 1024 * 2;
constexpr size_t OFF_R3 = OFF_R2 + SZ_R2, SZ_R3 = (size_t)T * 2816 * 2;
constexpr size_t OFF_BAR = OFF_R3 + SZ_R3;
constexpr size_t WS_END = OFF_BAR + 16384;
constexpr size_t OFF_XH = OFF_R1, OFF_QM = OFF_R1;
constexpr size_t OFF_AO = OFF_R2, OFF_QL = OFF_R2, OFF_KVL = OFF_R2 + (size_t)T * 384 * 2;
constexpr size_t OFF_U = OFF_R3;
constexpr size_t OFF_QA = OFF_R3, OFF_KA = OFF_QA + (size_t)T * 512 * 2, OFF_VAT = OFF_KA + (size_t)T * 512 * 2, OFF_KN = OFF_VAT + (size_t)T * 512 * 2,
                 OFF_VMT = OFF_KN + (size_t)T * 512 * 2, OFF_KR = OFF_VMT + (size_t)T * 512 * 2;
constexpr size_t OFF_Q1 = OFF_R3, OFF_K1 = OFF_Q1 + (size_t)T * 1024 * 2, OFF_V1T = OFF_K1 + (size_t)T * 256 * 2;
static_assert(OFF_KR + (size_t)T * 32 * 2 <= WS_END, "L0 attention buffers overflow R3");
static_assert(OFF_V1T + (size_t)T * 256 * 2 <= WS_END, "L1 attention buffers overflow R3");

constexpr int CST = 132;
constexpr int LDS_BYTES = 256 * CST * 4;
constexpr int SWA_TILE = 64 * 72 * 2 + 64 * 68 * 2;
constexpr int LDS_ST = 8 * SWA_TILE;
constexpr int LDS_NAB = LDS_ST + 16;
constexpr int LDS_TOTAL = LDS_NAB + 1872;

static_assert(LDS_ST >= LDS_BYTES, "barrier words must sit behind every phase's LDS image");
struct Params {
    const float* in[28];
    float* out;
    char* ws;
};

DI void seq_of(int t, int& s0, int& L) { if (t < TP) { s0 = t & ~8191; L = 8192; } else { s0 = TP; L = 16384; } }
DI const float* xrow(const Params& p, int t) { return t < TP ? p.in[0] + (size_t)t * DM : p.in[1] + (size_t)(t - TP) * DM; }
DI h8 cvt8(f4 a, f4 b, float s) { h8 v; v[0] = (hf)(a[0] * s); v[1] = (hf)(a[1] * s); v[2] = (hf)(a[2] * s); v[3] = (hf)(a[3] * s); v[4] = (hf)(b[0] * s); v[5] = (hf)(b[1] * s); v[6] = (hf)(b[2] * s); v[7] = (hf)(b[3] * s); return v; }
DI int tid_opaque() { int t = threadIdx.x; asm volatile("" : "+v"(t)); return t; }
DI float wave_sum(float v) { v += __shfl_xor(v, 32); v += __shfl_xor(v, 16); v += __shfl_xor(v, 8); v += __shfl_xor(v, 4); v += __shfl_xor(v, 2); v += __shfl_xor(v, 1); return v; }

DI void prep_weight(const float* __restrict__ src, const float* __restrict__ g, hf* __restrict__ dst, int K, int Nsrc, int Npad, int mode, char* smem) {
    hf* tl = (hf*)smem;
    const int tid = tid_opaque(), nn = tid & 63, kq = tid >> 6, on = tid >> 3, oc = tid & 7;
    const int ntn = Npad >> 6, ntk = K >> 6;
    for (int tile = blockIdx.x; tile < ntn * ntk; tile += gridDim.x) {
        const int tn = tile % ntn, tk = tile / ntn, n0 = tn * 64, k0 = tk * 64;
        int c0 = n0;
        if (mode == 1) { const int t = n0 >> 7; c0 = (n0 & 64) ? (DFF + t * 64) : (t * 64); }
        const int col = c0 + nn;
        __syncthreads();
#pragma unroll
        for (int r = 0; r < 8; ++r) {
            const int kk = kq + 8 * r;
            float x = 0.f;
            if (col < Nsrc) { x = src[(size_t)(k0 + kk) * Nsrc + col]; if (g) x *= g[k0 + kk]; }
            tl[nn * 72 + kk] = (hf)x;
        }
        __syncthreads();
        *(h8*)(dst + (size_t)(n0 + on) * K + k0 + oc * 8) = *(const h8*)(tl + on * 72 + oc * 8);
    }
}

__device__ void phase_prep(const Params& p, char* smem) {
    const long gtid = (long)blockIdx.x * NT + tid_opaque(), gs = (long)gridDim.x * NT;
    char* ws = p.ws;
    prep_weight(p.in[2], nullptr, (hf*)(ws + OFF_WIN0), 1024, 2208, 2304, 0, smem);
    prep_weight(p.in[5], p.in[4], (hf*)(ws + OFF_WQUP), 384, 768, 768, 0, smem);
    prep_weight(p.in[7], p.in[6], (hf*)(ws + OFF_WKVUP), 256, 1024, 1024, 0, smem);
    prep_weight(p.in[8], nullptr, (hf*)(ws + OFF_WOUT0), 1024, 1024, 1024, 0, smem);
    prep_weight(p.in[11], nullptr, (hf*)(ws + OFF_WUP0), 1024, 5632, 5632, 1, smem);
    prep_weight(p.in[14], nullptr, (hf*)(ws + OFF_WDN0), 2816, 1024, 1024, 0, smem);
    prep_weight(p.in[17], nullptr, (hf*)(ws + OFF_WIN1), 1024, 1536, 1536, 0, smem);
    prep_weight(p.in[19], nullptr, (hf*)(ws + OFF_WOUT1), 1024, 1024, 1024, 0, smem);
    prep_weight(p.in[22], nullptr, (hf*)(ws + OFF_WUP1), 1024, 5632, 5632, 1, smem);
    prep_weight(p.in[25], nullptr, (hf*)(ws + OFF_WDN1), 2816, 1024, 1024, 0, smem);
    hf* xh = (hf*)(ws + OFF_XH);
    for (long idx = gtid; idx < (long)T * 128; idx += gs) {
        const int t = (int)(idx >> 7), c = (int)(idx & 127) * 8;
        const float* xr = xrow(p, t) + c;
        const f4 a = *(const f4*)xr, b = *(const f4*)(xr + 4);
        *(h8*)(xh + (size_t)t * DM + c) = cvt8(a, b, 1.f);
    }
    float* rm = (float*)(ws + OFF_ROPEM); float* rg = (float*)(ws + OFF_ROPEG);
    for (long idx = gtid; idx < 16384L * 24; idx += gs) {
        const int pos = (int)(idx / 24), i = (int)(idx % 24);
        double inv;
        if (i < 16) inv = exp2(-(double)i / 16.0 * 13.287712379549449);
        else inv = exp2(-(double)(i - 16) / 8.0 * 18.931568569324174);
        const float angf = (float)pos * (float)inv;
        const double ang = (double)angf;
        const float c = (float)cos(ang), s = (float)sin(ang);
        if (i < 16) { rm[(size_t)pos * 32 + i] = c; rm[(size_t)pos * 32 + 16 + i] = s; }
        else { rg[(size_t)pos * 16 + (i - 16)] = c; rg[(size_t)pos * 16 + 8 + (i - 16)] = s; }
    }
}

constexpr int HTB = 128 * 64 * 2;
DI int lds_byte(int r, int c) { const int st = (r >> 4) * 2 + (c >> 5), rr = r & 15, cc = c & 31, ob = rr * 64 + cc * 2; return st * 1024 + (ob ^ (((ob >> 9) & 1) << 5)); }
DI void stage_rc(int b, int& R, int& C) { const int st = b / 1024, sb = b % 1024, swz = sb ^ (((sb >> 9) & 1) << 5); R = (st >> 1) * 16 + swz / 64; C = (st & 1) * 32 + (swz % 64) / 2; }

DI void tile_coords(int L, int nM, int nN, int& pm, int& pn) {
    const int nwg = nM * nN;
    int wgid = L; { const int q = nwg / 8, r = nwg % 8, xcd = wgid % 8, off = wgid / 8; wgid = (xcd < r ? xcd * (q + 1) : r * (q + 1) + (xcd - r) * q) + off; }
    const int nig = 8 * nN, gid = wgid / nig, fm = gid * 8, gsz = (nM - fm) < 8 ? (nM - fm) : 8;
    pm = fm + ((wgid % nig) % gsz); pn = (wgid % nig) / gsz;
}

DI void gemm256(const hf* __restrict__ A, int lda, int arow0, const hf* __restrict__ Bt, int K, int bcol, LAS char* lds, f4 (&acc)[2][2][4][2]) {
    const int tid = tid_opaque(), wid = __builtin_amdgcn_readfirstlane(tid >> 6), lane = tid & 63, wr = wid >> 2, wc = wid & 3, fr = lane & 15, fq = lane >> 4;
    const int nt = K >> 6;
    unsigned offA[2], offB[2];
#pragma unroll
    for (int i = 0; i < 2; ++i) {
        int R, C; stage_rc(tid * 16 + i * 8192, R, C);
        offA[i] = (unsigned)(R * lda + C) * 2u;
        offB[i] = (unsigned)(R * K + C) * 2u;
    }
    const char* Ab = (const char*)(A + (long)arow0 * lda);
    const char* Bb = (const char*)(Bt + (long)bcol * K);
    const size_t hA = (size_t)128 * lda * 2, hB = (size_t)128 * K * 2;
    const unsigned ldsw = (unsigned)wid * 1024u;
    const int aoff = lds_byte(wr * 64 + fr, fq * 8), boff = lds_byte(wc * 32 + fr, fq * 8);
#define SA(b, h) (((b) * 2 + (h)) * HTB)
#define SB(b, h) ((4 + (b) * 2 + (h)) * HTB)
#define STAGE_A(b, h, kt) do { _Pragma("unroll") for (int _i = 0; _i < 2; ++_i) \
        __builtin_amdgcn_global_load_lds((const unsigned*)(Ab + (h) * hA + (size_t)(kt) * 128 + offA[_i]), (LAS unsigned*)(lds + SA(b, h) + ldsw + _i * 8192), 16, 0, 0); } while (0)
#define STAGE_B(b, h, kt) do { _Pragma("unroll") for (int _i = 0; _i < 2; ++_i) \
        __builtin_amdgcn_global_load_lds((const unsigned*)(Bb + (h) * hB + (size_t)(kt) * 128 + offB[_i]), (LAS unsigned*)(lds + SB(b, h) + ldsw + _i * 8192), 16, 0, 0); } while (0)
#define LDA(dst, b, h) do { _Pragma("unroll") for (int m = 0; m < 4; ++m) _Pragma("unroll") for (int k = 0; k < 2; ++k) dst[m][k] = *(const LAS h8*)(lds + SA(b, h) + aoff + m * 2048 + k * 1024); } while (0)
#define LDB(dst, b, h) do { _Pragma("unroll") for (int n = 0; n < 2; ++n) _Pragma("unroll") for (int k = 0; k < 2; ++k) dst[n][k] = *(const LAS h8*)(lds + SB(b, h) + boff + n * 2048 + k * 1024); } while (0)
#define MMA(ai, bj, At_, Bt_) do { __builtin_amdgcn_s_setprio(1); _Pragma("unroll") for (int m = 0; m < 4; ++m) _Pragma("unroll") for (int n = 0; n < 2; ++n) _Pragma("unroll") for (int k = 0; k < 2; ++k) \
        acc[ai][bj][m][n] = MFMA16(At_[m][k], Bt_[n][k], acc[ai][bj][m][n]); __builtin_amdgcn_s_setprio(0); } while (0)
#define WAIT_V(n) asm volatile("s_waitcnt vmcnt(" #n ")" ::: "memory")
#define WAIT_L(n) asm volatile("s_waitcnt lgkmcnt(" #n ")" ::: "memory")
#define BAR __builtin_amdgcn_s_barrier()
#define SCHED __builtin_amdgcn_sched_barrier(0)
#pragma unroll
    for (int a_ = 0; a_ < 2; ++a_)
#pragma unroll
        for (int b_ = 0; b_ < 2; ++b_)
#pragma unroll
            for (int m = 0; m < 4; ++m)
#pragma unroll
                for (int n = 0; n < 2; ++n) acc[a_][b_][m][n] = (f4){0.f, 0.f, 0.f, 0.f};
    h8 At[4][2], B0[2][2], B1[2][2];
    WAIT_V(0);
    __syncthreads();
    STAGE_B(0, 0, 0); STAGE_A(0, 0, 0);
    STAGE_B(0, 1, 0); STAGE_A(0, 1, 0);
    if (wr == 1) BAR;
    WAIT_V(4); BAR;
    STAGE_B(1, 0, 1); STAGE_A(1, 0, 1); STAGE_B(1, 1, 1);
    WAIT_V(6); BAR;
    for (int t = 0; t < nt - 2; t += 2) {
        LDB(B0, 0, 0); SCHED; LDA(At, 0, 0); STAGE_A(1, 1, t + 1);
        WAIT_L(8); BAR; WAIT_L(0); MMA(0, 0, At, B0); BAR; SCHED;
        LDB(B1, 0, 1); STAGE_B(0, 0, t + 2);
        BAR; WAIT_L(0); MMA(0, 1, At, B1); BAR;
        LDA(At, 0, 1); STAGE_A(0, 0, t + 2);
        BAR; WAIT_L(0); MMA(1, 0, At, B0); BAR; SCHED;
        STAGE_B(0, 1, t + 2);
        WAIT_V(6); BAR; MMA(1, 1, At, B1); BAR;
        LDB(B0, 1, 0); SCHED; LDA(At, 1, 0); STAGE_A(0, 1, t + 2);
        WAIT_L(8); BAR; WAIT_L(0); MMA(0, 0, At, B0); BAR; SCHED;
        LDB(B1, 1, 1); STAGE_B(1, 0, t + 3);
        BAR; WAIT_L(0); MMA(0, 1, At, B1); BAR;
        LDA(At, 1, 1); STAGE_A(1, 0, t + 3);
        BAR; WAIT_L(0); MMA(1, 0, At, B0); BAR; SCHED;
        STAGE_B(1, 1, t + 3);
        WAIT_V(6); BAR; MMA(1, 1, At, B1); BAR;
    }
    { LDB(B0, 0, 0); LDA(At, 0, 0); STAGE_A(1, 1, nt - 1);
      BAR; WAIT_L(0); MMA(0, 0, At, B0); BAR;
      LDB(B1, 0, 1); BAR; WAIT_L(0); MMA(0, 1, At, B1); BAR;
      LDA(At, 0, 1); WAIT_V(4); BAR; WAIT_L(0); MMA(1, 0, At, B0); MMA(1, 1, At, B1); BAR; }
    { LDB(B0, 1, 0); LDA(At, 1, 0); WAIT_V(2); BAR; WAIT_L(0); MMA(0, 0, At, B0); BAR;
      LDB(B1, 1, 1); WAIT_V(0); BAR; WAIT_L(0); MMA(0, 1, At, B1); BAR;
      LDA(At, 1, 1); BAR; WAIT_L(0); MMA(1, 0, At, B0); MMA(1, 1, At, B1); BAR; }
    if (wr == 0) BAR;
#undef SA
#undef SB
#undef STAGE_A
#undef STAGE_B
#undef LDA
#undef LDB
#undef MMA
}

template <int BJ> DI void stage_half(const f4 (&acc)[2][2][4][2], float* C) {
    __syncthreads();
    const int tid = tid_opaque(), wid = tid >> 6, lane = tid & 63, wr = wid >> 2, wc = wid & 3, fr = lane & 15, fq = lane >> 4;
#pragma unroll
    for (int ai = 0; ai < 2; ++ai)
#pragma unroll
        for (int m = 0; m < 4; ++m)
#pragma unroll
            for (int n = 0; n < 2; ++n)
#pragma unroll
                for (int j = 0; j < 4; ++j) C[(ai * 128 + wr * 64 + m * 16 + fq * 4 + j) * CST + wc * 32 + n * 16 + fr] = acc[ai][BJ][m][n][j];
    __syncthreads();
}

DI void ld8(const float* C, int r, int c, f4& a, f4& b) { a = *(const f4*)(C + r * CST + c); b = *(const f4*)(C + r * CST + c + 4); }

template <int NCOLS, bool RSCALE>
DI void store_transposed(const float* C, int c0, hf* dst  , int tok0) {
    const int tid = tid_opaque();
    const int col = tid % NCOLS, rc0 = tid / NCOLS;
    constexpr int STEP = NT / NCOLS;
#pragma unroll
    for (int rc = rc0; rc < 32; rc += STEP) {
        h8 v;
#pragma unroll
        for (int j = 0; j < 8; ++j) { float x = C[(8 * rc + j) * CST + c0 + col]; if (RSCALE) x *= C[(8 * rc + j) * CST + 128]; v[j] = (hf)x; }
        *(h8*)(dst + (size_t)col * T + tok0 + 8 * rc) = v;
    }
}

DI void epi_in0(const Params& p, const float* C, int m0, int tn) {
    char* ws = p.ws;
    hf* Qa = (hf*)(ws + OFF_QA); hf* Ka = (hf*)(ws + OFF_KA); hf* VaT = (hf*)(ws + OFF_VAT);
    hf* QL = (hf*)(ws + OFF_QL); hf* KVL = (hf*)(ws + OFF_KVL); hf* Kr = (hf*)(ws + OFF_KR);
    float* SS = (float*)(ws + OFF_SS); const float* rm = (const float*)(ws + OFF_ROPEM);
    const int tid = tid_opaque(), cc = tid & 15, rb = tid >> 4;
    if (tn >= 8 && tn < 12) {
        store_transposed<128, false>(C, 0, VaT + (size_t)(tn - 8) * 128 * T, m0);
    } else if (tn == 17) {
        if (cc < 2) {
            int s0, L; seq_of(m0, s0, L);
#pragma unroll
            for (int i = 0; i < 8; ++i) {
                const int r = rb + 32 * i, t = m0 + r, pos = t - s0;
                f4 a0, a1, b0, b1; ld8(C, r, 8 * cc, a0, a1); ld8(C, r, 16 + 8 * cc, b0, b1);
                const float* cs = rm + (size_t)pos * 32 + 8 * cc;
                h8 o1, o2;
#pragma unroll
                for (int j = 0; j < 8; ++j) {
                    const float x1 = j < 4 ? a0[j & 3] : a1[j & 3], x2 = j < 4 ? b0[j & 3] : b1[j & 3];
                    const float c = cs[j], s = cs[16 + j];
                    o1[j] = (hf)(x1 * c - x2 * s); o2[j] = (hf)(x2 * c + x1 * s);
                }
                *(h8*)(Kr + (size_t)t * 32 + 8 * cc) = o1; *(h8*)(Kr + (size_t)t * 32 + 16 + 8 * cc) = o2;
            }
        }
    } else {
        hf* dst; int ld, cbase, ssidx = -1; float scale = 1.f;
        if (tn < 4) { dst = Qa; ld = 512; cbase = tn * 128; scale = 0.125f * LOG2E; }
        else if (tn < 8) { dst = Ka; ld = 512; cbase = (tn - 4) * 128; }
        else if (tn < 15) { dst = QL; ld = 384; cbase = (tn - 12) * 128; ssidx = tn - 12; }
        else { dst = KVL; ld = 256; cbase = (tn - 15) * 128; ssidx = 3 + (tn - 15); }
#pragma unroll
        for (int i = 0; i < 8; ++i) {
            const int r = rb + 32 * i, t = m0 + r;
            f4 a, b; ld8(C, r, 8 * cc, a, b);
            *(h8*)(dst + (size_t)t * ld + cbase + 8 * cc) = cvt8(a, b, scale);
            if (ssidx >= 0) {
                float ss = a[0] * a[0] + a[1] * a[1] + a[2] * a[2] + a[3] * a[3] + b[0] * b[0] + b[1] * b[1] + b[2] * b[2] + b[3] * b[3];
                ss += __shfl_xor(ss, 1); ss += __shfl_xor(ss, 2); ss += __shfl_xor(ss, 4); ss += __shfl_xor(ss, 8);
                if (cc == 0) SS[(size_t)t * 8 + ssidx] = ss;
            }
        }
    }
}

DI void epi_qup(const Params& p, float* C, int m0, int tn) {
    char* ws = p.ws;
    hf* Qm = (hf*)p.out;
    const float* SS = (const float*)(ws + OFF_SS); const float* rm = (const float*)(ws + OFF_ROPEM);
    const int tid = tid_opaque();
    const float QSC = 0.10206207261596575f * LOG2E;
    if (tid < 256) { const float* s = SS + (size_t)(m0 + tid) * 8; C[tid * CST + 128] = rsqrtf((s[0] + s[1] + s[2]) * (1.f / 384.f) + EPS); }
    __syncthreads();
    const int cc = tid & 15, rb = tid >> 4;
    const int n = tn * 128 + 8 * cc, hd = n / 96, w = n - hd * 96;
    int s0, L; seq_of(m0, s0, L);
#pragma unroll
    for (int i = 0; i < 8; ++i) {
        const int r = rb + 32 * i, t = m0 + r, pos = t - s0;
        const float rq = C[r * CST + 128] * QSC;
        f4 a, b; ld8(C, r, 8 * cc, a, b);
        if (w >= 64) {
            const int iw = w - 64;
            f4 pa, pb;
            if (iw < 16) ld8(C, r, 8 * cc + 16, pa, pb); else ld8(C, r, 8 * cc - 16, pa, pb);
            const float* cs = rm + (size_t)pos * 32 + (iw & 15);
            const float sg = iw < 16 ? -1.f : 1.f;
#pragma unroll
            for (int j = 0; j < 4; ++j) {
                a[j] = a[j] * cs[j] + sg * pa[j] * cs[16 + j];
                b[j] = b[j] * cs[4 + j] + sg * pb[j] * cs[20 + j];
            }
        }
        *(h8*)(Qm + (size_t)t * 768 + n) = cvt8(a, b, rq);
    }
}
DI void epi_kvup(const Params& p, float* C, int m0, int tn  ) {
    char* ws = p.ws;
    hf* Kn = (hf*)(ws + OFF_KN); hf* VmT = (hf*)(ws + OFF_VMT);
    const float* SS = (const float*)(ws + OFF_SS);
    const int tid = tid_opaque();
    if (tid < 256) { const float* s = SS + (size_t)(m0 + tid) * 8; C[tid * CST + 128] = rsqrtf((s[3] + s[4]) * (1.f / 256.f) + EPS); }
    __syncthreads();
    const int cc = tid & 7, rb = tid >> 3;
#pragma unroll
    for (int i = 0; i < 4; ++i) {
        const int r = rb + 64 * i, t = m0 + r;
        f4 a, b; ld8(C, r, 8 * cc, a, b);
        *(h8*)(Kn + (size_t)t * 512 + tn * 64 + 8 * cc) = cvt8(a, b, C[r * CST + 128]);
    }
    store_transposed<64, true>(C, 64, VmT + (size_t)tn * 64 * T, m0);
}

DI void epi_res(const Params& p, const float* C, int m0, int tn, bool res_from_input) {
    const int tid = tid_opaque(), cc = tid & 15, rb = tid >> 4;
    hf* Xh = (hf*)(p.ws + OFF_XH);
#pragma unroll
    for (int i = 0; i < 8; ++i) {
        const int r = rb + 32 * i, t = m0 + r, n = tn * 128 + 8 * cc;
        f4 a, b; ld8(C, r, 8 * cc, a, b);
        hf* yp = Xh + (size_t)t * DM + n;
        f4 r0, r1;
        if (res_from_input) { const float* rp = xrow(p, t) + n; r0 = *(const f4*)rp; r1 = *(const f4*)(rp + 4); }
        else { const h8 rv = *(const h8*)yp; r0 = (f4){(float)rv[0], (float)rv[1], (float)rv[2], (float)rv[3]}; r1 = (f4){(float)rv[4], (float)rv[5], (float)rv[6], (float)rv[7]}; }
        *(h8*)yp = cvt8(r0 * ALPHA + a, r1 * ALPHA + b, 1.f);
    }
}

DI float gelu_exact(float v) {
    const float t = __builtin_amdgcn_rcpf(fmaf(fabsf(v), 0.2316418882f, 1.0f));
    float q = fmaf(t, 0.5307027145f, -0.7265760135f); q = fmaf(q, t, 0.7107068705f); q = fmaf(q, t, -0.142248368f); q = fmaf(q, t, 0.127414796f); q *= t;
    const float e = __builtin_amdgcn_exp2f(v * v * -0.72134752044f);
    const float m = v * (q * e);
    return v < 0.f ? m : v - m;
}
DI void epi_ffn(const Params& p, const float* C, int s0, int L, int pos0, int tn, const float* cw, const float* cb) {
    hf* U = (hf*)(p.ws + OFF_U);
    const int tid = tid_opaque(), cc = tid & 7, rb = tid >> 3;
#pragma unroll 1
    for (int hh = 0; hh < 2; ++hh) {
        const int lc = 8 * cc + 4 * hh, gc = tn * 64 + lc;
        const f4 wg0 = *(const f4*)(cw + gc), wg1 = *(const f4*)(cw + 5632 + gc), wg2 = *(const f4*)(cw + 2 * 5632 + gc), bg = *(const f4*)(cb + gc);
        const f4 wv0 = *(const f4*)(cw + DFF + gc), wv1 = *(const f4*)(cw + 5632 + DFF + gc), wv2 = *(const f4*)(cw + 2 * 5632 + DFF + gc), bv = *(const f4*)(cb + DFF + gc);
#pragma unroll 1
        for (int i = 0; i < 4; ++i) {
            const int lr = rb + 64 * i, pos = pos0 + lr;
            if (lr >= 1 && lr <= 254 && pos < L) {
                const f4 zero = {0.f, 0.f, 0.f, 0.f};
                const bool hm = pos - 1 >= 0, hp = pos + 1 < L;
                const f4 g0 = hm ? *(const f4*)(C + (lr - 1) * CST + lc) : zero, g1 = *(const f4*)(C + lr * CST + lc), g2 = hp ? *(const f4*)(C + (lr + 1) * CST + lc) : zero;
                const f4 v0 = hm ? *(const f4*)(C + (lr - 1) * CST + 64 + lc) : zero, v1 = *(const f4*)(C + lr * CST + 64 + lc), v2 = hp ? *(const f4*)(C + (lr + 1) * CST + 64 + lc) : zero;
                const f4 gt = wg0 * g0 + wg1 * g1 + wg2 * g2 + bg;
                const f4 vl = wv0 * v0 + wv1 * v1 + wv2 * v2 + bv;
                h4 o;
#pragma unroll
                for (int j = 0; j < 4; ++j) o[j] = (hf)(gelu_exact(gt[j]) * vl[j]);
                *(h4*)(U + (size_t)(s0 + pos) * DFF + gc) = o;
            }
        }
    }
}

DI void epi_in1(const Params& p, const float* C, int m0, int tn) {
    char* ws = p.ws;
    hf* Q1 = (hf*)(ws + OFF_Q1); hf* K1 = (hf*)(ws + OFF_K1); hf* V1t = (hf*)(ws + OFF_V1T);
    const float* rg = (const float*)(ws + OFF_ROPEG);
    const int tid = tid_opaque(), cc = tid & 15, rb = tid >> 4;
    if (tn >= 10) { store_transposed<128, false>(C, 0, V1t + (size_t)(tn - 10) * 128 * T, m0); return; }
    int s0, L; seq_of(m0, s0, L);
    const int cw8 = cc & 7;
    hf* dst = tn < 8 ? Q1 : K1; const int ld = tn < 8 ? 1024 : 256, cbase = (tn < 8 ? tn : tn - 8) * 128;
    const float scale = tn < 8 ? 0.125f * LOG2E : 1.f;
#pragma unroll
    for (int i = 0; i < 8; ++i) {
        const int r = rb + 32 * i, t = m0 + r, pos = t - s0;
        f4 a, b; ld8(C, r, 8 * cc, a, b);
        if (cw8 < 2) {
            f4 pa, pb;
            if (cw8 == 0) ld8(C, r, 8 * cc + 8, pa, pb); else ld8(C, r, 8 * cc - 8, pa, pb);
            const float* cs = rg + (size_t)pos * 16;
            const float sg = cw8 == 0 ? -1.f : 1.f;
#pragma unroll
            for (int j = 0; j < 4; ++j) {
                a[j] = a[j] * cs[j] + sg * pa[j] * cs[8 + j];
                b[j] = b[j] * cs[4 + j] + sg * pb[j] * cs[12 + j];
            }
        }
        *(h8*)(dst + (size_t)t * ld + cbase + 8 * cc) = cvt8(a, b, scale);
    }
}

enum { G_IN0 = 0, G_UP = 1, G_RES_IN = 2, G_RES = 3, G_FFN = 4, G_IN1 = 5 };
template <int KIND, int HALF_> DI void run_epi(const Params& p, float* C, int m0, int pn, bool second, int s0, int L, int pos0, const float* cw, const float* cb) {
    const int tn = pn * 2 + HALF_;
    if (KIND == G_IN0) epi_in0(p, C, m0, tn);
    else if (KIND == G_UP) { if (!second) epi_qup(p, C, m0, tn); else epi_kvup(p, C, m0, tn); }
    else if (KIND == G_RES_IN) epi_res(p, C, m0, tn, true);
    else if (KIND == G_RES) epi_res(p, C, m0, tn, false);
    else if (KIND == G_FFN) epi_ffn(p, C, s0, L, pos0, tn, cw, cb);
    else epi_in1(p, C, m0, tn);
}
template <int KIND>
__device__ void phase_gemm(const Params& p, char* smem, const hf* A, int K, const hf* W, int nN, const float* cw, const float* cb) {
    LAS char* lds = (LAS char*)smem;
    float* C = (float*)smem;
    const int nM = KIND == G_FFN ? 197 : 192;
    const int ntile = KIND == G_UP ? 192 * 7 : nM * nN;
    for (int Lx = blockIdx.x; Lx < ntile; Lx += gridDim.x) {
        int pm, pn; const hf* Ax = A; const hf* Wx = W; int Kx = K; bool second = false;
        if (KIND == G_UP) {
            if (Lx < 192 * 3) tile_coords(Lx, 192, 3, pm, pn);
            else { tile_coords(Lx - 192 * 3, 192, 4, pm, pn); second = true; Ax = (const hf*)(p.ws + OFF_KVL); Wx = (const hf*)(p.ws + OFF_WKVUP); Kx = 256; }
        } else tile_coords(Lx, nM, nN, pm, pn);
        int arow0 = pm * 256, s0 = 0, L = 0, pos0 = 0;
        if (KIND == G_FFN) {
            int ti;
            if (pm < 132) { s0 = (pm / 33) * 8192; L = 8192; ti = pm % 33; } else { s0 = TP; L = 16384; ti = pm - 132; }
            pos0 = 254 * ti - 1; arow0 = s0 + pos0;
        }
        f4 acc[2][2][4][2];
        gemm256(Ax, Kx, arow0, Wx, Kx, pn * 256, lds, acc);
        const int m0 = pm * 256;
        stage_half<0>(acc, C);
        run_epi<KIND, 0>(p, C, m0, pn, second, s0, L, pos0, cw, cb);
        stage_half<1>(acc, C);
        run_epi<KIND, 1>(p, C, m0, pn, second, s0, L, pos0, cw, cb);
    }
}

enum { AT_MLA = 0, AT_NA = 1, AT_SWA = 2 };
struct AttnArgs {
    const hf* Q; int qs;
    const hf* K; int ks;
    const hf* Kx;
    const hf* Vt;
    hf* O;
    int t0;
    int kt0;
    int nkt;
    int R0, rows, kr0;
    int qpos0, kpos0; float sink;
};

template <int DQK, int MODE>
DI void attn_item(const AttnArgs& a, char* smem) {
    constexpr int KST = DQK + 8, VST = 68, KCH = 64 * DQK / 8;
    constexpr int NKC = (KCH + NT - 1) / NT;
    const float* biasL = (const float*)(smem + LDS_NAB);
    const int tid = tid_opaque(), lane = tid & 63, wave = tid >> 6, ql = lane & 31, h = lane >> 5;
    const int qrow = 32 * wave + ql;
    h8 qf[DQK / 16];
    {
        const hf* qp = a.Q + (size_t)(a.t0 + qrow) * a.qs + 8 * h;
#pragma unroll
        for (int s = 0; s < DQK / 16; ++s) qf[s] = *(const h8*)(qp + 16 * s);
    }
    float m = NEG_BIG, l = 0.f;
    if (MODE == AT_SWA) { m = a.sink; l = (h == 0) ? 1.f : 0.f; }
    f16v o[2];
#pragma unroll
    for (int e = 0; e < 16; ++e) { o[0][e] = 0.f; o[1][e] = 0.f; }
    int qr = 0, qc = 0, rsq = 0, csq = 0;
    if (MODE == AT_NA) {
        qr = a.R0 + (qrow >> 6); qc = qrow & 63;
        rsq = qr - 4; rsq = rsq < 0 ? 0 : (rsq > a.rows - 8 ? a.rows - 8 : rsq);
        csq = qc - 8; csq = csq < 0 ? 0 : (csq > 48 ? 48 : csq);
    }
    const int pq = a.qpos0 + qrow;
    const int pqw = a.qpos0 + 32 * wave;
    const int krow = tid >> 3, kkc = tid & 7;
    const hf* kbase = a.K + (size_t)(a.kt0 + krow) * a.ks + kkc * 8;
    const hf* vbase = a.Vt + (size_t)krow * T + a.kt0 + kkc * 8;
    for (int kb0 = 0; kb0 < a.nkt; kb0 += 8) {
      {
        h8 rk[8], rv[8];
#pragma unroll
        for (int j = 0; j < 8; ++j) if (kb0 + j < a.nkt) { rk[j] = *(const h8*)(kbase + (size_t)(64 * (kb0 + j)) * a.ks); rv[j] = *(const h8*)(vbase + 64 * (kb0 + j)); }
        __syncthreads();
#pragma unroll
        for (int j = 0; j < 8; ++j) if (kb0 + j < a.nkt) {
            hf* Kw = (hf*)(smem + j * SWA_TILE); hf* Vw = Kw + 64 * KST;
            *(h8*)(Kw + krow * KST + kkc * 8) = rk[j];
            h4 lo, hi; lo[0] = rv[j][0]; lo[1] = rv[j][1]; lo[2] = rv[j][2]; lo[3] = rv[j][3]; hi[0] = rv[j][4]; hi[1] = rv[j][5]; hi[2] = rv[j][6]; hi[3] = rv[j][7];
            *(h4*)(Vw + krow * VST + kkc * 8) = lo; *(h4*)(Vw + krow * VST + kkc * 8 + 4) = hi;
        }
        __syncthreads();
      }
      const int kend = kb0 + 8 < a.nkt ? kb0 + 8 : a.nkt;
      for (int kt = kb0; kt < kend; ++kt) {
        const hf* Ks = (const hf*)(smem + (kt - kb0) * SWA_TILE);
        const hf* Vs = Ks + 64 * KST;
        bool active = true;
        if (MODE == AT_NA) { const int kr = a.kr0 + kt; active = (kr >= rsq) && (kr < rsq + 8); }
        if (MODE == AT_SWA) { const int pk0 = a.kpos0 + 64 * kt; active = (pk0 <= pqw + 31 + 128) && (pk0 + 63 >= pqw - 128); }
        if (active) {
            f16v x[2];
#pragma unroll
            for (int i = 0; i < 2; ++i) {
#pragma unroll
                for (int e = 0; e < 16; ++e) x[i][e] = 0.f;
                const hf* kp = Ks + (32 * i + ql) * KST + 8 * h;
#pragma unroll
                for (int s = 0; s < DQK / 16; ++s) { const h8 kf = *(const h8*)(kp + 16 * s); x[i] = MFMA32(kf, qf[s], x[i]); }
            }
            if (MODE == AT_NA) {
                const int kr = a.kr0 + kt;
                const int brow = (kr - qr + 7) * 31;
#pragma unroll
                for (int i = 0; i < 2; ++i)
#pragma unroll
                    for (int e = 0; e < 16; ++e) {
                        const int kcol = 32 * i + (e & 3) + 8 * (e >> 2) + 4 * h;
                        const bool v = (kcol >= csq) && (kcol < csq + 16);
                        const int bi = v ? (brow + kcol - qc + 15) : 0;
                        const float bb = biasL[bi];
                        x[i][e] = v ? (x[i][e] + bb) : NEG_BIG;
                    }
            } else if (MODE == AT_SWA) {
                const int pk0 = a.kpos0 + 64 * kt;
#pragma unroll
                for (int i = 0; i < 2; ++i)
#pragma unroll
                    for (int e = 0; e < 16; ++e) {
                        const int pk = pk0 + 32 * i + (e & 3) + 8 * (e >> 2) + 4 * h;
                        const int dd = pq - pk;
                        const bool v = (dd <= 128) && (dd >= -128);
                        x[i][e] = v ? x[i][e] : NEG_BIG;
                    }
            }
            float mx = x[0][0];
#pragma unroll
            for (int e = 1; e < 16; ++e) mx = fmaxf(mx, x[0][e]);
#pragma unroll
            for (int e = 0; e < 16; ++e) mx = fmaxf(mx, x[1][e]);
            mx = fmaxf(mx, __shfl_xor(mx, 32));
            const float mnew = fmaxf(m, mx);
            const float alpha = __builtin_amdgcn_exp2f(m - mnew);
            m = mnew;
            float ps = 0.f;
#pragma unroll
            for (int i = 0; i < 2; ++i)
#pragma unroll
                for (int e = 0; e < 16; ++e) { const float pv = __builtin_amdgcn_exp2f(x[i][e] - mnew); x[i][e] = pv; ps += pv; }
            l = l * alpha + ps;
#pragma unroll
            for (int e = 0; e < 16; ++e) { o[0][e] *= alpha; o[1][e] *= alpha; }
#pragma unroll
            for (int i = 0; i < 2; ++i)
#pragma unroll
                for (int sp = 0; sp < 2; ++sp) {
                    h8 pf;
#pragma unroll
                    for (int j = 0; j < 8; ++j) pf[j] = (hf)x[i][8 * sp + j];
#pragma unroll
                    for (int dt = 0; dt < 2; ++dt) {
                        const hf* vp = Vs + (32 * dt + ql) * VST + 32 * i + 16 * sp + 4 * h;
                        const h4 v0 = *(const h4*)vp, v1 = *(const h4*)(vp + 8);
                        h8 vf; vf[0] = v0[0]; vf[1] = v0[1]; vf[2] = v0[2]; vf[3] = v0[3]; vf[4] = v1[0]; vf[5] = v1[1]; vf[6] = v1[2]; vf[7] = v1[3];
                        o[dt] = MFMA32(vf, pf, o[dt]);
                    }
                }
        }
      }
    }
    l += __shfl_xor(l, 32);
    const float inv = 1.f / l;
    hf* op = a.O + (size_t)(a.t0 + qrow) * 1024;
#pragma unroll
    for (int dt = 0; dt < 2; ++dt)
#pragma unroll
        for (int g = 0; g < 4; ++g) {
            h4 v; v[0] = (hf)(o[dt][4 * g] * inv); v[1] = (hf)(o[dt][4 * g + 1] * inv); v[2] = (hf)(o[dt][4 * g + 2] * inv); v[3] = (hf)(o[dt][4 * g + 3] * inv);
            *(h4*)(op + 32 * dt + 8 * g + 4 * h) = v;
        }
}


#define SBAR __builtin_amdgcn_sched_barrier(0)
DI void mla_item(const AttnArgs& a, char* smem) {
    constexpr int KROWB = 208, VROWB = 144;
    constexpr int KSLOT = 64 * KROWB, VSLOT = 64 * VROWB, SLOT = KSLOT + VSLOT, NST = 5, DUMP = NST * SLOT;
    LAS char* lds = (LAS char*)smem;
    const int tid = tid_opaque(), lane = tid & 63, wid = __builtin_amdgcn_readfirstlane(tid >> 6), ql = lane & 31, h = lane >> 5;
    const int qrow = 32 * wid + ql;
    h8 qf[6];
    {
        const hf* qp = a.Q + (size_t)(a.t0 + qrow) * a.qs + 8 * h;
#pragma unroll
        for (int s = 0; s < 6; ++s) qf[s] = *(const h8*)(qp + 16 * s);
    }
    float mref = 0.f, l = 0.f;
    f16v o0, o1;
#pragma unroll
    for (int e = 0; e < 16; ++e) { o0[e] = 0.f; o1[e] = 0.f; }
    const hf *kq0, *kq1, *vq0, *vq1; int kst0, kst1;
    {
        int row = tid / 13, kc = tid % 13; if (kc == 12) kc = 0;
        if (kc < 8) { kq0 = a.K + (size_t)row * a.ks + kc * 8; kst0 = a.ks; } else { kq0 = a.Kx + (size_t)row * 32 + (kc - 8) * 8; kst0 = 32; }
        const int p1 = tid + NT < 832 ? tid + NT : tid;
        row = p1 / 13; kc = p1 % 13; if (kc == 12) kc = 0;
        if (kc < 8) { kq1 = a.K + (size_t)row * a.ks + kc * 8; kst1 = a.ks; } else { kq1 = a.Kx + (size_t)row * 32 + (kc - 8) * 8; kst1 = 32; }
        int d = tid / 9, c = tid % 9; if (c == 8) c = 0;
        vq0 = a.Vt + (size_t)d * T + c * 8;
        const int p2 = tid + NT < 576 ? tid + NT : tid;
        d = p2 / 9; c = p2 % 9; if (c == 8) c = 0;
        vq1 = a.Vt + (size_t)d * T + c * 8;
    }
    const unsigned k1dst = wid < 5 ? (unsigned)(8192 + wid * 1024) : 0xffffffffu, v1dst = wid < 1 ? (unsigned)(KSLOT + 8192 + wid * 1024) : 0xffffffffu;
    auto issue = [&](int kt) {
        const int ktc = kt < a.nkt ? kt : a.nkt - 1;
        const size_t tok0 = (size_t)(a.kt0 + 64 * ktc);
        const unsigned sb = (unsigned)((kt % NST) * SLOT), dump = (unsigned)(DUMP + wid * 1024);
        __builtin_amdgcn_global_load_lds((const unsigned*)(kq0 + tok0 * kst0), (LAS unsigned*)(lds + sb + wid * 1024), 16, 0, 0);
        __builtin_amdgcn_global_load_lds((const unsigned*)(kq1 + tok0 * kst1), (LAS unsigned*)(lds + (k1dst != 0xffffffffu ? sb + k1dst : dump)), 16, 0, 0);
        __builtin_amdgcn_global_load_lds((const unsigned*)(vq0 + tok0), (LAS unsigned*)(lds + sb + KSLOT + wid * 1024), 16, 0, 0);
        __builtin_amdgcn_global_load_lds((const unsigned*)(vq1 + tok0), (LAS unsigned*)(lds + (v1dst != 0xffffffffu ? sb + v1dst : dump)), 16, 0, 0);
    };
    asm volatile("s_waitcnt vmcnt(0)" ::: "memory");
    __syncthreads();
    issue(0); issue(1); issue(2); issue(3);
    asm volatile("s_waitcnt vmcnt(8)" ::: "memory");
    __builtin_amdgcn_s_barrier();
    asm volatile("" ::: "memory");
    const int koff = ql * KROWB + 16 * h, voff = KSLOT + ql * VROWB + 8 * h;
#define KFR(slot, i, s) (*(const LAS h8*)(lds + (slot) * SLOT + koff + (i) * 32 * KROWB + 32 * (s)))
#define VLD(dst, slot, dt, i, sp) { const LAS char* vp_ = lds + (slot) * SLOT + voff + (dt) * 32 * VROWB + 64 * (i) + 32 * (sp); const h4 v0_ = *(const LAS h4*)vp_, v1_ = *(const LAS h4*)(vp_ + 16); \
        dst[0] = v0_[0]; dst[1] = v0_[1]; dst[2] = v0_[2]; dst[3] = v0_[3]; dst[4] = v1_[0]; dst[5] = v1_[1]; dst[6] = v1_[2]; dst[7] = v1_[3]; }
#define EX2(x, e, P, j) { const float p0_ = __builtin_amdgcn_exp2f(x[e]); const float p1_ = __builtin_amdgcn_exp2f(x[(e) + 1]); psA += p0_; psB += p1_; P[j] = (hf)p0_; P[(j) + 1] = (hf)p1_; }
    f16v xc0, xc1, xn0, xn1;
    {
#pragma unroll
        for (int e = 0; e < 16; ++e) { xc0[e] = 0.f; xc1[e] = 0.f; }
#pragma unroll
        for (int s = 0; s < 6; ++s) { const h8 kf = KFR(0, 0, s); xc0 = MFMA32(kf, qf[s], xc0); }
#pragma unroll
        for (int s = 0; s < 6; ++s) { const h8 kf = KFR(0, 1, s); xc1 = MFMA32(kf, qf[s], xc1); }
    }
    float tmax;
    {
        float mx = xc0[0];
#pragma unroll
        for (int e = 1; e < 16; ++e) mx = fmaxf(mx, xc0[e]);
#pragma unroll
        for (int e = 0; e < 16; ++e) mx = fmaxf(mx, xc1[e]);
        mx = fmaxf(mx, __shfl_xor(mx, 32));
        mref = mx;
#pragma unroll
        for (int e = 0; e < 16; ++e) { xc0[e] -= mx; xc1[e] -= mx; }
        tmax = 0.f;
    }
    int cb = 0;
    for (int kt = 0; kt + 1 < a.nkt; ++kt) {
        if (__any(tmax > 8.f)) {
            const float delta = tmax > 8.f ? tmax : 0.f;
            mref += delta;
            const float alpha = __builtin_amdgcn_exp2f(-delta);
            l *= alpha;
#pragma unroll
            for (int e = 0; e < 16; ++e) { xc0[e] -= delta; xc1[e] -= delta; o0[e] *= alpha; o1[e] *= alpha; }
        }
        const int nb = cb == NST - 1 ? 0 : cb + 1;
        issue(kt + 4);
        h8 kA0 = KFR(nb, 0, 0), kA1 = KFR(nb, 0, 1), kA2 = KFR(nb, 0, 2), kB0 = KFR(nb, 0, 3), kB1 = KFR(nb, 0, 4), kB2 = KFR(nb, 0, 5);
        const float ini = -mref;
#pragma unroll
        for (int e = 0; e < 16; ++e) { xn0[e] = ini; xn1[e] = ini; }
        float psA = 0.f, psB = 0.f;
        h8 P00, P01, P10, P11, vA0, vA1, vB0, vB1;
        SBAR;
        xn0 = MFMA32(kA0, qf[0], xn0); SBAR; EX2(xc0, 0, P00, 0); SBAR;
        xn0 = MFMA32(kA1, qf[1], xn0); SBAR; EX2(xc0, 2, P00, 2); SBAR;
        xn0 = MFMA32(kA2, qf[2], xn0); SBAR; kA0 = KFR(nb, 1, 0); kA1 = KFR(nb, 1, 1); kA2 = KFR(nb, 1, 2); EX2(xc0, 4, P00, 4); SBAR;
        xn0 = MFMA32(kB0, qf[3], xn0); SBAR; EX2(xc0, 6, P00, 6); SBAR;
        xn0 = MFMA32(kB1, qf[4], xn0); SBAR; EX2(xc0, 8, P01, 0); SBAR;
        xn0 = MFMA32(kB2, qf[5], xn0); SBAR; kB0 = KFR(nb, 1, 3); kB1 = KFR(nb, 1, 4); kB2 = KFR(nb, 1, 5); EX2(xc0, 10, P01, 2); SBAR;
        xn1 = MFMA32(kA0, qf[0], xn1); SBAR; EX2(xc0, 12, P01, 4); SBAR;
        xn1 = MFMA32(kA1, qf[1], xn1); SBAR; EX2(xc0, 14, P01, 6); SBAR;
        xn1 = MFMA32(kA2, qf[2], xn1); SBAR; VLD(vA0, cb, 0, 0, 0); VLD(vA1, cb, 1, 0, 0); EX2(xc1, 0, P10, 0); SBAR;
        xn1 = MFMA32(kB0, qf[3], xn1); SBAR; EX2(xc1, 2, P10, 2); SBAR;
        xn1 = MFMA32(kB1, qf[4], xn1); SBAR; VLD(vB0, cb, 0, 0, 1); VLD(vB1, cb, 1, 0, 1); EX2(xc1, 4, P10, 4); SBAR;
        xn1 = MFMA32(kB2, qf[5], xn1); SBAR; EX2(xc1, 6, P10, 6); SBAR;
        o0 = MFMA32(vA0, P00, o0); SBAR; EX2(xc1, 8, P11, 0); SBAR;
        o1 = MFMA32(vA1, P00, o1); SBAR; VLD(vA0, cb, 0, 1, 0); VLD(vA1, cb, 1, 1, 0); EX2(xc1, 10, P11, 2); SBAR;
        o0 = MFMA32(vB0, P01, o0); SBAR; EX2(xc1, 12, P11, 4); SBAR;
        o1 = MFMA32(vB1, P01, o1); SBAR; VLD(vB0, cb, 0, 1, 1); VLD(vB1, cb, 1, 1, 1); EX2(xc1, 14, P11, 6); SBAR;
        float mx;
        o0 = MFMA32(vA0, P10, o0); SBAR; mx = fmaxf(fmaxf(xn0[0], xn0[1]), xn0[2]); mx = fmaxf(fmaxf(mx, xn0[3]), xn0[4]); mx = fmaxf(fmaxf(mx, xn0[5]), xn0[6]); mx = fmaxf(fmaxf(mx, xn0[7]), xn0[8]); SBAR;
        o1 = MFMA32(vA1, P10, o1); SBAR; mx = fmaxf(fmaxf(mx, xn0[9]), xn0[10]); mx = fmaxf(fmaxf(mx, xn0[11]), xn0[12]); mx = fmaxf(fmaxf(mx, xn0[13]), xn0[14]); mx = fmaxf(fmaxf(mx, xn0[15]), xn1[0]); SBAR;
        o0 = MFMA32(vB0, P11, o0); SBAR; mx = fmaxf(fmaxf(mx, xn1[1]), xn1[2]); mx = fmaxf(fmaxf(mx, xn1[3]), xn1[4]); mx = fmaxf(fmaxf(mx, xn1[5]), xn1[6]); mx = fmaxf(fmaxf(mx, xn1[7]), xn1[8]); SBAR;
        o1 = MFMA32(vB1, P11, o1); SBAR; mx = fmaxf(fmaxf(mx, xn1[9]), xn1[10]); mx = fmaxf(fmaxf(mx, xn1[11]), xn1[12]); mx = fmaxf(fmaxf(mx, xn1[13]), xn1[14]); mx = fmaxf(mx, xn1[15]); SBAR;
        tmax = fmaxf(mx, __shfl_xor(mx, 32));
        l += psA + psB;
        asm volatile("s_waitcnt vmcnt(8)" ::: "memory");
        __builtin_amdgcn_s_barrier();
        asm volatile("" ::: "memory");
        xc0 = xn0; xc1 = xn1; cb = nb;
    }
    {
        if (__any(tmax > 8.f)) {
            const float delta = tmax > 8.f ? tmax : 0.f;
            mref += delta;
            const float alpha = __builtin_amdgcn_exp2f(-delta);
            l *= alpha;
#pragma unroll
            for (int e = 0; e < 16; ++e) { xc0[e] -= delta; xc1[e] -= delta; o0[e] *= alpha; o1[e] *= alpha; }
        }
        float psA = 0.f, psB = 0.f;
        h8 P00, P01, P10, P11, vA0, vA1;
        EX2(xc0, 0, P00, 0); EX2(xc0, 2, P00, 2); EX2(xc0, 4, P00, 4); EX2(xc0, 6, P00, 6);
        EX2(xc0, 8, P01, 0); EX2(xc0, 10, P01, 2); EX2(xc0, 12, P01, 4); EX2(xc0, 14, P01, 6);
        EX2(xc1, 0, P10, 0); EX2(xc1, 2, P10, 2); EX2(xc1, 4, P10, 4); EX2(xc1, 6, P10, 6);
        EX2(xc1, 8, P11, 0); EX2(xc1, 10, P11, 2); EX2(xc1, 12, P11, 4); EX2(xc1, 14, P11, 6);
        l += psA + psB;
        VLD(vA0, cb, 0, 0, 0); VLD(vA1, cb, 1, 0, 0); o0 = MFMA32(vA0, P00, o0); o1 = MFMA32(vA1, P00, o1);
        VLD(vA0, cb, 0, 0, 1); VLD(vA1, cb, 1, 0, 1); o0 = MFMA32(vA0, P01, o0); o1 = MFMA32(vA1, P01, o1);
        VLD(vA0, cb, 0, 1, 0); VLD(vA1, cb, 1, 1, 0); o0 = MFMA32(vA0, P10, o0); o1 = MFMA32(vA1, P10, o1);
        VLD(vA0, cb, 0, 1, 1); VLD(vA1, cb, 1, 1, 1); o0 = MFMA32(vA0, P11, o0); o1 = MFMA32(vA1, P11, o1);
    }
#undef KFR
#undef VLD
#undef EX2
    asm volatile("s_waitcnt vmcnt(0)" ::: "memory");
    l += __shfl_xor(l, 32);
    const float inv = 1.f / l;
    hf* op = a.O + (size_t)(a.t0 + qrow) * 1024;
#pragma unroll
    for (int g = 0; g < 4; ++g) {
        h4 v; v[0] = (hf)(o0[4 * g] * inv); v[1] = (hf)(o0[4 * g + 1] * inv); v[2] = (hf)(o0[4 * g + 2] * inv); v[3] = (hf)(o0[4 * g + 3] * inv);
        *(h4*)(op + 8 * g + 4 * h) = v;
        h4 w; w[0] = (hf)(o1[4 * g] * inv); w[1] = (hf)(o1[4 * g + 1] * inv); w[2] = (hf)(o1[4 * g + 2] * inv); w[3] = (hf)(o1[4 * g + 3] * inv);
        *(h4*)(op + 32 + 8 * g + 4 * h) = w;
    }
}

DI void mla_item64(const AttnArgs& a, char* smem) {
    constexpr int KROWB = 208, VROWB = 144;
    constexpr int KSLOT = 64 * KROWB, VSLOT = 64 * VROWB, SLOT = KSLOT + VSLOT, NST = 5, DUMP = NST * SLOT;
    LAS char* lds = (LAS char*)smem;
    const int tid = tid_opaque(), lane = tid & 63, wid = __builtin_amdgcn_readfirstlane(tid >> 6), ql = lane & 31, h = lane >> 5;
    const int rowA = 64 * wid + ql, rowB = rowA + 32;
    h8 qA[6], qB[6];
    {
        const hf* qp = a.Q + (size_t)(a.t0 + rowA) * a.qs + 8 * h;
#pragma unroll
        for (int s = 0; s < 6; ++s) { qA[s] = *(const h8*)(qp + 16 * s); qB[s] = *(const h8*)(qp + (size_t)32 * a.qs + 16 * s); }
    }
    float mA = NEG_BIG, lA = 0.f, mB = NEG_BIG, lB = 0.f;
    f16v oA0, oA1, oB0, oB1;
#pragma unroll
    for (int e = 0; e < 16; ++e) { oA0[e] = 0.f; oA1[e] = 0.f; oB0[e] = 0.f; oB1[e] = 0.f; }
    const hf *kq0, *kq1, *vq0, *vq1; int kst0, kst1;
    {
        int row = tid / 13, kc = tid % 13; if (kc == 12) kc = 0;
        if (kc < 8) { kq0 = a.K + (size_t)row * a.ks + kc * 8; kst0 = a.ks; } else { kq0 = a.Kx + (size_t)row * 32 + (kc - 8) * 8; kst0 = 32; }
        const int p1 = tid + NT < 832 ? tid + NT : tid;
        row = p1 / 13; kc = p1 % 13; if (kc == 12) kc = 0;
        if (kc < 8) { kq1 = a.K + (size_t)row * a.ks + kc * 8; kst1 = a.ks; } else { kq1 = a.Kx + (size_t)row * 32 + (kc - 8) * 8; kst1 = 32; }
        int d = tid / 9, c = tid % 9; if (c == 8) c = 0;
        vq0 = a.Vt + (size_t)d * T + c * 8;
        const int p2 = tid + NT < 576 ? tid + NT : tid;
        d = p2 / 9; c = p2 % 9; if (c == 8) c = 0;
        vq1 = a.Vt + (size_t)d * T + c * 8;
    }
    const unsigned k1dst = wid < 5 ? (unsigned)(8192 + wid * 1024) : 0xffffffffu, v1dst = wid < 1 ? (unsigned)(KSLOT + 8192 + wid * 1024) : 0xffffffffu;
    auto issue = [&](int kt) {
        const int ktc = kt < a.nkt ? kt : a.nkt - 1;
        const size_t tok0 = (size_t)(a.kt0 + 64 * ktc);
        const unsigned sb = (unsigned)((kt % NST) * SLOT), dump = (unsigned)(DUMP + wid * 1024);
        __builtin_amdgcn_global_load_lds((const unsigned*)(kq0 + tok0 * kst0), (LAS unsigned*)(lds + sb + wid * 1024), 16, 0, 0);
        __builtin_amdgcn_global_load_lds((const unsigned*)(kq1 + tok0 * kst1), (LAS unsigned*)(lds + (k1dst != 0xffffffffu ? sb + k1dst : dump)), 16, 0, 0);
        __builtin_amdgcn_global_load_lds((const unsigned*)(vq0 + tok0), (LAS unsigned*)(lds + sb + KSLOT + wid * 1024), 16, 0, 0);
        __builtin_amdgcn_global_load_lds((const unsigned*)(vq1 + tok0), (LAS unsigned*)(lds + (v1dst != 0xffffffffu ? sb + v1dst : dump)), 16, 0, 0);
    };
#pragma unroll
    for (int s = 0; s < 6; ++s) asm volatile("" :: "v"(qA[s]), "v"(qB[s]));
    asm volatile("s_waitcnt vmcnt(0)" ::: "memory");
    __syncthreads();
    issue(0); issue(1); issue(2); issue(3);
    asm volatile("s_waitcnt vmcnt(12)" ::: "memory");
    __builtin_amdgcn_s_barrier();
    asm volatile("" ::: "memory");
    const int koff = ql * KROWB + 16 * h, voff = KSLOT + ql * VROWB + 8 * h;
    int cb = 0;
    for (int kt = 0; kt < a.nkt; ++kt) {
        issue(kt + 4);
        const LAS char* kb = lds + cb * SLOT + koff;
        const LAS char* vb = lds + cb * SLOT + voff;
        f16v xA0, xA1, xB0, xB1;
#pragma unroll
        for (int e = 0; e < 16; ++e) { xA0[e] = 0.f; xA1[e] = 0.f; xB0[e] = 0.f; xB1[e] = 0.f; }
        h8 k0 = *(const LAS h8*)kb, k1 = *(const LAS h8*)(kb + 32 * KROWB);
#pragma unroll
        for (int s = 0; s < 6; ++s) {
            h8 n0 = k0, n1 = k1;
            if (s < 5) { n0 = *(const LAS h8*)(kb + 32 * (s + 1)); n1 = *(const LAS h8*)(kb + 32 * KROWB + 32 * (s + 1)); }
            xA0 = MFMA32(k0, qA[s], xA0); xB0 = MFMA32(k0, qB[s], xB0);
            xA1 = MFMA32(k1, qA[s], xA1); xB1 = MFMA32(k1, qB[s], xB1);
            k0 = n0; k1 = n1;
        }
        float alA, alB;
        {
            float mx = xA0[0];
#pragma unroll
            for (int e = 1; e < 16; ++e) mx = fmaxf(mx, xA0[e]);
#pragma unroll
            for (int e = 0; e < 16; ++e) mx = fmaxf(mx, xA1[e]);
            mx = fmaxf(mx, __shfl_xor(mx, 32));
            const float mn = fmaxf(mA, mx); alA = __builtin_amdgcn_exp2f(mA - mn); mA = mn;
            float ps = 0.f;
#pragma unroll
            for (int e = 0; e < 16; ++e) { const float p0 = __builtin_amdgcn_exp2f(xA0[e] - mn); xA0[e] = p0; const float p1 = __builtin_amdgcn_exp2f(xA1[e] - mn); xA1[e] = p1; ps += p0 + p1; }
            lA = lA * alA + ps;
#pragma unroll
            for (int e = 0; e < 16; ++e) { oA0[e] *= alA; oA1[e] *= alA; }
        }
        {
            float mx = xB0[0];
#pragma unroll
            for (int e = 1; e < 16; ++e) mx = fmaxf(mx, xB0[e]);
#pragma unroll
            for (int e = 0; e < 16; ++e) mx = fmaxf(mx, xB1[e]);
            mx = fmaxf(mx, __shfl_xor(mx, 32));
            const float mn = fmaxf(mB, mx); alB = __builtin_amdgcn_exp2f(mB - mn); mB = mn;
            float ps = 0.f;
#pragma unroll
            for (int e = 0; e < 16; ++e) { const float p0 = __builtin_amdgcn_exp2f(xB0[e] - mn); xB0[e] = p0; const float p1 = __builtin_amdgcn_exp2f(xB1[e] - mn); xB1[e] = p1; ps += p0 + p1; }
            lB = lB * alB + ps;
#pragma unroll
            for (int e = 0; e < 16; ++e) { oB0[e] *= alB; oB1[e] *= alB; }
        }
#pragma unroll
        for (int i = 0; i < 2; ++i)
#pragma unroll
            for (int sp = 0; sp < 2; ++sp) {
                h8 pA, pB;
#pragma unroll
                for (int j = 0; j < 8; ++j) { pA[j] = (hf)(i == 0 ? xA0[8 * sp + j] : xA1[8 * sp + j]); pB[j] = (hf)(i == 0 ? xB0[8 * sp + j] : xB1[8 * sp + j]); }
#pragma unroll
                for (int dt = 0; dt < 2; ++dt) {
                    const LAS char* vp = vb + dt * 32 * VROWB + 64 * i + 32 * sp;
                    const h4 v0 = *(const LAS h4*)vp, v1 = *(const LAS h4*)(vp + 16);
                    h8 vf; vf[0] = v0[0]; vf[1] = v0[1]; vf[2] = v0[2]; vf[3] = v0[3]; vf[4] = v1[0]; vf[5] = v1[1]; vf[6] = v1[2]; vf[7] = v1[3];
                    if (dt == 0) { oA0 = MFMA32(vf, pA, oA0); oB0 = MFMA32(vf, pB, oB0); } else { oA1 = MFMA32(vf, pA, oA1); oB1 = MFMA32(vf, pB, oB1); }
                }
            }
        asm volatile("s_waitcnt vmcnt(12)" ::: "memory");
        __builtin_amdgcn_s_barrier();
        asm volatile("" ::: "memory");
        cb = cb == NST - 1 ? 0 : cb + 1;
    }
    asm volatile("s_waitcnt vmcnt(0)" ::: "memory");
    lA += __shfl_xor(lA, 32); lB += __shfl_xor(lB, 32);
    const float ia = 1.f / lA, ib = 1.f / lB;
    hf* opA = a.O + (size_t)(a.t0 + rowA) * 1024; hf* opB = opA + (size_t)32 * 1024;
#pragma unroll
    for (int g = 0; g < 4; ++g) {
        h4 v;
        v[0] = (hf)(oA0[4 * g] * ia); v[1] = (hf)(oA0[4 * g + 1] * ia); v[2] = (hf)(oA0[4 * g + 2] * ia); v[3] = (hf)(oA0[4 * g + 3] * ia); *(h4*)(opA + 8 * g + 4 * h) = v;
        v[0] = (hf)(oA1[4 * g] * ia); v[1] = (hf)(oA1[4 * g + 1] * ia); v[2] = (hf)(oA1[4 * g + 2] * ia); v[3] = (hf)(oA1[4 * g + 3] * ia); *(h4*)(opA + 32 + 8 * g + 4 * h) = v;
        v[0] = (hf)(oB0[4 * g] * ib); v[1] = (hf)(oB0[4 * g + 1] * ib); v[2] = (hf)(oB0[4 * g + 2] * ib); v[3] = (hf)(oB0[4 * g + 3] * ib); *(h4*)(opB + 8 * g + 4 * h) = v;
        v[0] = (hf)(oB1[4 * g] * ib); v[1] = (hf)(oB1[4 * g + 1] * ib); v[2] = (hf)(oB1[4 * g + 2] * ib); v[3] = (hf)(oB1[4 * g + 3] * ib); *(h4*)(opB + 32 + 8 * g + 4 * h) = v;
    }
}

__device__ void phase_attn0(const Params& p, char* smem) {
    char* ws = p.ws;
    const int tid = tid_opaque();
    for (int it = blockIdx.x; it < 768 + 1536; it += gridDim.x) {
        AttnArgs a{};
        a.O = (hf*)(ws + OFF_AO);
        if (it < 768) {
            int head, s0, L, t0;
            if (it < 512) { const int u = (it & 7) + 8 * (it >> 7), qb = (it >> 3) & 15; const int sq = u >> 3; head = u & 7; s0 = sq * 8192; L = 8192; t0 = s0 + qb * 512; }
            else { const int j = it - 512; head = j & 7; s0 = TP; L = 16384; t0 = s0 + (j >> 3) * 512; }
            a.Q = (const hf*)p.out + head * 96; a.qs = 768;
            a.K = (const hf*)(ws + OFF_KN) + head * 64; a.ks = 512;
            a.Kx = (const hf*)(ws + OFF_KR);
            a.Vt = (const hf*)(ws + OFF_VMT) + (size_t)head * 64 * T;
            a.O += 512 + head * 64;
            a.t0 = t0; a.kt0 = s0; a.nkt = L / 64;
            mla_item64(a, smem);
        } else {
            const int i2 = it - 768, head = i2 & 7, qblk = i2 >> 3, t0 = qblk * 256;
            int s0, L; seq_of(t0, s0, L);
            const int rows = L / 64, R0 = (t0 - s0) / 64;
            int rs0 = R0 - 4; rs0 = rs0 < 0 ? 0 : (rs0 > rows - 8 ? rows - 8 : rs0);
            int rs1 = R0 + 3 - 4; rs1 = rs1 < 0 ? 0 : (rs1 > rows - 8 ? rows - 8 : rs1);
            __syncthreads();
            float* biasL = (float*)(smem + LDS_NAB);
            for (int i = tid; i < 465; i += NT) biasL[i] = p.in[3][head * 465 + i] * LOG2E;
            a.Q = (const hf*)(ws + OFF_QA) + head * 64; a.qs = 512;
            a.K = (const hf*)(ws + OFF_KA) + head * 64; a.ks = 512;
            a.Vt = (const hf*)(ws + OFF_VAT) + (size_t)head * 64 * T;
            a.O += head * 64;
            a.t0 = t0; a.kt0 = s0 + 64 * rs0; a.nkt = rs1 + 8 - rs0;
            a.R0 = R0; a.rows = rows; a.kr0 = rs0;
            attn_item<64, AT_NA>(a, smem);
        }
    }
}

DI void swa_stage(const AttnArgs& a, char* smem) {
    constexpr int KST = 72, VST = 68;
    const int tid = tid_opaque(), krow = tid >> 3, kkc = tid & 7;
    const hf* kbase = a.K + (size_t)(a.kt0 + krow) * a.ks + kkc * 8;
    const hf* vbase = a.Vt + (size_t)krow * T + a.kt0 + kkc * 8;
    h8 rk[8], rv[8];
#pragma unroll
    for (int kt = 0; kt < 8; ++kt) if (kt < a.nkt) { rk[kt] = *(const h8*)(kbase + (size_t)(64 * kt) * a.ks); rv[kt] = *(const h8*)(vbase + 64 * kt); }
    __syncthreads();
#pragma unroll
    for (int kt = 0; kt < 8; ++kt) if (kt < a.nkt) {
        hf* Ks = (hf*)(smem + kt * SWA_TILE); hf* Vs = Ks + 64 * KST;
        *(h8*)(Ks + krow * KST + kkc * 8) = rk[kt];
        h4 lo, hi; lo[0] = rv[kt][0]; lo[1] = rv[kt][1]; lo[2] = rv[kt][2]; lo[3] = rv[kt][3]; hi[0] = rv[kt][4]; hi[1] = rv[kt][5]; hi[2] = rv[kt][6]; hi[3] = rv[kt][7];
        *(h4*)(Vs + krow * VST + kkc * 8) = lo; *(h4*)(Vs + krow * VST + kkc * 8 + 4) = hi;
    }
    __syncthreads();
}
DI void swa_pair(const AttnArgs& a, const hf* QB, hf* OB, float sinkB, char* smem) {
    constexpr int KST = 72, VST = 68;
    const int tid = tid_opaque(), lane = tid & 63, wave = tid >> 6, ql = lane & 31, h = lane >> 5;
    const int qrow = 32 * wave + ql;
    h8 qa[4], qb[4];
    {
        const hf* pa = a.Q + (size_t)(a.t0 + qrow) * a.qs + 8 * h; const hf* pb = QB + (size_t)(a.t0 + qrow) * a.qs + 8 * h;
#pragma unroll
        for (int s = 0; s < 4; ++s) { qa[s] = *(const h8*)(pa + 16 * s); qb[s] = *(const h8*)(pb + 16 * s); }
    }
    float mA = a.sink, mB = sinkB, lA = (h == 0) ? 1.f : 0.f, lB = lA;
    f16v oA0, oA1, oB0, oB1;
#pragma unroll
    for (int e = 0; e < 16; ++e) { oA0[e] = 0.f; oA1[e] = 0.f; oB0[e] = 0.f; oB1[e] = 0.f; }
    const int pq = a.qpos0 + qrow, pqw = a.qpos0 + 32 * wave;
    for (int kt = 0; kt < a.nkt; ++kt) {
        const hf* Ks = (const hf*)(smem + kt * SWA_TILE);
        const hf* Vs = Ks + 64 * KST;
        const int pk0 = a.kpos0 + 64 * kt;
        if ((pk0 <= pqw + 31 + 128) && (pk0 + 63 >= pqw - 128)) {
            f16v xA0, xA1, xB0, xB1;
#pragma unroll
            for (int e = 0; e < 16; ++e) { xA0[e] = 0.f; xA1[e] = 0.f; xB0[e] = 0.f; xB1[e] = 0.f; }
            const hf* kp = Ks + ql * KST + 8 * h;
#pragma unroll
            for (int s = 0; s < 4; ++s) {
                const h8 k0 = *(const h8*)(kp + 16 * s), k1 = *(const h8*)(kp + 32 * KST + 16 * s);
                xA0 = MFMA32(k0, qa[s], xA0); xB0 = MFMA32(k0, qb[s], xB0);
                xA1 = MFMA32(k1, qa[s], xA1); xB1 = MFMA32(k1, qb[s], xB1);
            }
            if (!((pk0 >= pqw + 31 - 128) && (pk0 + 63 <= pqw + 128))) {
                const int base = pk0 + 4 * h - pq + 128;
#pragma unroll
                for (int e = 0; e < 16; ++e) {
                    const unsigned t0 = (unsigned)(base + (e & 3) + 8 * (e >> 2)), t1 = t0 + 32u;
                    if (t0 > 256u) { xA0[e] = NEG_BIG; xB0[e] = NEG_BIG; }
                    if (t1 > 256u) { xA1[e] = NEG_BIG; xB1[e] = NEG_BIG; }
                }
            }
            float mxa = xA0[0], mxb = xB0[0];
#pragma unroll
            for (int e = 1; e < 16; ++e) { mxa = fmaxf(mxa, xA0[e]); mxb = fmaxf(mxb, xB0[e]); }
#pragma unroll
            for (int e = 0; e < 16; ++e) { mxa = fmaxf(mxa, xA1[e]); mxb = fmaxf(mxb, xB1[e]); }
            const float pa_ = __shfl_xor(mxa, 32), pb_ = __shfl_xor(mxb, 32);
            const float mna = fmaxf(mA, fmaxf(mxa, pa_)), mnb = fmaxf(mB, fmaxf(mxb, pb_));
            const float alA = __builtin_amdgcn_exp2f(mA - mna), alB = __builtin_amdgcn_exp2f(mB - mnb); mA = mna; mB = mnb;
            float psa = 0.f, psb = 0.f;
#pragma unroll
            for (int e = 0; e < 16; ++e) {
                const float p0 = __builtin_amdgcn_exp2f(xA0[e] - mna), q0 = __builtin_amdgcn_exp2f(xB0[e] - mnb), p1 = __builtin_amdgcn_exp2f(xA1[e] - mna), q1 = __builtin_amdgcn_exp2f(xB1[e] - mnb);
                xA0[e] = p0; xB0[e] = q0; xA1[e] = p1; xB1[e] = q1; psa += p0 + p1; psb += q0 + q1;
            }
            lA = lA * alA + psa; lB = lB * alB + psb;
#pragma unroll
            for (int e = 0; e < 16; ++e) { oA0[e] *= alA; oB0[e] *= alB; oA1[e] *= alA; oB1[e] *= alB; }
#pragma unroll
            for (int i = 0; i < 2; ++i)
#pragma unroll
                for (int sp = 0; sp < 2; ++sp) {
                    h8 pA, pB;
#pragma unroll
                    for (int j = 0; j < 8; ++j) { pA[j] = (hf)(i == 0 ? xA0[8 * sp + j] : xA1[8 * sp + j]); pB[j] = (hf)(i == 0 ? xB0[8 * sp + j] : xB1[8 * sp + j]); }
#pragma unroll
                    for (int dt = 0; dt < 2; ++dt) {
                        const hf* vp = Vs + (32 * dt + ql) * VST + 32 * i + 16 * sp + 4 * h;
                        const h4 v0 = *(const h4*)vp, v1 = *(const h4*)(vp + 8);
                        h8 vf; vf[0] = v0[0]; vf[1] = v0[1]; vf[2] = v0[2]; vf[3] = v0[3]; vf[4] = v1[0]; vf[5] = v1[1]; vf[6] = v1[2]; vf[7] = v1[3];
                        if (dt == 0) { oA0 = MFMA32(vf, pA, oA0); oB0 = MFMA32(vf, pB, oB0); } else { oA1 = MFMA32(vf, pA, oA1); oB1 = MFMA32(vf, pB, oB1); }
                    }
                }
        }
    }
    lA += __shfl_xor(lA, 32); lB += __shfl_xor(lB, 32);
    const float ia = 1.f / lA, ib = 1.f / lB;
    hf* opA = a.O + (size_t)(a.t0 + qrow) * 1024; hf* opB = OB + (size_t)(a.t0 + qrow) * 1024;
#pragma unroll
    for (int g = 0; g < 4; ++g) {
        h4 v;
        v[0] = (hf)(oA0[4 * g] * ia); v[1] = (hf)(oA0[4 * g + 1] * ia); v[2] = (hf)(oA0[4 * g + 2] * ia); v[3] = (hf)(oA0[4 * g + 3] * ia); *(h4*)(opA + 8 * g + 4 * h) = v;
        v[0] = (hf)(oA1[4 * g] * ia); v[1] = (hf)(oA1[4 * g + 1] * ia); v[2] = (hf)(oA1[4 * g + 2] * ia); v[3] = (hf)(oA1[4 * g + 3] * ia); *(h4*)(opA + 32 + 8 * g + 4 * h) = v;
        v[0] = (hf)(oB0[4 * g] * ib); v[1] = (hf)(oB0[4 * g + 1] * ib); v[2] = (hf)(oB0[4 * g + 2] * ib); v[3] = (hf)(oB0[4 * g + 3] * ib); *(h4*)(opB + 8 * g + 4 * h) = v;
        v[0] = (hf)(oB1[4 * g] * ib); v[1] = (hf)(oB1[4 * g + 1] * ib); v[2] = (hf)(oB1[4 * g + 2] * ib); v[3] = (hf)(oB1[4 * g + 3] * ib); *(h4*)(opB + 32 + 8 * g + 4 * h) = v;
    }
}

__device__ void phase_attn1(const Params& p, char* smem) {
    char* ws = p.ws;
    for (int it = blockIdx.x; it < 192 * 4; it += gridDim.x) {
        const int hkv = it & 3, qblk = it >> 2, t0 = qblk * 256;
        int s0, L; seq_of(t0, s0, L);
        const int qpos0 = t0 - s0;
        const int ks = qpos0 - 128 < 0 ? 0 : qpos0 - 128, ke = qpos0 + 384 > L ? L : qpos0 + 384;
        AttnArgs a{};
        a.qs = 1024;
        a.K = (const hf*)(ws + OFF_K1) + hkv * 64; a.ks = 256;
        a.Vt = (const hf*)(ws + OFF_V1T) + (size_t)hkv * 64 * T;
        a.t0 = t0; a.kt0 = s0 + ks; a.nkt = (ke - ks) / 64;
        a.qpos0 = qpos0; a.kpos0 = ks;
        swa_stage(a, smem);
#pragma unroll 1
        for (int pr = 0; pr < 2; ++pr) {
            const int hq = 4 * hkv + 2 * pr;
            a.Q = (const hf*)(ws + OFF_Q1) + hq * 64; a.O = (hf*)(ws + OFF_AO) + hq * 64; a.sink = p.in[18][hq] * LOG2E;
            swa_pair(a, a.Q + 64, a.O + 64, p.in[18][hq + 1] * LOG2E, smem);
        }
    }
}

__device__ void phase_ln(const Params& p, const float* g, const float* b, bool last) {
    const int lane = tid_opaque() & 63;
    const int gw = (blockIdx.x * NT + tid_opaque()) >> 6, nw = gridDim.x * (NT / 64);
    hf* Xh = (hf*)(p.ws + OFF_XH);
    f4 gg[4], bb[4];
#pragma unroll
    for (int i = 0; i < 2; ++i) { gg[2 * i] = *(const f4*)(g + i * 512 + lane * 8); gg[2 * i + 1] = *(const f4*)(g + i * 512 + lane * 8 + 4); bb[2 * i] = *(const f4*)(b + i * 512 + lane * 8); bb[2 * i + 1] = *(const f4*)(b + i * 512 + lane * 8 + 4); }
    constexpr int RB = 4;
    for (int row0 = gw; row0 < T; row0 += nw * RB) {
        h8 hv[RB][2];
#pragma unroll
        for (int r = 0; r < RB; ++r) {
            const int row = row0 + r * nw;
            if (row < T) { const hf* y = Xh + (size_t)row * DM; hv[r][0] = *(const h8*)(y + lane * 8); hv[r][1] = *(const h8*)(y + 512 + lane * 8); }
        }
#pragma unroll
        for (int r = 0; r < RB; ++r) {
            const int row = row0 + r * nw;
            if (row < T) {
                hf* y = Xh + (size_t)row * DM;
                f4 v[4];
#pragma unroll
                for (int i = 0; i < 2; ++i) {
                    v[2 * i] = (f4){(float)hv[r][i][0], (float)hv[r][i][1], (float)hv[r][i][2], (float)hv[r][i][3]}; v[2 * i + 1] = (f4){(float)hv[r][i][4], (float)hv[r][i][5], (float)hv[r][i][6], (float)hv[r][i][7]};
                }
                float s_ = 0.f;
#pragma unroll
                for (int i = 0; i < 4; ++i) s_ += v[i][0] + v[i][1] + v[i][2] + v[i][3];
                const float mu = wave_sum(s_) * (1.f / 1024.f);
                float q = 0.f;
#pragma unroll
                for (int i = 0; i < 4; ++i) { v[i] = v[i] - mu; q += v[i][0] * v[i][0] + v[i][1] * v[i][1] + v[i][2] * v[i][2] + v[i][3] * v[i][3]; }
                const float rstd = rsqrtf(wave_sum(q) * (1.f / 1024.f) + EPS);
#pragma unroll
                for (int i = 0; i < 2; ++i) {
                    const f4 o0 = v[2 * i] * rstd * gg[2 * i] + bb[2 * i], o1 = v[2 * i + 1] * rstd * gg[2 * i + 1] + bb[2 * i + 1];
                    if (last) { float* op = p.out + (size_t)row * DM + i * 512 + lane * 8; *(f4*)op = o0; *(f4*)(op + 4) = o1; }
                    else *(h8*)(y + i * 512 + lane * 8) = cvt8(o0, o1, 1.f);
                }
            }
        }
    }
}


#define XB_TMO      128
#define XB_XCNT(j)  (256  + 64 * (j))
#define XB_XSUB(j)  (1280 + 64 * (j))
#define XB_XGEN(j)  (2304 + 64 * (j))
#define XB_TOP      3328
#define XB_TOPGEN   3392
#define XCD_BAR_WORDS 3456
#define XB_SPIN_CAP (1u << 18)
DI unsigned xb_ld(unsigned* p)              { return __hip_atomic_load(p, __ATOMIC_RELAXED, __HIP_MEMORY_SCOPE_AGENT); }
DI unsigned xb_add(unsigned* p, unsigned v) { return __hip_atomic_fetch_add(p, v, __ATOMIC_RELAXED, __HIP_MEMORY_SCOPE_AGENT); }
DI unsigned xb_xcc_id() { return (unsigned)__builtin_amdgcn_s_getreg((3 << 11) | 20) & 0xFu; }
#define XB_SPIN(cond, bar) do { unsigned _sp = 0; while (cond) { __builtin_amdgcn_s_sleep(1); \
    if ((++_sp & 255u) == 0u) { if (xb_ld(&(bar)[XB_TMO])) break; if (_sp > XB_SPIN_CAP) { atomicAdd(&(bar)[XB_TMO], 1u); break; } } } } while (0)
struct XcdBarrier { unsigned* bar; unsigned x; volatile LAS unsigned* st; };
DI XcdBarrier xcd_barrier_post(unsigned* bar, volatile LAS unsigned* st) {
    XcdBarrier b; b.bar = bar; b.x = xb_xcc_id(); b.st = st;
    if (threadIdx.x == 0) (void)xb_add(&bar[XB_XCNT(b.x)], 1u);
    return b;
}
DI void xcd_barrier_complete(unsigned* bar, unsigned x, unsigned& nloc, unsigned& nx) {
    const unsigned G = gridDim.x * gridDim.y * gridDim.z;
    unsigned sum, cnt, mine, sp = 0u;
    for (;;) {
        sum = 0u; cnt = 0u; mine = 0u;
#pragma unroll
        for (unsigned j = 0; j < 16; ++j) { const unsigned c = xb_ld(&bar[XB_XCNT(j)]); sum += c; cnt += (c > 0u) ? 1u : 0u; mine = (j == x) ? c : mine; }
        if (sum == G) break;
        __builtin_amdgcn_s_sleep(1);
        if ((++sp & 255u) == 0u) { if (xb_ld(&bar[XB_TMO])) break; if (sp > XB_SPIN_CAP) { atomicAdd(&bar[XB_TMO], 1u); break; } }
    }
    nloc = mine > 0u ? mine : 1u; nx = cnt > 0u ? cnt : 1u;
}
DI void xcd_barrier(const XcdBarrier& b) {
    asm volatile("s_waitcnt vmcnt(0)" ::: "memory");
    __syncthreads();
    if (threadIdx.x == 0) {
        unsigned* bar = b.bar;
        __builtin_amdgcn_s_waitcnt(0);
        unsigned nloc = b.st[0], nx = b.st[1];
        if (nloc == 0u) { xcd_barrier_complete(bar, b.x, nloc, nx); b.st[0] = nloc; b.st[1] = nx; }
        const unsigned old = xb_add(&bar[XB_XSUB(b.x)], 1u);
        const unsigned gen = old / nloc;
        if (old + 1u == (gen + 1u) * nloc) {
            __builtin_amdgcn_fence(__ATOMIC_RELEASE, "agent");
            asm volatile("s_waitcnt vmcnt(0)" ::: "memory");
            const unsigned og = xb_add(&bar[XB_TOP], 1u);
            const unsigned tg = og / nx;
            if (og + 1u == (tg + 1u) * nx) xb_add(&bar[XB_TOPGEN], 1u);
            else XB_SPIN(xb_ld(&bar[XB_TOPGEN]) == tg, bar);
            __builtin_amdgcn_fence(__ATOMIC_ACQUIRE, "agent");
            xb_add(&bar[XB_XGEN(b.x)], 1u);
            asm volatile("s_waitcnt vmcnt(0)" ::: "memory");
        } else {
            XB_SPIN(xb_ld(&bar[XB_XGEN(b.x)]) == gen, bar);
            __builtin_amdgcn_fence(__ATOMIC_ACQUIRE, "agent");
            asm volatile("s_waitcnt vmcnt(0)" ::: "memory");
        }
    }
    __syncthreads();
}

constexpr int NPHASE = 16;
template <int PH> DI void run_phase(const Params& p, char* smem) {
    char* ws = p.ws;
    if (PH == 0) phase_prep(p, smem);
    else if (PH == 1) phase_gemm<G_IN0>(p, smem, (const hf*)(ws + OFF_XH), 1024, (const hf*)(ws + OFF_WIN0), 9, nullptr, nullptr);
    else if (PH == 2) phase_gemm<G_UP>(p, smem, (const hf*)(ws + OFF_QL), 384, (const hf*)(ws + OFF_WQUP), 3, nullptr, nullptr);
    else if (PH == 3) phase_attn0(p, smem);
    else if (PH == 4) phase_gemm<G_RES>(p, smem, (const hf*)(ws + OFF_AO), 1024, (const hf*)(ws + OFF_WOUT0), 4, nullptr, nullptr);
    else if (PH == 5) phase_ln(p, p.in[9], p.in[10], false);
    else if (PH == 6) phase_gemm<G_FFN>(p, smem, (const hf*)(ws + OFF_XH), 1024, (const hf*)(ws + OFF_WUP0), 22, p.in[12], p.in[13]);
    else if (PH == 7) phase_gemm<G_RES>(p, smem, (const hf*)(ws + OFF_U), 2816, (const hf*)(ws + OFF_WDN0), 4, nullptr, nullptr);
    else if (PH == 8) phase_ln(p, p.in[15], p.in[16], false);
    else if (PH == 9) phase_gemm<G_IN1>(p, smem, (const hf*)(ws + OFF_XH), 1024, (const hf*)(ws + OFF_WIN1), 6, nullptr, nullptr);
    else if (PH == 10) phase_attn1(p, smem);
    else if (PH == 11) phase_gemm<G_RES>(p, smem, (const hf*)(ws + OFF_AO), 1024, (const hf*)(ws + OFF_WOUT1), 4, nullptr, nullptr);
    else if (PH == 12) phase_ln(p, p.in[20], p.in[21], false);
    else if (PH == 13) phase_gemm<G_FFN>(p, smem, (const hf*)(ws + OFF_XH), 1024, (const hf*)(ws + OFF_WUP1), 22, p.in[23], p.in[24]);
    else if (PH == 14) phase_gemm<G_RES>(p, smem, (const hf*)(ws + OFF_U), 2816, (const hf*)(ws + OFF_WDN1), 4, nullptr, nullptr);
    else if (PH == 15) phase_ln(p, p.in[26], p.in[27], true);
}

template <int LO, int HI> struct PhaseLoop {
    static DI void run(const Params& p, char* smem, const XcdBarrier& xb) {
        for (int r = 0; r < ((PROBE_MASK >> LO) & 1) + 1; ++r) run_phase<LO>(p, smem);
        if (LO + 1 < HI) {
            if (LO == 0) cg::this_grid().sync(); else xcd_barrier(xb);
            for (int r = 0; r < PROBE_SYNCS; ++r) xcd_barrier(xb);
            PhaseLoop<LO + 1, HI>::run(p, smem, xb);
        }
    }
};
template <int HI> struct PhaseLoop<HI, HI> { static DI void run(const Params&, char*, const XcdBarrier&) {} };

__global__ void __launch_bounds__(NT) mega_kernel(Params p) {
    extern __shared__ __attribute__((aligned(16))) char smem[];
    volatile LAS unsigned* st = (volatile LAS unsigned*)(LAS char*)(smem + LDS_ST);
    if (threadIdx.x == 0) { st[0] = 0u; st[1] = 0u; }
    __syncthreads();
    const XcdBarrier xb = xcd_barrier_post((unsigned*)(p.ws + OFF_BAR), st);
    PhaseLoop<0, NPHASE>::run(p, smem, xb);
}
extern "C" void kernel_launch(void* const* d_in, const int* in_sizes, int n_in, void* d_out, int out_size, void* d_ws, size_t ws_size, hipStream_t stream) {
    static int grid = 0;
    if (grid == 0) {
        if (n_in != 28 || out_size != T * DM || ws_size < WS_END) { fprintf(stderr, "kernel_launch: unexpected shapes (n_in %d out %d ws %zu need %zu)\n", n_in, out_size, ws_size, (size_t)WS_END); grid = -1; return; }
        int dev = 0, cus = 0, per_cu = 0;
        (void)hipGetDevice(&dev);
        (void)hipDeviceGetAttribute(&cus, hipDeviceAttributeMultiprocessorCount, dev);
        if (hipFuncSetAttribute((const void*)mega_kernel, hipFuncAttributeMaxDynamicSharedMemorySize, LDS_TOTAL) != hipSuccess) fprintf(stderr, "kernel_launch: hipFuncSetAttribute failed\n");
        if (hipOccupancyMaxActiveBlocksPerMultiprocessor(&per_cu, (const void*)mega_kernel, NT, LDS_TOTAL) != hipSuccess || per_cu < 1) { fprintf(stderr, "kernel_launch: occupancy query failed (%d)\n", per_cu); per_cu = 1; }
        grid = cus;
    }
    if (grid < 0) return;
    Params p{};
    for (int i = 0; i < 28; ++i) p.in[i] = (const float*)d_in[i];
    p.out = (float*)d_out; p.ws = (char*)d_ws;
#if MEGA
    if (hipMemsetAsync((char*)d_ws + OFF_BAR, 0, XCD_BAR_WORDS * 4, stream) != hipSuccess) { fprintf(stderr, "kernel_launch: hipMemsetAsync of the barrier words failed\n"); return; }
    void* args[] = {&p};
    hipError_t e = hipLaunchCooperativeKernel((const void*)mega_kernel, dim3(grid), dim3(NT), args, LDS_TOTAL, stream);
    if (e != hipSuccess) fprintf(stderr, "cooperative launch failed: %s (grid %d)\n", hipGetErrorString(e), grid);
#endif
}
```
